# Optimizing an MI355X kernel written in HIP

```python
import jax, jax.numpy as jnp
from jax import lax
import numpy as np

D_MODEL = 2048
BATCH = 4
SEQ = 4096
DEPTH = 1

SGU_CHUNK = 128
SGU_GROUPS = 8
SGU_WIDTH = D_MODEL // 2
MOBA_HEADS = 16
MOBA_HEAD_DIM = D_MODEL // MOBA_HEADS
MOBA_WIDTH = MOBA_HEADS * MOBA_HEAD_DIM
MOBA_BLOCK = 256
MOBA_TOPK = 3
MOBA_Q_CHUNK = 128
ROPE_THETA = 10000.0
MOE_GROUPS = 4
MOE_EXPERTS_PER_GROUP = 8
MOE_EXPERTS = MOE_GROUPS * MOE_EXPERTS_PER_GROUP
MOE_TOPK = 2
MOE_D_FF = D_MODEL // 4
MOE_ROW_BLOCK = 128
EPS = 1e-6
NEG_INF = -1e30
IN_COLS = 2 * SGU_WIDTH + 3 * MOBA_WIDTH + 2 * D_MODEL

kernel_name = 'hybrid_sgu_moba_hiermoe_block'


def rms_norm(x, g):
    xf = x.astype(jnp.float32)
    y = xf * lax.rsqrt(jnp.mean(xf * xf, axis=-1, keepdims=True) + EPS)
    return (y * g.astype(jnp.float32)).astype(x.dtype)


def layer_norm(x, g, b):
    xf = x.astype(jnp.float32)
    mu = jnp.mean(xf, axis=-1, keepdims=True)
    var = jnp.mean(jnp.square(xf - mu), axis=-1, keepdims=True)
    y = (xf - mu) * lax.rsqrt(var + EPS)
    return (y * g.astype(jnp.float32) + b.astype(jnp.float32)).astype(x.dtype)


def modulate(n, shift, scale):
    return n * (1.0 + scale[:, None, :]) + shift[:, None, :]


def rotary_tables(positions, dim):
    inv_freq = ROPE_THETA ** (-jnp.arange(0, dim, 2, dtype=jnp.float32) / dim)
    ang = positions.astype(jnp.float32)[..., None] * inv_freq
    return jnp.cos(ang), jnp.sin(ang)


def apply_rotary(x, cos, sin):
    x1, x2 = jnp.split(x, 2, axis=-1)
    c = cos[:, :, None, :].astype(x.dtype)
    s = sin[:, :, None, :].astype(x.dtype)
    return jnp.concatenate([x1 * c - x2 * s, x2 * c + x1 * s], axis=-1)


def spatial_gating(z, ln_g, ln_b, w_s, b_s):
    B, S, _ = z.shape
    u, v = jnp.split(z, 2, axis=-1)
    v = layer_norm(v, ln_g, ln_b)
    nc = S // SGU_CHUNK
    cg = SGU_WIDTH // SGU_GROUPS
    v = v.reshape(B, nc, SGU_CHUNK, SGU_GROUPS, cg)
    causal = jnp.tril(jnp.ones((SGU_CHUNK, SGU_CHUNK), dtype=bool))
    w = jnp.where(causal[None], w_s, 0)
    sv = jnp.einsum('gij,bcjgd->bcigd', w, v) + b_s.T[None, None, :, :, None]
    return u * sv.reshape(B, S, SGU_WIDTH)


def moba_attention(q, k, v):
    B, S, H, dh = q.shape
    s_pad = -(-S // MOBA_BLOCK) * MOBA_BLOCK
    pad = ((0, 0), (0, s_pad - S), (0, 0), (0, 0))
    q, k, v = jnp.pad(q, pad), jnp.pad(k, pad), jnp.pad(v, pad)
    nb = s_pad // MOBA_BLOCK
    n_top = min(MOBA_TOPK, nb)
    nq = s_pad // MOBA_Q_CHUNK
    scale = dh ** -0.5

    def heads_first(t):
        return t.transpose(0, 2, 1, 3).reshape(B * H, s_pad, dh)

    qh, kh, vh = heads_first(q), heads_first(k), heads_first(v)
    kb = kh.reshape(B * H, nb, MOBA_BLOCK, dh)
    vb = vh.reshape(B * H, nb, MOBA_BLOCK, dh)
    k_mean = jnp.mean(kb.astype(jnp.float32), axis=2)
    gate = jnp.einsum('zsd,znd->zsn', qh.astype(jnp.float32), k_mean)
    q_blk = jnp.arange(s_pad) // MOBA_BLOCK
    past = jnp.arange(nb)[None, :] < q_blk[:, None]
    gate = jnp.where(past[None], gate, NEG_INF)
    _, top_idx = lax.top_k(gate, n_top)

    def one_head(args):
        q_z, idx_z, kb_z, vb_z = args

        def one_chunk(cargs):
            q_c, idx_c, ci = cargs
            start = ci * MOBA_Q_CHUNK
            q_pos = start + jnp.arange(MOBA_Q_CHUNK)
            blk = start // MOBA_BLOCK
            k_own = lax.dynamic_index_in_dim(kb_z, blk, 0, keepdims=False)
            v_own = lax.dynamic_index_in_dim(vb_z, blk, 0, keepdims=False)
            k_sel = kb_z[idx_c]
            v_sel = vb_z[idx_c]
            s_own = jnp.einsum('qd,kd->qk', q_c, k_own).astype(jnp.float32) * scale
            k_pos = blk * MOBA_BLOCK + jnp.arange(MOBA_BLOCK)
            s_own = jnp.where(k_pos[None, :] <= q_pos[:, None], s_own, NEG_INF)
            s_sel = jnp.einsum('qd,qnkd->qnk', q_c, k_sel).astype(jnp.float32) * scale
            s_sel = jnp.where((idx_c < blk)[:, :, None], s_sel, NEG_INF)
            s_all = jnp.concatenate([s_own, s_sel.reshape(MOBA_Q_CHUNK, n_top * MOBA_BLOCK)], axis=-1)
            p = jax.nn.softmax(s_all, axis=-1).astype(q_c.dtype)
            p_own = p[:, :MOBA_BLOCK]
            p_sel = p[:, MOBA_BLOCK:].reshape(MOBA_Q_CHUNK, n_top, MOBA_BLOCK)
            return jnp.einsum('qk,kd->qd', p_own, v_own) + jnp.einsum('qnk,qnkd->qd', p_sel, v_sel)

        return lax.map(one_chunk, (q_z, idx_z, jnp.arange(nq)))

    out = lax.map(one_head, (qh.reshape(B * H, nq, MOBA_Q_CHUNK, dh),
                             top_idx.reshape(B * H, nq, MOBA_Q_CHUNK, n_top), kb, vb))
    out = out.reshape(B, H, s_pad, dh)[:, :, :S].transpose(0, 2, 1, 3)
    return out.reshape(B, S, H * dh)


def hierarchical_moe(n, w_rg, b_rg, w_re, b_re, w_gate, w_up, w_down):
    B, S, D = n.shape
    T = B * S
    xt = n.reshape(T, D)
    tok = jnp.arange(T)
    g_logits = (xt @ w_rg + b_rg).astype(jnp.float32)
    g_prob = jax.nn.softmax(g_logits, axis=-1)
    g_sel = jnp.argmax(g_logits, axis=-1).astype(jnp.int32)
    p_group = g_prob[tok, g_sel][:, None]
    e_logits = ((xt @ w_re).reshape(T, MOE_GROUPS, MOE_EXPERTS_PER_GROUP) + b_re).astype(jnp.float32)
    e_logits = e_logits[tok, g_sel]
    top_val, top_loc = lax.top_k(e_logits, MOE_TOPK)
    w_tok = jax.nn.softmax(top_val, axis=-1) * p_group
    expert_id = (g_sel[:, None] * MOE_EXPERTS_PER_GROUP + top_loc).reshape(-1)
    token_id = jnp.repeat(tok, MOE_TOPK)
    weight = w_tok.reshape(-1)
    A = T * MOE_TOPK
    cap = -(-(A + MOE_EXPERTS * MOE_ROW_BLOCK) // MOE_ROW_BLOCK) * MOE_ROW_BLOCK
    n_blocks = cap // MOE_ROW_BLOCK
    order = jnp.argsort(expert_id)
    e_sorted = expert_id[order]
    counts = jnp.bincount(expert_id, length=MOE_EXPERTS)
    padded = (counts + MOE_ROW_BLOCK - 1) // MOE_ROW_BLOCK * MOE_ROW_BLOCK
    start = jnp.cumsum(counts) - counts
    end_padded = jnp.cumsum(padded)
    start_padded = end_padded - padded
    dest = start_padded[e_sorted] + (jnp.arange(A) - start[e_sorted])
    row_token = jnp.full((cap,), T, dtype=jnp.int32).at[dest].set(token_id[order].astype(jnp.int32))
    row_weight = jnp.zeros((cap,), weight.dtype).at[dest].set(weight[order])
    block_expert = jnp.minimum(
        jnp.searchsorted(end_padded, jnp.arange(n_blocks) * MOE_ROW_BLOCK, side='right'),
        MOE_EXPERTS - 1)
    x_pad = jnp.concatenate([xt, jnp.zeros((1, D), xt.dtype)], axis=0)
    rows = x_pad[row_token].reshape(n_blocks, MOE_ROW_BLOCK, D)

    def expert_block(args):
        xb, e = args
        hid = jax.nn.silu(xb @ w_gate[e]) * (xb @ w_up[e])
        return hid @ w_down[e]

    y_rows = lax.map(expert_block, (rows, block_expert)).reshape(cap, D)
    y = jnp.zeros((T + 1, D), y_rows.dtype).at[row_token].add(
        y_rows * row_weight[:, None].astype(y_rows.dtype))
    return y[:T].reshape(B, S, D)


def setup_inputs(seed: int = 0) -> dict:
    key = jax.random.key(seed)
    ks = jax.random.split(key, 32)
    f32 = jnp.float32
    L, D = DEPTH, D_MODEL

    def nrm(k, shape, scale):
        return jax.random.normal(k, shape, f32) * scale

    x = nrm(ks[0], (BATCH, SEQ, D), 1.0)
    c = nrm(ks[1], (BATCH, D), 1.0)
    offset = jax.random.randint(ks[2], (BATCH, 1), 0, 1024, dtype=jnp.int32)
    positions = offset + jnp.arange(SEQ, dtype=jnp.int32)[None, :]
    return {
        'x': x,
        'c': c,
        'positions': positions,
        'w_ada': nrm(ks[3], (L, D, 6 * D), 0.5 * D ** -0.5),
        'b_ada': nrm(ks[4], (L, 6 * D), 0.02),
        'norm_mix_g': 1.0 + nrm(ks[5], (L, D), 0.02),
        'w_in': nrm(ks[6], (L, D, IN_COLS), D ** -0.5),
        'sgu_ln_g': 1.0 + nrm(ks[7], (L, SGU_WIDTH), 0.02),
        'sgu_ln_b': nrm(ks[8], (L, SGU_WIDTH), 0.02),
        'sgu_w_s': nrm(ks[9], (L, SGU_GROUPS, SGU_CHUNK, SGU_CHUNK), SGU_CHUNK ** -0.5),
        'sgu_b_s': 1.0 + nrm(ks[10], (L, SGU_GROUPS, SGU_CHUNK), 0.02),
        'w_sgu_out': nrm(ks[11], (L, SGU_WIDTH, D), SGU_WIDTH ** -0.5),
        'w_moba_out': nrm(ks[12], (L, MOBA_WIDTH, D), MOBA_WIDTH ** -0.5),
        'w_out': nrm(ks[13], (L, D, D), D ** -0.5),
        'norm_ffn_g': 1.0 + nrm(ks[14], (L, D), 0.02),
        'w_route_group': nrm(ks[15], (L, D, MOE_GROUPS), D ** -0.5),
        'b_route_group': nrm(ks[16], (L, MOE_GROUPS), 0.01),
        'w_route_expert': nrm(ks[17], (L, D, MOE_EXPERTS), D ** -0.5),
        'b_route_expert': nrm(ks[18], (L, MOE_GROUPS, MOE_EXPERTS_PER_GROUP), 0.01),
        'w_exp_gate': nrm(ks[19], (L, MOE_EXPERTS, D, MOE_D_FF), D ** -0.5),
        'w_exp_up': nrm(ks[20], (L, MOE_EXPERTS, D, MOE_D_FF), D ** -0.5),
        'w_exp_down': nrm(ks[21], (L, MOE_EXPERTS, MOE_D_FF, D), MOE_D_FF ** -0.5),
        'norm_final_g': 1.0 + nrm(ks[22], (D,), 0.02),
    }


def reference(x, c, positions, w_ada, b_ada, norm_mix_g, w_in, sgu_ln_g, sgu_ln_b, sgu_w_s,
              sgu_b_s, w_sgu_out, w_moba_out, w_out, norm_ffn_g, w_route_group, b_route_group,
              w_route_expert, b_route_expert, w_exp_gate, w_exp_up, w_exp_down, norm_final_g):
    B, S, D = x.shape
    cos, sin = rotary_tables(positions, MOBA_HEAD_DIM)
    c_act = jax.nn.silu(c)
    splits = [2 * SGU_WIDTH, 2 * SGU_WIDTH + MOBA_WIDTH, 2 * SGU_WIDTH + 2 * MOBA_WIDTH,
              2 * SGU_WIDTH + 3 * MOBA_WIDTH, 2 * SGU_WIDTH + 3 * MOBA_WIDTH + D_MODEL]
    h = x
    for l in range(DEPTH):
        ada = c_act @ w_ada[l] + b_ada[l]
        sh_m, sc_m, g_m, sh_f, sc_f, g_f = jnp.split(ada, 6, axis=-1)
        n = modulate(rms_norm(h, norm_mix_g[l]), sh_m, sc_m)
        proj = n @ w_in[l]
        z_sgu, q, k, v, gate_a, gate_b = jnp.split(proj, splits, axis=-1)
        y_a = spatial_gating(jax.nn.gelu(z_sgu), sgu_ln_g[l], sgu_ln_b[l],
                             sgu_w_s[l], sgu_b_s[l]) @ w_sgu_out[l]
        q = apply_rotary(q.reshape(B, S, MOBA_HEADS, MOBA_HEAD_DIM), cos, sin)
        k = apply_rotary(k.reshape(B, S, MOBA_HEADS, MOBA_HEAD_DIM), cos, sin)
        v = v.reshape(B, S, MOBA_HEADS, MOBA_HEAD_DIM)
        y_b = moba_attention(q, k, v) @ w_moba_out[l]
        merged = jax.nn.sigmoid(gate_a) * y_a + jax.nn.sigmoid(gate_b) * y_b
        h = h + g_m[:, None, :] * (merged @ w_out[l])
        n2 = modulate(rms_norm(h, norm_ffn_g[l]), sh_f, sc_f)
        h = h + g_f[:, None, :] * hierarchical_moe(
            n2, w_route_group[l], b_route_group[l], w_route_expert[l], b_route_expert[l],
            w_exp_gate[l], w_exp_up[l], w_exp_down[l])
    return rms_norm(h, norm_final_g)
```

```cpp
#include <hip/hip_runtime.h>
#include <cstdio>
#include <cstdint>

#define GAS __attribute__((address_space(1)))
#define LAS __attribute__((address_space(3)))
typedef unsigned short bf16;
typedef unsigned v4u __attribute__((ext_vector_type(4)));
typedef unsigned v2u __attribute__((ext_vector_type(2)));
typedef float f32x2 __attribute__((ext_vector_type(2)));
typedef float f32x4 __attribute__((ext_vector_type(4)));
typedef float f32x16 __attribute__((ext_vector_type(16)));
typedef short bf16x8 __attribute__((ext_vector_type(8)));
typedef short s16x4 __attribute__((ext_vector_type(4)));
typedef GAS unsigned gu32;
#define RLX_AGENT __ATOMIC_RELAXED, __HIP_MEMORY_SCOPE_AGENT
#define LDS_WAIT() asm volatile("s_waitcnt lgkmcnt(0)" ::: "memory")
#define VM_WAIT() asm volatile("s_waitcnt vmcnt(0)" ::: "memory")

constexpr int BATCH = 4, SEQ = 4096, T = BATCH * SEQ, D = 2048;
constexpr int SGW = 1024, NHEAD = 16, HD = 128, INC = 12288;
constexpr int NEXP = 32, DFF = 512, LCAP = 16384;
constexpr float EPS = 1e-6f;
constexpr int NWAVES = 8;
#ifndef PROBE_DUP
#define PROBE_DUP 0
#endif
#define DUPLOOP(k) for (int rep_ = 0; rep_ < (((PROBE_DUP) >> (k)) & 1) + 1; ++rep_)

constexpr size_t MiB = 1u << 20;
constexpr size_t WS_CTL = 0, CTL_ZERO_BYTES = 1 * MiB;
constexpr size_t WS_ADAP = 1 * MiB;
constexpr size_t WS_ADA = 1 * MiB + 786432;
constexpr size_t WS_COS = 2 * MiB, WS_SIN = 6 * MiB;
constexpr size_t WS_KM = 10 * MiB;
constexpr size_t WS_WS = 10 * MiB + 512 * 1024;
constexpr size_t WS_RT = 11 * MiB;
constexpr size_t WS_TOKE = 12 * MiB, WS_TOKP = WS_TOKE + 128 * 1024, WS_TOKW = WS_TOKP + 128 * 1024;
constexpr size_t WS_LIST = 13 * MiB;
constexpr size_t WS_WINZ = 16 * MiB;
constexpr size_t WS_WIN8 = 24 * MiB;
constexpr size_t WS_WSO = 48 * MiB;
constexpr size_t WS_WMO8 = 52 * MiB;
constexpr size_t WS_WOUT = 60 * MiB;
constexpr size_t WS_WGU8 = 68 * MiB;
constexpr size_t WS_WD8 = 132 * MiB;
constexpr size_t WS_N = 164 * MiB;
constexpr size_t WS_N1F8 = 228 * MiB;
constexpr size_t WS_UV = 260 * MiB;
constexpr size_t WS_Q = 324 * MiB, WS_K = 388 * MiB, WS_V = 452 * MiB;
constexpr size_t WS_SA = 516 * MiB, WS_SB = 580 * MiB;
constexpr size_t WS_END = 644 * MiB;
constexpr size_t WS_Q8 = WS_Q, WS_K8 = WS_K, WS_VT8 = WS_V;
constexpr size_t WS_SGUO = WS_N, WS_O8 = WS_N + 32 * MiB, WS_N2F8 = WS_UV, WS_MERGED = WS_UV, WS_HID8 = WS_N, WS_YROW = WS_Q, WS_DELTA = WS_SA;
constexpr int CW_BAR = 4096, CW_QUEUE = 8192, CW_CNT = 8192 + 64;

constexpr int RING_BYTES = 131072, LDSCTL_OFF = RING_BYTES, MISC_OFF = LDSCTL_OFF + 320, TAB_OFF = LDSCTL_OFF + 1024;
constexpr int LDS_BYTES = 155648;

__device__ __forceinline__ unsigned f2bf(float f) { unsigned u = __builtin_bit_cast(unsigned, f); return (u + 0x7fffu + ((u >> 16) & 1u)) >> 16; }
__device__ __forceinline__ unsigned pk2(float lo, float hi) { return f2bf(lo) | (f2bf(hi) << 16); }
typedef __bf16 bf16x2_t __attribute__((ext_vector_type(2)));
__device__ __forceinline__ unsigned cvt_pk_bf16(float lo, float hi) { f32x2 v = {lo, hi}; bf16x2_t b = __builtin_convertvector(v, bf16x2_t); return __builtin_bit_cast(unsigned, b); }
__device__ __forceinline__ unsigned pk_fp8x4(float a, float b, float c, float d) { unsigned w = 0u; w = __builtin_amdgcn_cvt_pk_fp8_f32(a, b, w, false); w = __builtin_amdgcn_cvt_pk_fp8_f32(c, d, w, true); return w; }
__device__ __forceinline__ float bflo(unsigned w) { return __builtin_bit_cast(float, w << 16); }
__device__ __forceinline__ float bfhi(unsigned w) { return __builtin_bit_cast(float, w & 0xffff0000u); }
__device__ __forceinline__ float wave_sum(float v) {
#pragma unroll
    for (int o = 1; o < 64; o <<= 1) v += __shfl_xor(v, o);
    return v;
}
__device__ __forceinline__ float fast_sigmoid(float x) { return __builtin_amdgcn_rcpf(1.0f + __builtin_amdgcn_exp2f(-1.4426950408889634f * x)); }
__device__ __forceinline__ float gelu_tanh(float x) { const float u = x * (1.0f + 0.044715f * x * x); return x * __builtin_amdgcn_rcpf(1.0f + __builtin_amdgcn_exp2f(-2.3022081985f * u)); }

#define XB_TMO      128
#define XB_XCNT(j)  (256  + 64 * (j))
#define XB_XSUB(j)  (1280 + 64 * (j))
#define XB_XGEN(j)  (2304 + 64 * (j))
#define XB_TOP      3328
#define XB_TOPGEN   3392
#define XCD_BAR_WORDS 3456
#define XB_SPIN_CAP (1u << 18)
__device__ __forceinline__ unsigned xb_ld(unsigned* p)              { return __hip_atomic_load(p, __ATOMIC_RELAXED, __HIP_MEMORY_SCOPE_AGENT); }
__device__ __forceinline__ unsigned xb_add(unsigned* p, unsigned v) { return __hip_atomic_fetch_add(p, v, __ATOMIC_RELAXED, __HIP_MEMORY_SCOPE_AGENT); }
__device__ __forceinline__ unsigned xb_xcc_id() { return (unsigned)__builtin_amdgcn_s_getreg((3 << 11) | 20) & 0xFu; }
#define XB_SPIN(cond, bar) do { unsigned _sp = 0; while (cond) { __builtin_amdgcn_s_sleep(1); \
    if ((++_sp & 255u) == 0u) { if (xb_ld(&(bar)[XB_TMO])) break; if (_sp > XB_SPIN_CAP) { atomicAdd(&(bar)[XB_TMO], 1u); break; } } } } while (0)
struct XcdBarrier { unsigned* bar; unsigned x; volatile LAS unsigned* st; };
__device__ __forceinline__ XcdBarrier xcd_barrier_post(unsigned* bar, volatile LAS unsigned* st, int tid) {
    XcdBarrier b; b.bar = bar; b.x = xb_xcc_id(); b.st = st;
    if (tid == 0) (void)xb_add(&bar[XB_XCNT(b.x)], 1u);
    return b;
}
__device__ __forceinline__ void xcd_barrier_complete(unsigned* bar, unsigned x, unsigned& nloc, unsigned& nx) {
    const unsigned G = gridDim.x * gridDim.y * gridDim.z;
    unsigned sum, cnt, mine, sp = 0u;
    for (;;) {
        sum = 0u; cnt = 0u; mine = 0u;
#pragma unroll
        for (unsigned j = 0; j < 16; ++j) { const unsigned c = xb_ld(&bar[XB_XCNT(j)]); sum += c; cnt += (c > 0u) ? 1u : 0u; mine = (j == x) ? c : mine; }
        if (sum == G) break;
        __builtin_amdgcn_s_sleep(1);
        if ((++sp & 255u) == 0u) { if (xb_ld(&bar[XB_TMO])) break; if (sp > XB_SPIN_CAP) { atomicAdd(&bar[XB_TMO], 1u); break; } }
    }
    nloc = mine > 0u ? mine : 1u; nx = cnt > 0u ? cnt : 1u;
}
__device__ __forceinline__ void xcd_barrier(const XcdBarrier& b, int tid) {
    asm volatile("s_waitcnt vmcnt(0)" ::: "memory");
    __syncthreads();
    if (tid == 0) {
        unsigned* bar = b.bar;
        __builtin_amdgcn_s_waitcnt(0);
        unsigned nloc = b.st[0], nx = b.st[1];
        if (nloc == 0u) { xcd_barrier_complete(bar, b.x, nloc, nx); b.st[0] = nloc; b.st[1] = nx; }
        const unsigned old = xb_add(&bar[XB_XSUB(b.x)], 1u);
        const unsigned gen = old / nloc;
        if (old + 1u == (gen + 1u) * nloc) {
            __builtin_amdgcn_fence(__ATOMIC_RELEASE, "agent");
            asm volatile("s_waitcnt vmcnt(0)" ::: "memory");
            const unsigned og = xb_add(&bar[XB_TOP], 1u);
            const unsigned tg = og / nx;
            if (og + 1u == (tg + 1u) * nx) xb_add(&bar[XB_TOPGEN], 1u);
            else XB_SPIN(xb_ld(&bar[XB_TOPGEN]) == tg, bar);
            __builtin_amdgcn_fence(__ATOMIC_ACQUIRE, "agent");
            xb_add(&bar[XB_XGEN(b.x)], 1u);
            asm volatile("s_waitcnt vmcnt(0)" ::: "memory");
        } else {
            XB_SPIN(xb_ld(&bar[XB_XGEN(b.x)]) == gen, bar);
            __builtin_amdgcn_fence(__ATOMIC_ACQUIRE, "agent");
            asm volatile("s_waitcnt vmcnt(0)" ::: "memory");
        }
    }
    __syncthreads();
}

namespace pg8 {
constexpr int BM = 256, BK = 64, HALF = 128, HTB = HALF * BK * 2, STAGE_BYTES = 8 * HTB, NXCD = 8, WGM = 8;
__device__ __forceinline__ int lds_byte(int r, int c) { const int st = (r >> 4) * 2 + (c >> 5), rr = r & 15, cc = c & 31, ob = rr * 64 + cc * 2; return st * 1024 + (ob ^ (((ob >> 9) & 1) << 5)); }
__device__ __forceinline__ void stage_rc(int b, int& R, int& C) { const int st = b / 1024, sb = b % 1024, swz = sb ^ (((sb >> 9) & 1) << 5); R = (st >> 1) * 16 + swz / 64; C = (st & 1) * 32 + (swz % 64) / 2; }
__device__ __forceinline__ int perm32(int rho) { const int n = rho >> 4, i = rho & 15; return 8 * (i >> 2) + 4 * n + (i & 3); }
typedef int v8i __attribute__((ext_vector_type(8)));
typedef int v4i __attribute__((ext_vector_type(4)));
constexpr int M8_SHIFT = 4;
constexpr int W8_SHIFT = 5;
__device__ __forceinline__ v8i cat8(bf16x8 lo, bf16x8 hi) { const v4i a = __builtin_bit_cast(v4i, lo), b = __builtin_bit_cast(v4i, hi); return __builtin_shufflevector(a, b, 0, 1, 2, 3, 4, 5, 6, 7); }
struct Unit { int pm, pn, ex, kt0, nkt; };

struct StaticOrder {
    int nM, nN, nwg, G, c, nkt; const char* Bt; size_t tstepB;
    __device__ __forceinline__ void init(int M, int N, int rowbytes, int G_, int c_, const void* Bt_) { nM = M / BM; nN = N / BM; nwg = nM * nN; G = G_; c = c_; Bt = (const char*)Bt_; tstepB = (size_t)BM * rowbytes; nkt = rowbytes / 128; }
    __device__ __forceinline__ bool next(int i, Unit& u) const {
        const long L = (long)i * G + c; if (L >= nwg) return false;
        int wgid = (int)L; { const int q = nwg / NXCD, r = nwg % NXCD, xcd = wgid % NXCD, off = wgid / NXCD; wgid = (xcd < r ? xcd * (q + 1) : r * (q + 1) + (xcd - r) * q) + off; }
        const int nig = WGM * nN, gid = wgid / nig, fm = gid * WGM, gsz = (nM - fm) < WGM ? (nM - fm) : WGM;
        u.pm = fm + ((wgid % nig) % gsz); u.pn = (wgid % nig) / gsz; u.ex = 0; u.kt0 = 0; u.nkt = nkt; return true;
    }
    __device__ __forceinline__ const char* b_ptr(const Unit& u) const { return Bt + (size_t)u.pn * tstepB; }
    __device__ __forceinline__ unsigned a_row(const Unit& u, int r) const { return (unsigned)(u.pm * BM + r); }
};

template <bool F8, class Epi, class Sched>
__device__ __forceinline__ void gemm_phase(LAS unsigned char* lds, const char* Ab, const int rowbytes, const Sched& S, const Epi& E, const int tid, const int a8shift = 0) {
    const int wid = __builtin_amdgcn_readfirstlane(tid >> 6), lane = tid & 63, wr = wid >> 2, wc = wid & 3, fr = lane & 15, fq = lane >> 4;
    int Rs[2]; unsigned Cs[2], voffB[2];
#pragma unroll
    for (int i = 0; i < 2; ++i) { int R, C; stage_rc(tid * 16 + i * 8192, R, C); const int Rb = Epi::PERM ? ((R & ~31) + perm32(R & 31)) : R;
        Rs[i] = R; Cs[i] = (unsigned)C * 2u; voffB[i] = (unsigned)(Rb * rowbytes + C * 2); }
    const size_t kstep = (size_t)(BK * 2);
    const size_t hstep = (size_t)HALF * rowbytes;
    const unsigned rowb = (unsigned)rowbytes;
    const unsigned ldsw = (unsigned)wid * 1024u;
    const int aoff = lds_byte(wr * 64 + fr, fq * 8), boff = lds_byte(wc * 32 + fr, fq * 8);
#define PG8_SA(b, h) (((b) * 2 + (h)) * HTB)
#define PG8_SB(b, h) ((4 + (b) * 2 + (h)) * HTB)
#define PG8_STAGE_B(bufoff, gbase) do { _Pragma("unroll") for (int _i = 0; _i < 2; ++_i) \
        __builtin_amdgcn_global_load_lds((const unsigned*)((const char*)(gbase) + voffB[_i]), (LAS unsigned*)(lds + (bufoff) + ldsw + _i * 8192), 16, 0, 0); } while (0)
#define PG8_STAGE_A(bufoff, kbyte, h) do { _Pragma("unroll") for (int _i = 0; _i < 2; ++_i) \
        __builtin_amdgcn_global_load_lds((const unsigned*)(Ab + (kbyte) + vC[h][_i]), (LAS unsigned*)(lds + (bufoff) + ldsw + _i * 8192), 16, 0, 0); } while (0)
#define PG8_LDA(dst, b, h) do { _Pragma("unroll") for (int m = 0; m < 4; ++m) _Pragma("unroll") for (int k = 0; k < 2; ++k) dst[m][k] = *(const LAS bf16x8*)(lds + PG8_SA(b, h) + aoff + m * 2048 + k * 1024); } while (0)
#define PG8_LDB(dst, b, h) do { _Pragma("unroll") for (int n = 0; n < 2; ++n) _Pragma("unroll") for (int k = 0; k < 2; ++k) dst[n][k] = *(const LAS bf16x8*)(lds + PG8_SB(b, h) + boff + n * 2048 + k * 1024); } while (0)
#define PG8_MMA(ai, bj, At, Bt) do { __builtin_amdgcn_s_setprio(1); _Pragma("unroll") for (int m = 0; m < 4; ++m) _Pragma("unroll") for (int n = 0; n < 2; ++n) { \
        if constexpr (F8) acc[ai][bj][m][n] = __builtin_amdgcn_mfma_scale_f32_16x16x128_f8f6f4(cat8(Bt[n][0], Bt[n][1]), cat8(At[m][0], At[m][1]), acc[ai][bj][m][n], 0, 0, 0, 127 - W8_SHIFT, 0, 127 - a8shift); \
        else { _Pragma("unroll") for (int k = 0; k < 2; ++k) acc[ai][bj][m][n] = __builtin_amdgcn_mfma_f32_16x16x32_bf16(Bt[n][k], At[m][k], acc[ai][bj][m][n], 0, 0, 0); } } __builtin_amdgcn_s_setprio(0); } while (0)
#define PG8_WAIT_V(n) asm volatile("s_waitcnt vmcnt(" #n ")" ::: "memory")
#define PG8_WAIT_L(n) asm volatile("s_waitcnt lgkmcnt(" #n ")" ::: "memory")
#define PG8_BAR __builtin_amdgcn_s_barrier()
#define PG8_SCHED __builtin_amdgcn_sched_barrier(0)
    Unit cur, nxt; int ui = 0;
    if (!S.next(0, cur)) return;
    f32x4 acc[2][2][4][2];
#pragma unroll
    for (int a = 0; a < 2; ++a)
#pragma unroll
        for (int b = 0; b < 2; ++b)
#pragma unroll
            for (int m = 0; m < 4; ++m)
#pragma unroll
                for (int n = 0; n < 2; ++n) acc[a][b][m][n] = (f32x4){0.f, 0.f, 0.f, 0.f};
    bf16x8 At[4][2], B0[2][2], B1[2][2];
    unsigned vC[2][2], vN[2][2];
#pragma unroll
    for (int h = 0; h < 2; ++h)
#pragma unroll
        for (int i = 0; i < 2; ++i) vC[h][i] = S.a_row(cur, h * HALF + Rs[i]) * rowb + Cs[i];
    const char* cB = S.b_ptr(cur) + (size_t)cur.kt0 * kstep; size_t kc = (size_t)cur.kt0 * kstep; int nt = cur.nkt;
    PG8_STAGE_B(PG8_SB(0, 0), cB); PG8_STAGE_B(PG8_SB(0, 1), cB + hstep); PG8_STAGE_A(PG8_SA(0, 0), kc, 0); PG8_STAGE_A(PG8_SA(0, 1), kc, 1);
    if (wr == 1) PG8_BAR;
    PG8_WAIT_V(2); PG8_BAR;
    PG8_STAGE_B(PG8_SB(1, 0), cB + kstep); PG8_STAGE_A(PG8_SA(1, 0), kc + kstep, 0); PG8_STAGE_B(PG8_SB(1, 1), cB + hstep + kstep);
    PG8_WAIT_V(6); PG8_BAR;
    for (;;) {
        const bool has_next = S.next(ui + 1, nxt);
        const char* nB = has_next ? S.b_ptr(nxt) + (size_t)nxt.kt0 * kstep : cB; const size_t kn = has_next ? (size_t)nxt.kt0 * kstep : kc;
#pragma unroll
        for (int h = 0; h < 2; ++h)
#pragma unroll
            for (int i = 0; i < 2; ++i) vN[h][i] = has_next ? (S.a_row(nxt, h * HALF + Rs[i]) * rowb + Cs[i]) : vC[h][i];
        for (int t = 0; t < nt; t += 2) {
            const bool last = (t == nt - 2);
            const size_t ka1 = kc + (size_t)(t + 1) * kstep;
            const size_t ka2 = last ? kn : kc + (size_t)(t + 2) * kstep;
            const char* b2 = last ? nB : cB + (size_t)(t + 2) * kstep; const char* b3 = b2 + kstep;
            PG8_LDB(B0, 0, 0); PG8_LDB(B1, 0, 1); PG8_SCHED; PG8_LDA(At, 0, 0); PG8_STAGE_A(PG8_SA(1, 1), ka1, 1);
            if (last) {
#pragma unroll
                for (int h = 0; h < 2; ++h)
#pragma unroll
                    for (int i = 0; i < 2; ++i) vC[h][i] = vN[h][i];
            }
            PG8_WAIT_V(8); PG8_WAIT_L(0); PG8_BAR; PG8_MMA(0, 0, At, B0); PG8_MMA(0, 1, At, B1); PG8_BAR; PG8_SCHED;
            PG8_LDA(At, 0, 1); PG8_STAGE_B(PG8_SB(0, 0), b2); PG8_STAGE_B(PG8_SB(0, 1), b2 + hstep); PG8_STAGE_A(PG8_SA(0, 0), ka2, 0);
            PG8_WAIT_V(8); PG8_WAIT_L(0); PG8_BAR; PG8_MMA(1, 0, At, B0); PG8_MMA(1, 1, At, B1); PG8_BAR; PG8_SCHED;
            PG8_LDB(B0, 1, 0); PG8_LDB(B1, 1, 1); PG8_SCHED; PG8_LDA(At, 1, 0); PG8_STAGE_A(PG8_SA(0, 1), ka2, 1);
            PG8_WAIT_V(8); PG8_WAIT_L(0); PG8_BAR; PG8_MMA(0, 0, At, B0); PG8_MMA(0, 1, At, B1); PG8_BAR; PG8_SCHED;
            PG8_LDA(At, 1, 1); PG8_STAGE_B(PG8_SB(1, 0), b3); PG8_STAGE_B(PG8_SB(1, 1), b3 + hstep); PG8_STAGE_A(PG8_SA(1, 0), ka2 + kstep, 0);
            PG8_WAIT_V(8); PG8_WAIT_L(0); PG8_BAR; PG8_MMA(1, 0, At, B0); PG8_MMA(1, 1, At, B1); PG8_BAR; PG8_SCHED;
        }
        if (wr == 0) PG8_BAR;
        E(acc, cur, wr, wc, fr, fq);
        if (!has_next) break;
#pragma unroll
        for (int a = 0; a < 2; ++a)
#pragma unroll
            for (int b = 0; b < 2; ++b)
#pragma unroll
                for (int m = 0; m < 4; ++m)
#pragma unroll
                    for (int n = 0; n < 2; ++n) acc[a][b][m][n] = (f32x4){0.f, 0.f, 0.f, 0.f};
        cur = nxt; cB = nB; kc = kn; nt = cur.nkt; ++ui;
        if (wr == 1) PG8_BAR;
    }
    PG8_WAIT_V(0);
    PG8_BAR;
#undef PG8_SA
#undef PG8_SB
#undef PG8_STAGE_A
#undef PG8_STAGE_B
#undef PG8_LDA
#undef PG8_LDB
#undef PG8_MMA
#undef PG8_WAIT_V
#undef PG8_WAIT_L
#undef PG8_BAR
#undef PG8_SCHED
}

typedef const f32x4 (&AccRef)[2][2][4][2];

struct EpiInProj {
    static constexpr bool PERM = true;
    bf16* UV; unsigned char* Q8; unsigned char* K8; unsigned char* VT8; bf16* SA; bf16* SB; const float* cosT; const float* sinT; int pn_off;
    __device__ __forceinline__ void operator()(AccRef acc, const Unit& u, int wr, int wc, int fr, int fq) const {
        asm volatile("" : "+v"(fr), "+v"(fq));
        const int pn = u.pn + pn_off, rbase = u.pm * BM + wr * 64 + fr, cl = wc * 32 + 8 * fq;
        if (pn < 8) {
#pragma unroll
            for (int ai = 0; ai < 2; ++ai)
#pragma unroll
                for (int m = 0; m < 4; ++m) { bf16* rp = UV + (size_t)(rbase + ai * HALF + m * 16) * D + pn * BM + cl;
#pragma unroll
                    for (int bj = 0; bj < 2; ++bj) { const f32x4 a = acc[ai][bj][m][0], b = acc[ai][bj][m][1];
                        v4u w; w.x = cvt_pk_bf16(gelu_tanh(a[0]), gelu_tanh(a[1])); w.y = cvt_pk_bf16(gelu_tanh(a[2]), gelu_tanh(a[3]));
                        w.z = cvt_pk_bf16(gelu_tanh(b[0]), gelu_tanh(b[1])); w.w = cvt_pk_bf16(gelu_tanh(b[2]), gelu_tanh(b[3]));
                        *(v4u*)(rp + bj * HALF) = w; } }
        } else if (pn < 24) {
            unsigned char* dst = (pn < 16) ? Q8 : K8; const int hp = ((pn - 8) & 7) * 2, j0 = cl >> 1;
#pragma unroll
            for (int ai = 0; ai < 2; ++ai)
#pragma unroll
                for (int m = 0; m < 4; ++m) { const int row = rbase + ai * HALF + m * 16, b = row >> 12, s = row & 4095;
                    const f32x4 c4 = *(const f32x4*)(cosT + (size_t)row * 64 + j0), s4 = *(const f32x4*)(sinT + (size_t)row * 64 + j0);
#pragma unroll
                    for (int bj = 0; bj < 2; ++bj) { const f32x4 x0 = acc[ai][bj][m][0], x1 = acc[ai][bj][m][1];
                        v2u w;
                        w.x = pk_fp8x4(x0[0] * c4[0] - x0[1] * s4[0], x0[1] * c4[0] + x0[0] * s4[0], x0[2] * c4[1] - x0[3] * s4[1], x0[3] * c4[1] + x0[2] * s4[1]);
                        w.y = pk_fp8x4(x1[0] * c4[2] - x1[1] * s4[2], x1[1] * c4[2] + x1[0] * s4[2], x1[2] * c4[3] - x1[3] * s4[3], x1[3] * c4[3] + x1[2] * s4[3]);
                        *(v2u*)(dst + ((size_t)(b * NHEAD + hp + bj) * SEQ + s) * HD + cl) = w; } }
        } else if (pn < 32) {
            const int hp = (pn - 24) * 2, lane = fr + 16 * fq, qbase = lane & ~3, jq = lane & 3;
#pragma unroll
            for (int ai = 0; ai < 2; ++ai)
#pragma unroll
                for (int m = 0; m < 4; ++m) { const int row = rbase + ai * HALF + m * 16, b = row >> 12, s0 = (row & 4095) & ~3;
#pragma unroll
                    for (int bj = 0; bj < 2; ++bj) { const f32x4 a = acc[ai][bj][m][0], c = acc[ai][bj][m][1];
                        const unsigned w0 = pk_fp8x4(a[0], a[1], a[2], a[3]), w1 = pk_fp8x4(c[0], c[1], c[2], c[3]);
                        unsigned o0 = 0u, o1 = 0u;
#pragma unroll
                        for (int q = 0; q < 4; ++q) { const unsigned t0 = (unsigned)__shfl((int)w0, qbase + q), t1 = (unsigned)__shfl((int)w1, qbase + q);
                            o0 |= ((t0 >> (8 * jq)) & 0xffu) << (8 * q); o1 |= ((t1 >> (8 * jq)) & 0xffu) << (8 * q); }
                        unsigned char* vp = VT8 + ((size_t)(b * NHEAD + hp + bj) * HD + cl + jq) * SEQ + s0;
                        *(unsigned*)vp = o0; *(unsigned*)(vp + 4 * SEQ) = o1; } }
        } else {
            bf16* dst = (pn < 40) ? SA : SB; const int colt = ((pn - 32) & 7) * BM;
#pragma unroll
            for (int ai = 0; ai < 2; ++ai)
#pragma unroll
                for (int m = 0; m < 4; ++m) { bf16* rp = dst + (size_t)(rbase + ai * HALF + m * 16) * D + colt + cl;
#pragma unroll
                    for (int bj = 0; bj < 2; ++bj) { const f32x4 a = acc[ai][bj][m][0], b = acc[ai][bj][m][1];
                        v4u w; w.x = cvt_pk_bf16(fast_sigmoid(a[0]), fast_sigmoid(a[1])); w.y = cvt_pk_bf16(fast_sigmoid(a[2]), fast_sigmoid(a[3]));
                        w.z = cvt_pk_bf16(fast_sigmoid(b[0]), fast_sigmoid(b[1])); w.w = cvt_pk_bf16(fast_sigmoid(b[2]), fast_sigmoid(b[3]));
                        *(v4u*)(rp + bj * HALF) = w; } }
        }
    }
};
struct EpiGateSeg {
    static constexpr bool PERM = true;
    const bf16* SAg; const bf16* SBg; bf16* T1; unsigned char* Mg; int seg;
    __device__ __forceinline__ void operator()(AccRef acc, const Unit& u, int wr, int wc, int fr, int fq) const {
        const int rbase = u.pm * BM + wr * 64 + fr, col0 = u.pn * BM + wc * 32 + 8 * fq;
        if (seg == 0) {
#pragma unroll
            for (int ai = 0; ai < 2; ++ai) {
                v4u g[4][2];
#pragma unroll
                for (int m = 0; m < 4; ++m)
#pragma unroll
                    for (int bj = 0; bj < 2; ++bj) g[m][bj] = *(const v4u*)(SAg + (size_t)(rbase + ai * HALF + m * 16) * D + col0 + bj * HALF);
#pragma unroll
                for (int m = 0; m < 4; ++m) { const size_t off = (size_t)(rbase + ai * HALF + m * 16) * D + col0;
#pragma unroll
                    for (int bj = 0; bj < 2; ++bj) { const v4u gg = g[m][bj]; const f32x4 a = acc[ai][bj][m][0], b = acc[ai][bj][m][1];
                        v4u w; w.x = cvt_pk_bf16(bflo(gg.x) * a[0], bfhi(gg.x) * a[1]); w.y = cvt_pk_bf16(bflo(gg.y) * a[2], bfhi(gg.y) * a[3]);
                        w.z = cvt_pk_bf16(bflo(gg.z) * b[0], bfhi(gg.z) * b[1]); w.w = cvt_pk_bf16(bflo(gg.w) * b[2], bfhi(gg.w) * b[3]);
                        *(v4u*)(T1 + off + bj * HALF) = w; } }
            }
        } else {
#pragma unroll
            for (int ai = 0; ai < 2; ++ai)
#pragma unroll
                for (int mp = 0; mp < 2; ++mp) {
                    v4u tt[2][2], g[2][2];
#pragma unroll
                    for (int mm = 0; mm < 2; ++mm)
#pragma unroll
                        for (int bj = 0; bj < 2; ++bj) { const size_t off = (size_t)(rbase + ai * HALF + (2 * mp + mm) * 16) * D + col0 + bj * HALF; tt[mm][bj] = *(const v4u*)(T1 + off); g[mm][bj] = *(const v4u*)(SBg + off); }
#pragma unroll
                    for (int mm = 0; mm < 2; ++mm) { const int m = 2 * mp + mm; const size_t off = (size_t)(rbase + ai * HALF + m * 16) * D + col0;
#pragma unroll
                        for (int bj = 0; bj < 2; ++bj) { const v4u t = tt[mm][bj], gg = g[mm][bj]; const f32x4 a = acc[ai][bj][m][0], b = acc[ai][bj][m][1];
                            constexpr float MS = (float)(1 << M8_SHIFT);
                            v2u w; w.x = pk_fp8x4((bflo(t.x) + bflo(gg.x) * a[0]) * MS, (bfhi(t.x) + bfhi(gg.x) * a[1]) * MS, (bflo(t.y) + bflo(gg.y) * a[2]) * MS, (bfhi(t.y) + bfhi(gg.y) * a[3]) * MS);
                            w.y = pk_fp8x4((bflo(t.z) + bflo(gg.z) * b[0]) * MS, (bfhi(t.z) + bfhi(gg.z) * b[1]) * MS, (bflo(t.w) + bflo(gg.w) * b[2]) * MS, (bfhi(t.w) + bfhi(gg.w) * b[3]) * MS);
                            *(v2u*)(Mg + off + bj * HALF) = w; } }
                }
        }
    }
};
struct EpiDelta {
    static constexpr bool PERM = true;
    const float* gm; bf16* Dl;
    __device__ __forceinline__ void operator()(AccRef acc, const Unit& u, int wr, int wc, int fr, int fq) const {
        const int rbase = u.pm * BM + wr * 64 + fr, col0 = u.pn * BM + wc * 32 + 8 * fq, b = (u.pm * BM) >> 12;
        f32x4 gv[2][2];
#pragma unroll
        for (int bj = 0; bj < 2; ++bj)
#pragma unroll
            for (int n = 0; n < 2; ++n) gv[bj][n] = *(const f32x4*)(gm + (size_t)b * 12288 + col0 + bj * HALF + 4 * n);
#pragma unroll
        for (int ai = 0; ai < 2; ++ai)
#pragma unroll
            for (int m = 0; m < 4; ++m) { bf16* rp = Dl + (size_t)(rbase + ai * HALF + m * 16) * D + col0;
#pragma unroll
                for (int bj = 0; bj < 2; ++bj) { const f32x4 a = acc[ai][bj][m][0] * gv[bj][0], c = acc[ai][bj][m][1] * gv[bj][1];
                    v4u w; w.x = cvt_pk_bf16(a[0], a[1]); w.y = cvt_pk_bf16(a[2], a[3]); w.z = cvt_pk_bf16(c[0], c[1]); w.w = cvt_pk_bf16(c[2], c[3]);
                    *(v4u*)(rp + bj * HALF) = w; } }
    }
};
struct MoeSched {
    const LAS int* bstart; const LAS int* cntl; const int* list; int npn, total, G, c, nkt; const char* Bt; size_t estride, tstepB; bool gather;
    __device__ __forceinline__ bool next(int i, Unit& u) const {
        const int L = i * G + c; if (L >= total) return false;
        const int rb = L / npn; int e = 0;
        for (int j = 1; j < NEXP; ++j) e += (bstart[j] <= rb) ? 1 : 0;
        u.pm = rb; u.pn = L - rb * npn; u.ex = e; u.kt0 = 0; u.nkt = nkt; return true;
    }
    __device__ __forceinline__ const char* b_ptr(const Unit& u) const { return Bt + (size_t)u.ex * estride + (size_t)u.pn * tstepB; }
    __device__ __forceinline__ unsigned a_row(const Unit& u, int r) const {
        if (!gather) return (unsigned)(u.pm * BM + r);
        const int pos = (u.pm - bstart[u.ex]) * BM + r;
        return (pos < cntl[u.ex]) ? (unsigned)list[u.ex * LCAP + pos] : 0u;
    }
};
struct EpiSwiGLU {
    static constexpr bool PERM = true;
    unsigned char* HID;
    __device__ __forceinline__ void operator()(AccRef acc, const Unit& u, int wr, int wc, int fr, int fq) const {
        const int rbase = u.pm * BM + wr * 64 + fr, hc0 = u.pn * 128 + wc * 16 + 4 * fq;
#pragma unroll
        for (int ai = 0; ai < 2; ++ai)
#pragma unroll
            for (int m = 0; m < 4; ++m) { unsigned char* rp = HID + (size_t)(rbase + ai * HALF + m * 16) * DFF + hc0;
#pragma unroll
                for (int bj = 0; bj < 2; ++bj) { const f32x4 g = acc[ai][bj][m][0], up = acc[ai][bj][m][1];
                    *(unsigned*)(rp + bj * 64) = pk_fp8x4(g[0] * fast_sigmoid(g[0]) * up[0], g[1] * fast_sigmoid(g[1]) * up[1], g[2] * fast_sigmoid(g[2]) * up[2], g[3] * fast_sigmoid(g[3]) * up[3]); } }
    }
};
struct EpiStoreBf16 {
    static constexpr bool PERM = true;
    bf16* Y;
    __device__ __forceinline__ void operator()(AccRef acc, const Unit& u, int wr, int wc, int fr, int fq) const {
        const int rbase = u.pm * BM + wr * 64 + fr, col0 = u.pn * BM + wc * 32 + 8 * fq;
#pragma unroll
        for (int ai = 0; ai < 2; ++ai)
#pragma unroll
            for (int m = 0; m < 4; ++m) { bf16* rp = Y + (size_t)(rbase + ai * HALF + m * 16) * D + col0;
#pragma unroll
                for (int bj = 0; bj < 2; ++bj) { const f32x4 a = acc[ai][bj][m][0], b = acc[ai][bj][m][1];
                    v4u w; w.x = cvt_pk_bf16(a[0], a[1]); w.y = cvt_pk_bf16(a[2], a[3]); w.z = cvt_pk_bf16(b[0], b[1]); w.w = cvt_pk_bf16(b[2], b[3]);
                    *(v4u*)(rp + bj * HALF) = w; } }
    }
};
}

namespace att {
constexpr int NW = 8, QBLK = 32, KVBLK = 64, QB = 256, OP = 2048;
constexpr int KPITCH = 144, VPITCH = 144;
constexpr int SHM_K = 2 * KVBLK * KPITCH, SHM_V = HD * VPITCH;
constexpr int LDS_BYTES = 2 * SHM_V + 2 * SHM_K + NW * 64 * 4;
constexpr float SCALE = 0.08838834764831845f, THR = 4.f;
constexpr int O8_SHIFT = 4;
constexpr int KM_SHIFT = 4;
#define SBAR() __builtin_amdgcn_sched_barrier(0)
typedef pg8::v8i v8i; typedef pg8::v4i v4i;
__device__ __forceinline__ v8i cat32(v4i a, v4i b) { return __builtin_shufflevector(a, b, 0, 1, 2, 3, 4, 5, 6, 7); }
__device__ __forceinline__ v4i ld16(const unsigned char* p) { return *reinterpret_cast<const v4i*>(p); }
__device__ __forceinline__ f32x16 mma8(v8i a, v8i b, f32x16 c) { return __builtin_amdgcn_mfma_scale_f32_32x32x64_f8f6f4(a, b, c, 0, 0, 0, 127, 0, 127); }
__device__ __forceinline__ int crow(int r, int hi) { return (r & 3) + 8 * (r >> 2) + 4 * hi; }
__device__ __forceinline__ void mask_tile(f32x16& p0, f32x16& p1, int dq) {
    const float NEG = -__builtin_inff();
#pragma unroll
    for (int r = 0; r < 16; ++r) {
        const int c = (r & 3) + 8 * (r >> 2);
        if (dq - c < 0) p0[r] = NEG;
        if (dq - c - 32 < 0) p1[r] = NEG;
    }
}
__device__ __forceinline__ void partialSM(f32x16& p0, f32x16& p1, float& m_reg, float& mn, float& alpha, bool keep) {
    float pmax = p0[0];
#pragma unroll
    for (int r = 1; r < 16; ++r) pmax = fmaxf(pmax, p0[r]);
#pragma unroll
    for (int r = 0; r < 16; ++r) pmax = fmaxf(pmax, p1[r]);
    { auto rr = __builtin_amdgcn_permlane32_swap(__float_as_uint(pmax), __float_as_uint(pmax), false, false);
      pmax = fmaxf(__uint_as_float(rr[0]), __uint_as_float(rr[1])); }
    const float NEG = -__builtin_inff();
    pmax = keep ? pmax : NEG;
    constexpr float C2 = 1.4426950408889634f * SCALE;
    if (__builtin_expect(__all((pmax - m_reg) * SCALE <= THR), 1)) { mn = m_reg; alpha = 1.f; }
    else { mn = fmaxf(m_reg, pmax); alpha = __builtin_amdgcn_exp2f((m_reg - mn) * C2); m_reg = mn; }
    const float c2l = keep ? C2 : 0.f;
    const float mnL = keep ? -mn * C2 : NEG;
#pragma unroll
    for (int r = 0; r < 16; ++r) p0[r] = fmaf(p0[r], c2l, mnL);
#pragma unroll
    for (int r = 0; r < 16; ++r) p1[r] = fmaf(p1[r], c2l, mnL);
#pragma unroll
    for (int r = 0; r < 16; ++r) p0[r] = __builtin_amdgcn_exp2f(p0[r]);
}
__device__ __forceinline__ void finishSM(f32x16& p0, f32x16& p1, float alpha, float& l_reg, v8i& pf) {
#pragma unroll
    for (int r = 0; r < 16; ++r) p1[r] = __builtin_amdgcn_exp2f(p1[r]);
    float ps = 0;
#pragma unroll
    for (int r = 0; r < 16; ++r) ps += p0[r];
#pragma unroll
    for (int r = 0; r < 16; ++r) ps += p1[r];
    { auto rr = __builtin_amdgcn_permlane32_swap(__float_as_uint(ps), __float_as_uint(ps), false, false);
      ps = __uint_as_float(rr[0]) + __uint_as_float(rr[1]); }
    l_reg = l_reg * alpha + ps;
#pragma unroll
    for (int q = 0; q < 4; ++q) { pf[q] = (int)pk_fp8x4(p0[4 * q], p0[4 * q + 1], p0[4 * q + 2], p0[4 * q + 3]); pf[4 + q] = (int)pk_fp8x4(p1[4 * q], p1[4 * q + 1], p1[4 * q + 2], p1[4 * q + 3]); }
}
template <int SUB>
__device__ __forceinline__ void qkt(int KB, f32x16& p0, f32x16& p1, const unsigned char* K_lds, int r32, int hi, const v8i* qf) {
    p0 = f32x16{}; p1 = f32x16{};
    const unsigned char* kb = K_lds + KB * SHM_K + (SUB * KVBLK + r32) * KPITCH + hi * 32;
#pragma unroll
    for (int ks = 0; ks < 2; ++ks) {
        const v8i a0 = cat32(ld16(kb + ks * 64), ld16(kb + ks * 64 + 16)), a1 = cat32(ld16(kb + 32 * KPITCH + ks * 64), ld16(kb + 32 * KPITCH + ks * 64 + 16));
        p0 = mma8(a0, qf[ks], p0); p1 = mma8(a1, qf[ks], p1); }
}
template <int SUB>
__device__ __forceinline__ void pv_tile(int VB, f32x16* o, const unsigned char* V_lds, int r32, int hi, v8i pf) {
    const unsigned char* vb = V_lds + VB * SHM_V + r32 * VPITCH + SUB * KVBLK + hi * 32;
#pragma unroll
    for (int d0 = 0; d0 < 4; ++d0) { const v8i a = cat32(ld16(vb + d0 * 32 * VPITCH), ld16(vb + d0 * 32 * VPITCH + 16)); o[d0] = mma8(a, pf, o[d0]); }
}
__device__ __forceinline__ unsigned moba_sel(const v8i* qf, const unsigned char* KM, int qb, int r32, int hi) {
    f32x16 g = f32x16{}; const unsigned char* kp = KM + (r32 & 15) * HD + hi * 32;
#pragma unroll
    for (int ks = 0; ks < 2; ++ks) g = mma8(cat32(ld16(kp + ks * 64), ld16(kp + ks * 64 + 16)), qf[ks], g);
    float v[16];
#pragma unroll
    for (int r = 0; r < 8; ++r) { const float mine = g[r], oth = __shfl_xor(mine, 32); const int base = (r & 3) + 8 * (r >> 2);
        v[base] = hi ? oth : mine; v[base + 4] = hi ? mine : oth; }
#pragma unroll
    for (int n = 0; n < 16; ++n) v[n] = (n < qb) ? v[n] : -1e30f;
    unsigned sel = 0u;
#pragma unroll
    for (int pass = 0; pass < 3; ++pass) {
        float best = v[0]; int bi = 0;
#pragma unroll
        for (int n = 1; n < 16; ++n) { const bool gt = v[n] > best; best = gt ? v[n] : best; bi = gt ? n : bi; }
        if (best > -1e29f) sel |= 1u << bi;
#pragma unroll
        for (int n = 0; n < 16; ++n) v[n] = (n == bi) ? -__builtin_inff() : v[n];
    }
    return sel;
}
struct BlockRef { const unsigned char* Q; const unsigned char* K; const unsigned char* V; unsigned char* O; const unsigned char* KM; int qb; };
struct Seam { v8i qf[2]; v4i st_k[2], st_v[2]; };
__device__ __forceinline__ BlockRef make_ref(unsigned char* ws, int vcu, int k) {
    const int x8 = vcu & 7, bh = (k < 2) ? (vcu >> 3) : 32 + (vcu >> 3), qb = (k & 1) ? 15 - x8 : x8, b = bh >> 4, h = bh & 15;
    BlockRef r; r.Q = ws + WS_Q8 + ((size_t)bh * SEQ + (size_t)qb * 256) * HD; r.K = ws + WS_K8 + (size_t)bh * SEQ * HD; r.V = ws + WS_VT8 + (size_t)bh * HD * SEQ;
    r.O = ws + WS_O8 + ((size_t)(b * SEQ + qb * 256)) * OP + h * HD; r.KM = ws + WS_KM + (size_t)bh * 16 * HD; r.qb = qb; return r;
}
#define VMW() asm volatile("s_waitcnt vmcnt(0)" ::: "memory")
#define VMWN(n) asm volatile("s_waitcnt vmcnt(%0)" :: "i"(n) : "memory")
#define SLOAD_H(Kp, Vp, k0) do { const unsigned char* kp_ = (Kp) + (size_t)(k0) * HD + klo; const unsigned char* vp_ = (Vp) + (size_t)(k0) + vlo; \
        S.st_k[0] = ld16(kp_); S.st_k[1] = ld16(kp_ + KVBLK * HD); S.st_v[0] = ld16(vp_); S.st_v[1] = ld16(vp_ + KVBLK); } while (0)
#define SWRITE_HK(bf) do { *(v4i*)(K_lds + (bf) * SHM_K + kws) = S.st_k[0]; *(v4i*)(K_lds + (bf) * SHM_K + kws + KVBLK * KPITCH) = S.st_k[1]; } while (0)
#define SWRITE_HV(bf) do { _Pragma("unroll") for (int i_ = 0; i_ < 2; ++i_) { unsigned char* vd_ = V_lds + (bf) * SHM_V + vws + i_ * KVBLK; \
        *(int*)(vd_) = S.st_v[i_][0]; *(int*)(vd_ + 32) = S.st_v[i_][1]; *(int*)(vd_ + 4) = S.st_v[i_][2]; *(int*)(vd_ + 36) = S.st_v[i_][3]; } } while (0)
#define SWRITE_H(bf) do { SWRITE_HV(bf); SWRITE_HK(bf); } while (0)
#define QLOAD(Qp) do { const unsigned char* qp_ = (Qp) + qoff; S.qf[0] = cat32(ld16(qp_), ld16(qp_ + 16)); S.qf[1] = cat32(ld16(qp_ + 64), ld16(qp_ + 80)); } while (0)
#define ATT_GEOM() const int wid = __builtin_amdgcn_readfirstlane(tid >> 6), lane = tid & 63, r32 = lane & 31, hi = lane >> 5; \
    const unsigned klo = (unsigned)((tid >> 3) * HD + (tid & 7) * 16), kws = (unsigned)((tid >> 3) * KPITCH + (tid & 7) * 16); \
    const unsigned vlo = (unsigned)((tid >> 2) * SEQ + (tid & 3) * 16), vws = (unsigned)((tid >> 2) * VPITCH + (tid & 3) * 8); \
    const unsigned qoff = (unsigned)((wid * QBLK + r32) * HD + hi * 32); \
    unsigned char* V_lds = (unsigned char*)lds; unsigned char* K_lds = (unsigned char*)lds + 2 * SHM_V
__device__ __forceinline__ void moba_prime(const BlockRef& cur, char* lds, Seam& S, const int tid) {
    ATT_GEOM(); (void)V_lds; (void)vws;
    QLOAD(cur.Q);
    SLOAD_H(cur.K, cur.V, 0); VMW(); SWRITE_HK(0);
    __syncthreads();
}
__device__ __forceinline__ void moba_block(const BlockRef& cur, const BlockRef& nxt, char* lds, Seam& S, const int tid) {
    ATT_GEOM();
    const int qb = cur.qb, NS = 2 * (qb + 1);
    const int qlo = qb * QB + wid * QBLK;
    unsigned* sel_l = (unsigned*)(lds + 2 * SHM_V + 2 * SHM_K) + wid * 64;
    { const unsigned sel0 = (qb > 0) ? moba_sel(S.qf, cur.KM, qb, r32, hi) : 0u; if (hi == 0) sel_l[r32] = sel0; }
    float m_reg = -1e30f, l_reg = 0; f32x16 o[4] = {};
    const unsigned char* Kh = cur.K; const unsigned char* Vh = cur.V;
#define RESC(a) do { if (__any((a) < 1.f)) { for (int d_ = 0; d_ < 4; ++d_) for (int r = 0; r < 16; ++r) o[d_][r] *= (a); } } while (0)
#define KBASE(t) ((t) * KVBLK)
#define KEEP(t) ((((t) >> 2) >= qb) || (((sel_l[r32] >> ((t) >> 2)) & 1u) != 0u))
#define MASKT(P0_, P1_, t) do { const int kb_ = KBASE(t); if (kb_ + KVBLK - 1 > qlo) mask_tile(P0_, P1_, qlo - kb_ + r32 - 4 * hi); } while (0)
    f32x16 pA0, pA1, pB0, pB1; float mnA, mnB, alA, alB; v8i pf;
#define STEP_A(T_, B_, LOADNEXT) do { SBAR(); qkt<0>(B_, pA0, pA1, K_lds, r32, hi, S.qf); finishSM(pB0, pB1, alB, l_reg, pf); SBAR(); \
        if (LOADNEXT) { SLOAD_H(Kh, Vh, KBASE(2 * (T_) + 2)); SBAR(); } \
        pv_tile<1>(1 - (B_), o, V_lds, r32, hi, pf); MASKT(pA0, pA1, 2 * (T_)); partialSM(pA0, pA1, m_reg, mnA, alA, KEEP(2 * (T_))); RESC(alA); } while (0)
#define STEP_B(T_, B_, WRITENEXT) do { SBAR(); qkt<1>(B_, pB0, pB1, K_lds, r32, hi, S.qf); finishSM(pA0, pA1, alA, l_reg, pf); SBAR(); \
        pv_tile<0>(B_, o, V_lds, r32, hi, pf); MASKT(pB0, pB1, 2 * (T_) + 1); partialSM(pB0, pB1, m_reg, mnB, alB, KEEP(2 * (T_) + 1)); \
        if (WRITENEXT) { __syncthreads(); VMW(); SWRITE_H(1 - (B_)); RESC(alB); __syncthreads(); } else { RESC(alB); } } while (0)
    SWRITE_HV(0); SBAR();
    SLOAD_H(Kh, Vh, KBASE(2));
    SBAR(); qkt<0>(0, pA0, pA1, K_lds, r32, hi, S.qf);
    MASKT(pA0, pA1, 0); partialSM(pA0, pA1, m_reg, mnA, alA, KEEP(0));
    __syncthreads();
    STEP_B(0, 0, true);
    for (int T_ = 1; T_ + 1 < NS; ++T_) { const int bsel = T_ & 1; STEP_A(T_, bsel, true); STEP_B(T_, bsel, true); }
    STEP_A(NS - 1, 1, false);
    SBAR(); qkt<1>(1, pB0, pB1, K_lds, r32, hi, S.qf); SBAR();
    SLOAD_H(nxt.K, nxt.V, 0); SBAR();
    QLOAD(nxt.Q);
    SBAR();
    finishSM(pA0, pA1, alA, l_reg, pf); SBAR();
    pv_tile<0>(1, o, V_lds, r32, hi, pf);
    MASKT(pB0, pB1, 2 * NS - 1); partialSM(pB0, pB1, m_reg, mnB, alB, true); RESC(alB);
    finishSM(pB0, pB1, alB, l_reg, pf); SBAR(); pv_tile<1>(1, o, V_lds, r32, hi, pf);
    SBAR(); VMWN(4); SWRITE_HK(0); SBAR();
    { const float rl = __builtin_amdgcn_rcpf(l_reg) * (float)(1 << O8_SHIFT);
      int r32e = r32, hie = hi; asm volatile("" : "+v"(r32e), "+v"(hie));
      unsigned char* Ow = cur.O + (size_t)(wid * QBLK + r32e) * OP + 4 * hie;
#pragma unroll
      for (int d0 = 0; d0 < 4; ++d0)
#pragma unroll
          for (int g4 = 0; g4 < 4; ++g4) *(unsigned*)(Ow + d0 * 32 + 8 * g4) = pk_fp8x4(o[d0][4 * g4] * rl, o[d0][4 * g4 + 1] * rl, o[d0][4 * g4 + 2] * rl, o[d0][4 * g4 + 3] * rl); }
    __syncthreads();
#undef RESC
#undef KBASE
#undef KEEP
#undef MASKT
#undef STEP_A
#undef STEP_B
}
#undef VMW
#undef VMWN
#undef SLOAD_H
#undef SWRITE_HK
#undef SWRITE_HV
#undef SWRITE_H
#undef QLOAD
#undef ATT_GEOM
}

struct Args { const float* in[23]; float* out; unsigned char* ws; };
typedef const __attribute__((address_space(4))) Args* ArgsP;
__device__ __forceinline__ int ltid(int wave0) { int l; asm volatile("v_mbcnt_lo_u32_b32 %0, -1, 0\n\tv_mbcnt_hi_u32_b32 %0, -1, %0" : "=v"(l)); return (wave0 << 6) | l; }
__device__ __forceinline__ ArgsP kargs() { ArgsP p = (ArgsP)__builtin_amdgcn_kernarg_segment_ptr(); asm volatile("" : "+s"(p)); return p; }
#define WSP(T_, off) ((T_*)(ws + (off)))

struct ConvUnit { const float* W; void* WT; int ldw, ldt, k0, n0, kind, add; };
__device__ __forceinline__ int conv_row(const ConvUnit& c, int n) {
    if (c.kind == 2) { if (n >= 6144) return n - 2048; const int p = n & 127; return (n & ~127) + 2 * (p & 63) + (p >> 6) - 2048; }
    if (c.kind == 3) return (n >> 2) * 8 + (n & 3) + c.add;
    return n;
}
constexpr int CBUF = 65536, OP8 = 144, OP16 = 272;
__device__ __forceinline__ void conv_dma(const ConvUnit& c, int wave, int lane, LAS unsigned char* buf) {
    const float* Wl = c.W + (size_t)(c.k0 + 16 * wave + (lane >> 5)) * c.ldw + c.n0 + 4 * (lane & 31);
#pragma unroll
    for (int i = 0; i < 8; ++i) __builtin_amdgcn_global_load_lds((const unsigned*)(Wl + (size_t)(2 * i) * c.ldw), (LAS unsigned*)(buf + (16 * wave + 2 * i) * 512), 16, 0, 0);
}
__device__ __forceinline__ void conv_read(int wave, int lane, const LAS unsigned char* buf, float (&f)[32]) {
    const LAS float* p = (const LAS float*)(buf + (16 * wave) * 512 + 4 * lane);
#pragma unroll
    for (int i = 0; i < 16; ++i) { f[i] = p[i * 128]; f[16 + i] = p[i * 128 + 64]; }
}
__device__ __forceinline__ void conv_park8(int wave, int lane, LAS unsigned char* img, const float (&f)[32]) {
    constexpr float SC = (float)(1 << pg8::W8_SHIFT);
#pragma unroll
    for (int h = 0; h < 2; ++h) { v4u o; o.x = pk_fp8x4(f[16 * h] * SC, f[16 * h + 1] * SC, f[16 * h + 2] * SC, f[16 * h + 3] * SC); o.y = pk_fp8x4(f[16 * h + 4] * SC, f[16 * h + 5] * SC, f[16 * h + 6] * SC, f[16 * h + 7] * SC);
        o.z = pk_fp8x4(f[16 * h + 8] * SC, f[16 * h + 9] * SC, f[16 * h + 10] * SC, f[16 * h + 11] * SC); o.w = pk_fp8x4(f[16 * h + 12] * SC, f[16 * h + 13] * SC, f[16 * h + 14] * SC, f[16 * h + 15] * SC);
        *(LAS v4u*)(img + (lane + 64 * h) * OP8 + 16 * wave) = o; }
}
__device__ __forceinline__ void conv_out8(const ConvUnit& c, int tid, const LAS unsigned char* img) {
#pragma unroll
    for (int j = 0; j < 2; ++j) { const int row = (tid >> 3) + 64 * j, ch = tid & 7; const v4u v = *(const LAS v4u*)(img + row * OP8 + 16 * ch);
        *(v4u*)((unsigned char*)c.WT + (size_t)conv_row(c, c.n0 + row) * c.ldt + c.k0 + 16 * ch) = v; }
}
__device__ __forceinline__ void conv_park16(int wave, int lane, LAS unsigned char* img, const float (&f)[32], const int h) {
    v4u o0, o1; o0.x = pk2(f[16 * h], f[16 * h + 1]); o0.y = pk2(f[16 * h + 2], f[16 * h + 3]); o0.z = pk2(f[16 * h + 4], f[16 * h + 5]); o0.w = pk2(f[16 * h + 6], f[16 * h + 7]);
    o1.x = pk2(f[16 * h + 8], f[16 * h + 9]); o1.y = pk2(f[16 * h + 10], f[16 * h + 11]); o1.z = pk2(f[16 * h + 12], f[16 * h + 13]); o1.w = pk2(f[16 * h + 14], f[16 * h + 15]);
    LAS unsigned char* q = img + lane * OP16 + 32 * wave; *(LAS v4u*)q = o0; *(LAS v4u*)(q + 16) = o1;
}
__device__ __forceinline__ void conv_out16(const ConvUnit& c, int tid, const LAS unsigned char* img, const int h) {
#pragma unroll
    for (int j = 0; j < 2; ++j) { const int row = (tid >> 4) + 32 * j, ch = tid & 15; const v4u v = *(const LAS v4u*)(img + row * OP16 + 16 * ch);
        *(v4u*)((bf16*)c.WT + (size_t)conv_row(c, c.n0 + 64 * h + row) * c.ldt + c.k0 + 8 * ch) = v; }
}
constexpr int NCONV = 8320;
__device__ __forceinline__ ConvUnit conv_decode(int u, ArgsP A, unsigned char* ws) {
    ConvUnit c; c.add = 0;
    if (u < 1536) { const int kp = u / 96, g = u - kp * 96; c.W = A->in[6]; c.ldw = INC; c.k0 = kp * 128; c.n0 = g * 128; c.ldt = D;
        if (g < 16) { c.WT = ws + WS_WINZ; c.kind = 0; } else { c.WT = ws + WS_WIN8; c.kind = 2; } return c; }
    u -= 1536;
    if (u < 128) { c.W = A->in[11]; c.ldw = D; c.k0 = (u >> 4) * 128; c.n0 = (u & 15) * 128; c.WT = ws + WS_WSO; c.ldt = SGW; c.kind = 0; return c; }
    u -= 128;
    if (u < 256) { c.W = A->in[12]; c.ldw = D; c.k0 = (u >> 4) * 128; c.n0 = (u & 15) * 128; c.WT = ws + WS_WMO8; c.ldt = D; c.kind = 1; return c; }
    u -= 256;
    if (u < 256) { c.W = A->in[13]; c.ldw = D; c.k0 = (u >> 4) * 128; c.n0 = (u & 15) * 128; c.WT = ws + WS_WOUT; c.ldt = D; c.kind = 1; return c; }
    u -= 256;
    const int m = u >> 11, r = u & 2047, e = r >> 6, q = r & 63;
    if (m < 2) { c.W = A->in[19 + m] + (size_t)e * D * DFF; c.ldw = DFF; c.k0 = (q >> 2) * 128; c.n0 = (q & 3) * 128; c.WT = ws + WS_WGU8 + (size_t)e * 1024 * D; c.ldt = D; c.kind = 3; c.add = 4 * m; return c; }
    c.W = A->in[21] + (size_t)e * DFF * D; c.ldw = D; c.k0 = (q >> 4) * 128; c.n0 = (q & 15) * 128; c.WT = ws + WS_WD8 + (size_t)e * D * DFF; c.ldt = DFF; c.kind = 1; return c;
}
constexpr int NCONV_EARLY = 1536;
__device__ __forceinline__ void conv_run(LAS unsigned char* lds, const int tid, const int wave, const int lane, int u, const int uend) {
    float f[32];
    LAS unsigned char* b0 = lds; LAS unsigned char* b1 = lds + CBUF; LAS unsigned char* img = lds + TAB_OFF;
#define CONV_CLAMP(x) ((x) < uend ? (x) : uend - 1)
#define CONV_BAR() do { asm volatile("s_waitcnt lgkmcnt(0)" ::: "memory"); __builtin_amdgcn_s_barrier(); asm volatile("" ::: "memory"); } while (0)
#define CONV_STEP(N, buf) do { \
        asm volatile("s_waitcnt vmcnt(" #N ")" ::: "memory"); __builtin_amdgcn_s_barrier(); asm volatile("" ::: "memory"); \
        conv_read(wave, lane, buf, f); CONV_BAR(); \
        { ArgsP Ai = kargs(); const ConvUnit cn = conv_decode(CONV_CLAMP(u + 512), Ai, Ai->ws); conv_dma(cn, wave, lane, buf); } \
        { ArgsP Ai = kargs(); const ConvUnit c = conv_decode(u, Ai, Ai->ws); \
          if (c.kind != 0) { conv_park8(wave, lane, img, f); CONV_BAR(); conv_out8(c, tid, img); } \
          else { conv_park16(wave, lane, img, f, 0); CONV_BAR(); conv_out16(c, tid, img, 0); CONV_BAR(); conv_park16(wave, lane, img, f, 1); CONV_BAR(); conv_out16(c, tid, img, 1); } } \
        u += 256; } while (0)
    { ArgsP Ai = kargs(); const ConvUnit c = conv_decode(u, Ai, Ai->ws); conv_dma(c, wave, lane, b0); }
    { ArgsP Ai = kargs(); const ConvUnit c = conv_decode(CONV_CLAMP(u + 256), Ai, Ai->ws); conv_dma(c, wave, lane, b1); }
    CONV_STEP(8, b0);
    if (u < uend) { CONV_STEP(10, b1);
        for (;;) {
            if (u >= uend) break; CONV_STEP(12, b0);
            if (u >= uend) break; CONV_STEP(12, b1);
        } }
    asm volatile("s_waitcnt vmcnt(0)" ::: "memory");
    __builtin_amdgcn_s_barrier();
#undef CONV_STEP
#undef CONV_BAR
#undef CONV_CLAMP
}

__global__ void __launch_bounds__(NWAVES * 64, 2) fwd_kernel(Args args) {
    extern __shared__ __attribute__((aligned(16))) unsigned char lds_raw[];
    LAS unsigned char* lds = (LAS unsigned char*)lds_raw;
    const int wave0 = __builtin_amdgcn_readfirstlane((int)threadIdx.x >> 6);
    constexpr int G = 256;
#define BX ((int)blockIdx.x)
#define VCU (((int)blockIdx.x & 7) * 32 + ((int)blockIdx.x >> 3))
    volatile LAS unsigned* MISC = (volatile LAS unsigned*)(lds + MISC_OFF);
    for (int u = ltid(wave0); u < (LDS_BYTES - LDSCTL_OFF) / 4; u += NWAVES * 64) ((LAS unsigned*)(lds + LDSCTL_OFF))[u] = 0u;
    __syncthreads();
    (void)xcd_barrier_post((unsigned*)(args.ws + WS_CTL) + CW_BAR, MISC + 8, ltid(wave0));
#define GRID_BAR() do { XcdBarrier b_; b_.bar = (unsigned*)(kargs()->ws + WS_CTL) + CW_BAR; b_.x = xb_xcc_id(); b_.st = (volatile LAS unsigned*)(lds + MISC_OFF) + 8; xcd_barrier(b_, ltid(wave0)); } while (0)

    DUPLOOP(0) {
    {
        ArgsP A = kargs(); unsigned char* ws = A->ws; const int tid = ltid(wave0), lane = tid & 63, wave = __builtin_amdgcn_readfirstlane(tid >> 6); (void)lane; (void)wave; gu32* ctl = (gu32*)(ws + WS_CTL);
        const float* cin = A->in[1];
        LAS float* cact = (LAS float*)(lds + 98304);
        for (int i = tid; i < BATCH * D; i += NWAVES * 64) { const float v = cin[i]; cact[i] = v / (1.0f + __expf(-v)); }
        __syncthreads();
        { const int it = (wave < 6) ? VCU * 6 + wave : 1536 + VCU * 2 + (wave - 6); ArgsP Ai = kargs(); unsigned char* wsi = Ai->ws;
            if (it < 1536) {
                const int qd = it / 384, col = (it - qd * 384) * 32 + 4 * (lane & 7), rq = lane >> 3;
                f32x4 a0 = {0.f, 0.f, 0.f, 0.f}, a1 = a0, a2 = a0, a3 = a0;
                for (int k0 = qd * 512; k0 < qd * 512 + 512; k0 += 256) {
                    f32x4 w[32];
#pragma unroll
                    for (int i = 0; i < 32; ++i) w[i] = *(const f32x4*)(Ai->in[3] + (size_t)(k0 + rq + 8 * i) * 12288 + col);
#pragma unroll
                    for (int i = 0; i < 32; ++i) { const int k = k0 + rq + 8 * i;
                        a0 += cact[k] * w[i]; a1 += cact[D + k] * w[i]; a2 += cact[2 * D + k] * w[i]; a3 += cact[3 * D + k] * w[i]; }
                }
#pragma unroll
                for (int e = 0; e < 4; ++e)
#pragma unroll
                    for (int o = 8; o < 64; o <<= 1) { a0[e] += __shfl_xor(a0[e], o); a1[e] += __shfl_xor(a1[e], o); a2[e] += __shfl_xor(a2[e], o); a3[e] += __shfl_xor(a3[e], o); }
                if (rq == 0) { const f32x4 bb = (qd == 0) ? *(const f32x4*)(Ai->in[4] + col) : (f32x4){0.f, 0.f, 0.f, 0.f}; float* ap = ((float*)(wsi + WS_ADAP)) + (size_t)qd * 49152 + col;
                    *(f32x4*)(ap) = a0 + bb; *(f32x4*)(ap + 12288) = a1 + bb; *(f32x4*)(ap + 2 * 12288) = a2 + bb; *(f32x4*)(ap + 3 * 12288) = a3 + bb; }
            } else if (it < 1792) {
                const int tok = (it - 1536) * 64 + lane; const double pos = (double)((const int*)Ai->in[2])[tok];
                float* cosT = (float*)(wsi + WS_COS); float* sinT = (float*)(wsi + WS_SIN);
                double inv = 1.0;
                for (int j = 0; j < 64; ++j) {
                    const double rev = pos * inv * 0.15915494309189535;
                    const float fr = (float)(rev - __builtin_floor(rev));
                    cosT[(size_t)tok * 64 + j] = __builtin_amdgcn_cosf(fr); sinT[(size_t)tok * 64 + j] = __builtin_amdgcn_sinf(fr);
                    inv *= 0.8659643233600653;
                }
            } else if (it < 1824) {
                const int g = (it - 1792) >> 2, part = (it - 1792) & 3; bf16* WSb = (bf16*)(wsi + WS_WS);
                for (int i = part * 4096 + lane; i < part * 4096 + 4096; i += 64) { const int r = i >> 7, c = i & 127; WSb[g * 16384 + i] = (c <= r) ? (bf16)f2bf(Ai->in[9][g * 16384 + i]) : (bf16)0; }
            } else if (it < 2016) {
                const int q = it - 1824, u = q & 7, n0 = (q >> 3) * 2; bf16* RT = (bf16*)(wsi + WS_RT);
#pragma unroll
                for (int nn = 0; nn < 2; ++nn) { const int n = n0 + nn;
#pragma unroll
                    for (int i = 0; i < 4; ++i) { const int k = u * 256 + lane + 64 * i; const float w = (n < 4) ? Ai->in[15][k * 4 + n] : (n < 36) ? Ai->in[17][k * 32 + (n - 4)] : 0.f;
                        const unsigned hi = f2bf(w); const int ks = k >> 5, kk = k & 31; RT[((ks * 2) * 48 + n) * 32 + kk] = (bf16)hi; RT[((ks * 2 + 1) * 48 + n) * 32 + kk] = (bf16)f2bf(w - __builtin_bit_cast(float, hi << 16)); } }
            }
        }
        __syncthreads();
        conv_run(lds, tid, wave, lane, VCU, NCONV_EARLY);
    }
    GRID_BAR();
    }

    DUPLOOP(1) {
    {
        ArgsP A = kargs(); unsigned char* ws = A->ws; const int tid = ltid(wave0), lane = tid & 63, wave = __builtin_amdgcn_readfirstlane(tid >> 6); (void)lane; (void)wave;
        const float* x = A->in[0]; const float* g_mix = A->in[5]; const float* adap = WSP(float, WS_ADAP); float* adaf = WSP(float, WS_ADA); bf16* Nb = WSP(bf16, WS_N); unsigned char* N8 = ws + WS_N1F8;
        LAS float* tg = (LAS float*)(lds); LAS float* tb = (LAS float*)(lds + 8192);
        const int row0 = VCU * 64, b = row0 >> 12;
        for (int i = tid; i < D; i += NWAVES * 64) { const float* ap = adap + b * 12288 + i;
            tg[i] = g_mix[i] * (1.0f + ((ap[2048] + ap[49152 + 2048]) + (ap[2 * 49152 + 2048] + ap[3 * 49152 + 2048]))); tb[i] = (ap[0] + ap[49152]) + (ap[2 * 49152] + ap[3 * 49152]); }
        if (tid < 192) { const int i = VCU * 192 + tid; adaf[i] = (adap[i] + adap[49152 + i]) + (adap[2 * 49152 + i] + adap[3 * 49152 + i]); }
        __syncthreads();
        for (int rq = 0; rq < 2; ++rq) {
            f32x4 v[4][8];
#pragma unroll
            for (int q = 0; q < 4; ++q) { const f32x4* xr = (const f32x4*)(x + (size_t)(row0 + wave * 8 + rq * 4 + q) * D) + lane;
#pragma unroll
                for (int j = 0; j < 8; ++j) v[q][j] = xr[64 * j]; }
#pragma unroll
            for (int q = 0; q < 4; ++q) { const int row = row0 + wave * 8 + rq * 4 + q; float ss = 0.f;
#pragma unroll
                for (int j = 0; j < 8; ++j) ss += (v[q][j].x * v[q][j].x + v[q][j].y * v[q][j].y) + (v[q][j].z * v[q][j].z + v[q][j].w * v[q][j].w);
                const float rstd = rsqrtf(wave_sum(ss) * (1.f / D) + EPS);
                v2u* o8 = (v2u*)(Nb + (size_t)row * D) + lane;
#pragma unroll
                for (int j = 0; j < 8; ++j) { const f32x4 gg = *(const LAS f32x4*)(tg + 4 * lane + 256 * j), bb = *(const LAS f32x4*)(tb + 4 * lane + 256 * j);
                    const f32x4 y = v[q][j] * rstd * gg + bb; v2u w; w.x = cvt_pk_bf16(y.x, y.y); w.y = cvt_pk_bf16(y.z, y.w); o8[64 * j] = w;
                    *((unsigned*)(N8 + (size_t)row * D) + lane + 64 * j) = pk_fp8x4(y.x, y.y, y.z, y.w); } }
        }
    }
    GRID_BAR();
    }

    DUPLOOP(2) {
    {
        ArgsP A = kargs(); unsigned char* ws = A->ws; const int tid = ltid(wave0), lane = tid & 63, wave = __builtin_amdgcn_readfirstlane(tid >> 6); (void)lane; (void)wave;
        bf16* Nb = WSP(bf16, WS_N); bf16* UV = WSP(bf16, WS_UV); unsigned char* Qh = ws + WS_Q8; unsigned char* Kh = ws + WS_K8; unsigned char* Vh = ws + WS_VT8;
        bf16* SAg = WSP(bf16, WS_SA); bf16* SBg = WSP(bf16, WS_SB); const float* cosT = WSP(float, WS_COS); const float* sinT = WSP(float, WS_SIN);
        { pg8::StaticOrder S; S.init(T, 2048, D * 2, G, BX, ws + WS_WINZ);
          pg8::EpiInProj E{UV, Qh, Kh, Vh, SAg, SBg, cosT, sinT, 0};
          pg8::gemm_phase<false>(lds, (const char*)Nb, D * 2, S, E, tid); }
        { pg8::StaticOrder S; S.init(T, 10240, D, G, BX, ws + WS_WIN8);
          pg8::EpiInProj E{UV, Qh, Kh, Vh, SAg, SBg, cosT, sinT, 8};
          pg8::gemm_phase<true>(lds, (const char*)(ws + WS_N1F8), D, S, E, tid); }
    }
    GRID_BAR();
    }

    DUPLOOP(3) {
    {
        ArgsP A = kargs(); unsigned char* ws = A->ws; const int tid = ltid(wave0), lane = tid & 63, wave = __builtin_amdgcn_readfirstlane(tid >> 6); (void)lane; (void)wave;
        const float* sgu_ln_g = A->in[7]; const float* sgu_ln_b = A->in[8]; const float* sgu_b_s = A->in[10];
        const bf16* UV = WSP(bf16, WS_UV); const bf16* WSb = WSP(bf16, WS_WS); bf16* SGUO = WSP(bf16, WS_SGUO); const unsigned char* K8 = ws + WS_K8; unsigned char* KM = ws + WS_KM;
        constexpr int VP = 136;
        LAS bf16* vT = (LAS bf16*)lds; LAS f32x2* st = (LAS f32x2*)(lds + 2 * 128 * VP * 2); LAS float* kx = (LAS float*)(lds + 73728);
        { const int item = VCU * NWAVES + wave, blk = item >> 1, half = item & 1, c8 = (lane & 15) * 8, r0 = lane >> 4;
          const unsigned char* kp = K8 + ((size_t)blk * 256 + half * 128 + r0) * HD + c8;
          float sacc[8] = {0.f, 0.f, 0.f, 0.f, 0.f, 0.f, 0.f, 0.f};
          { v2u w[32];
#pragma unroll
              for (int u = 0; u < 32; ++u) w[u] = *(const v2u*)(kp + (size_t)(4 * u) * HD);
#pragma unroll
              for (int u = 0; u < 32; ++u) { const f32x2 a0 = __builtin_amdgcn_cvt_pk_f32_fp8((int)w[u].x, false), a1 = __builtin_amdgcn_cvt_pk_f32_fp8((int)w[u].x, true), a2 = __builtin_amdgcn_cvt_pk_f32_fp8((int)w[u].y, false), a3 = __builtin_amdgcn_cvt_pk_f32_fp8((int)w[u].y, true);
                  sacc[0] += a0.x; sacc[1] += a0.y; sacc[2] += a1.x; sacc[3] += a1.y; sacc[4] += a2.x; sacc[5] += a2.y; sacc[6] += a3.x; sacc[7] += a3.y; } }
#pragma unroll
          for (int e = 0; e < 8; ++e) { sacc[e] += __shfl_xor(sacc[e], 16); sacc[e] += __shfl_xor(sacc[e], 32); }
          LAS float* kxp = kx + (wave >> 1) * 128 + c8;
          if (half == 1 && lane < 16) {
#pragma unroll
              for (int e = 0; e < 8; ++e) kxp[e] = sacc[e]; }
          __syncthreads();
          if (half == 0 && lane < 16) {
#pragma unroll
              for (int e = 0; e < 8; ++e) sacc[e] = (sacc[e] + kxp[e]) * ((float)(1 << att::KM_SHIFT) / 256.f);
              v2u o; o.x = pk_fp8x4(sacc[0], sacc[1], sacc[2], sacc[3]); o.y = pk_fp8x4(sacc[4], sacc[5], sacc[6], sacc[7]);
              *(v2u*)(KM + (size_t)blk * HD + c8) = o; } }
        {
            const int ch = VCU >> 1, hf = VCU & 1, R0 = ch * 128;
            v4u aa[4][8];
#pragma unroll
            for (int it4 = 0; it4 < 4; ++it4) { const v4u* vp = (const v4u*)(UV + (size_t)(R0 + wave * 16 + it4 * 4 + (lane >> 4)) * D + SGW) + (lane & 15);
#pragma unroll
                for (int q = 0; q < 8; ++q) aa[it4][q] = vp[16 * q]; }
#pragma unroll
            for (int it4 = 0; it4 < 4; ++it4) { const int j = wave * 16 + it4 * 4 + (lane >> 4);
                const v4u (&a)[8] = aa[it4];
                float s = 0.f;
#pragma unroll
                for (int q = 0; q < 8; ++q) s += ((bflo(a[q].x) + bfhi(a[q].x)) + (bflo(a[q].y) + bfhi(a[q].y))) + ((bflo(a[q].z) + bfhi(a[q].z)) + (bflo(a[q].w) + bfhi(a[q].w)));
#pragma unroll
                for (int o = 1; o < 16; o <<= 1) s += __shfl_xor(s, o);
                const float mean = s * (1.f / SGW); float qv = 0.f;
#pragma unroll
                for (int q = 0; q < 8; ++q) { float d;
                    d = bflo(a[q].x) - mean; qv += d * d; d = bfhi(a[q].x) - mean; qv += d * d; d = bflo(a[q].y) - mean; qv += d * d; d = bfhi(a[q].y) - mean; qv += d * d;
                    d = bflo(a[q].z) - mean; qv += d * d; d = bfhi(a[q].z) - mean; qv += d * d; d = bflo(a[q].w) - mean; qv += d * d; d = bfhi(a[q].w) - mean; qv += d * d; }
#pragma unroll
                for (int o = 1; o < 16; o <<= 1) qv += __shfl_xor(qv, o);
                if ((lane & 15) == 0) st[j] = (f32x2){mean, rsqrtf(qv * (1.f / SGW) + EPS)};
            }
            __syncthreads();
            for (int ps = 0; ps < 2; ++ps) {
                const int gp = hf * 2 + ps;
                { const int j = lane + 64 * (wave & 1), cb = 64 * (wave >> 1); const f32x2 ms = st[j];
                  v4u a[8];
#pragma unroll
                  for (int cq = 0; cq < 8; ++cq) a[cq] = *(const v4u*)(UV + (size_t)(R0 + j) * D + SGW + gp * 256 + cb + 8 * cq);
#pragma unroll
                  for (int cq = 0; cq < 8; ++cq) { const int c0 = cb + 8 * cq, chn = gp * 256 + c0;
                      const f32x4 g0 = *(const f32x4*)(sgu_ln_g + chn), g1 = *(const f32x4*)(sgu_ln_g + chn + 4), b0 = *(const f32x4*)(sgu_ln_b + chn), b1 = *(const f32x4*)(sgu_ln_b + chn + 4);
                      const float e[8] = {bflo(a[cq].x), bfhi(a[cq].x), bflo(a[cq].y), bfhi(a[cq].y), bflo(a[cq].z), bfhi(a[cq].z), bflo(a[cq].w), bfhi(a[cq].w)};
                      const float gg[8] = {g0[0], g0[1], g0[2], g0[3], g1[0], g1[1], g1[2], g1[3]}, bb[8] = {b0[0], b0[1], b0[2], b0[3], b1[0], b1[1], b1[2], b1[3]};
#pragma unroll
                      for (int i = 0; i < 8; ++i) vT[(c0 + i) * VP + j] = (bf16)f2bf((e[i] - ms.x) * ms.y * gg[i] + bb[i]); } }
                __syncthreads();
                { const int g = wave >> 2, ib = wave & 3, gg = gp * 2 + g, r32 = lane & 31, hi = lane >> 5; const int nks = 2 * (ib + 1);
                  const bf16* Wg = WSb + (size_t)gg * 16384 + (size_t)(ib * 32 + r32) * 128 + hi * 8;
                  f32x16 acc[4] = {};
                  const int tokr = R0 + ib * 32 + r32;
                  bf16x8 bwv[8]; v2u uu[4][4];
#pragma unroll
                  for (int ks = 0; ks < 8; ++ks) bwv[ks] = *(const bf16x8*)(Wg + (ks < nks ? ks : 0) * 16);
#pragma unroll
                  for (int db = 0; db < 4; ++db)
#pragma unroll
                      for (int q4 = 0; q4 < 4; ++q4) uu[db][q4] = *(const v2u*)(UV + (size_t)tokr * D + gg * 128 + db * 32 + 8 * q4 + 4 * hi);
                  __builtin_amdgcn_sched_barrier(0);
#pragma unroll
                  for (int ks = 0; ks < 8; ++ks) { if (ks >= nks) break;
                      const bf16x8 bw = bwv[ks];
#pragma unroll
                      for (int db = 0; db < 4; ++db) { const bf16x8 av = *(const LAS bf16x8*)(vT + (size_t)(g * 128 + db * 32 + r32) * VP + ks * 16 + hi * 8);
                          acc[db] = __builtin_amdgcn_mfma_f32_32x32x16_bf16(av, bw, acc[db], 0, 0, 0); }
                  }
                  const float bs = sgu_b_s[gg * 128 + ib * 32 + r32];
#pragma unroll
                  for (int db = 0; db < 4; ++db)
#pragma unroll
                      for (int q4 = 0; q4 < 4; ++q4) { const int d = db * 32 + 8 * q4 + 4 * hi;
                          const v2u u2 = uu[db][q4];
                          v2u w; w.x = cvt_pk_bf16(bflo(u2.x) * (acc[db][4 * q4 + 0] + bs), bfhi(u2.x) * (acc[db][4 * q4 + 1] + bs));
                          w.y = cvt_pk_bf16(bflo(u2.y) * (acc[db][4 * q4 + 2] + bs), bfhi(u2.y) * (acc[db][4 * q4 + 3] + bs));
                          *(v2u*)(SGUO + (size_t)tokr * SGW + gg * 128 + d) = w; } }
                __syncthreads();
            }
        }
    }
    GRID_BAR();
    }

    if ((BX & 1) == 0) { const int tid = ltid(wave0); conv_run(lds, tid, __builtin_amdgcn_readfirstlane(tid >> 6), tid & 63, NCONV_EARLY + VCU, NCONV); }
    {
        char* al = (char*)lds_raw;
        ArgsP A = kargs(); unsigned char* ws = A->ws; const int tid = ltid(wave0), lane = tid & 63, wave = __builtin_amdgcn_readfirstlane(tid >> 6); (void)lane; (void)wave;
        att::Seam S;
        att::moba_prime(att::make_ref(ws, VCU, 0), al, S, tid);
        constexpr int NBLK = 4 * ((((PROBE_DUP) >> 4) & 1) + 1);
        for (int k = 0; k < NBLK; ++k) att::moba_block(att::make_ref(ws, VCU, k & 3), att::make_ref(ws, VCU, (k + 1) & 3), al, S, tid);
    }
    if ((BX & 1) != 0) { asm volatile("s_waitcnt vmcnt(0)" ::: "memory"); __syncthreads(); const int tid = ltid(wave0); conv_run(lds, tid, __builtin_amdgcn_readfirstlane(tid >> 6), tid & 63, NCONV_EARLY + VCU, NCONV); }
    GRID_BAR();

    DUPLOOP(5) {
    {
        ArgsP A = kargs(); unsigned char* ws = A->ws; const int tid = ltid(wave0), lane = tid & 63, wave = __builtin_amdgcn_readfirstlane(tid >> 6); (void)lane; (void)wave;
        const bf16* SAg = WSP(bf16, WS_SA); const bf16* SBg = WSP(bf16, WS_SB); bf16* T1 = WSP(bf16, WS_Q); unsigned char* MERGED = ws + WS_MERGED;
        { pg8::StaticOrder S; S.init(T, D, SGW * 2, G, BX, ws + WS_WSO);
          pg8::EpiGateSeg E{SAg, SBg, T1, MERGED, 0};
          pg8::gemm_phase<false>(lds, (const char*)(ws + WS_SGUO), SGW * 2, S, E, tid); }
        { pg8::StaticOrder S; S.init(T, D, D, G, BX, ws + WS_WMO8);
          pg8::EpiGateSeg E{SAg, SBg, T1, MERGED, 1};
          pg8::gemm_phase<true>(lds, (const char*)(ws + WS_O8), D, S, E, tid, att::O8_SHIFT); }
    }
    GRID_BAR();
    }

    DUPLOOP(6) {
    {
        ArgsP A = kargs(); unsigned char* ws = A->ws; const int tid = ltid(wave0), lane = tid & 63, wave = __builtin_amdgcn_readfirstlane(tid >> 6); (void)lane; (void)wave;
        const float* ada = WSP(float, WS_ADA); bf16* DELTA = WSP(bf16, WS_DELTA);
        pg8::StaticOrder S; S.init(T, D, D, G, BX, ws + WS_WOUT);
        pg8::EpiDelta E{ada + 4096, DELTA};
        pg8::gemm_phase<true>(lds, (const char*)(ws + WS_MERGED), D, S, E, tid, pg8::M8_SHIFT);
    }
    GRID_BAR();
    }

    DUPLOOP(10) {
    {
        ArgsP A = kargs(); unsigned char* ws = A->ws; const int tid = ltid(wave0), lane = tid & 63, wave = __builtin_amdgcn_readfirstlane(tid >> 6); (void)lane; (void)wave; gu32* ctl = (gu32*)(ws + WS_CTL);
        const float* g_ffn = A->in[14]; const float* b_rg = A->in[16]; const float* b_re = A->in[18]; const float* __restrict__ x = A->in[0]; const bf16* __restrict__ DELTA = WSP(bf16, WS_DELTA);
        const float* ada = WSP(float, WS_ADA); const bf16* __restrict__ RT = WSP(bf16, WS_RT); unsigned char* __restrict__ N28 = ws + WS_N2F8;
        int* tok_e = WSP(int, WS_TOKE); int* tok_p = WSP(int, WS_TOKP); float* tok_w = WSP(float, WS_TOKW); int* elist = WSP(int, WS_LIST);
        if (rep_ == 1) { ctl += 32768; tok_e = WSP(int, WS_K); tok_p = tok_e + 2 * T; tok_w = (float*)(tok_p + 2 * T); elist = (int*)(ws + WS_K + 8 * MiB); }
        LAS unsigned char* At = lds;
        LAS float* lgx = (LAS float*)(lds + TAB_OFF);
        const int row0 = VCU * 64, b = row0 >> 12;
        for (int ps = 0; ps < 2; ++ps) {
            { const f32x4* gp = (const f32x4*)g_ffn + lane; const f32x4* scp = (const f32x4*)(ada + b * 12288 + 8192) + lane; const f32x4* shp = (const f32x4*)(ada + b * 12288 + 6144) + lane;
#pragma unroll
              for (int rp = 0; rp < 2; ++rp) {
                  f32x4 v[2][8]; v2u dl[2][8];
#pragma unroll
                  for (int q = 0; q < 2; ++q) { const int row = row0 + ps * 32 + wave * 4 + rp * 2 + q;
#pragma unroll
                      for (int j = 0; j < 8; ++j) { v[q][j] = *((const f32x4*)(x + (size_t)row * D) + lane + 64 * j); dl[q][j] = *((const v2u*)(DELTA + (size_t)row * D) + lane + 64 * j); } }
#pragma unroll
                  for (int q = 0; q < 2; ++q) { const int rl = wave * 4 + rp * 2 + q, row = row0 + ps * 32 + rl; float ss = 0.f;
#pragma unroll
                      for (int j = 0; j < 8; ++j) { v[q][j] += (f32x4){bflo(dl[q][j].x), bfhi(dl[q][j].x), bflo(dl[q][j].y), bfhi(dl[q][j].y)};
                          ss += (v[q][j].x * v[q][j].x + v[q][j].y * v[q][j].y) + (v[q][j].z * v[q][j].z + v[q][j].w * v[q][j].w); }
                      const float rstd = rsqrtf(wave_sum(ss) * (1.f / D) + EPS);
#pragma unroll
                      for (int j = 0; j < 8; ++j) { const f32x4 y = v[q][j] * rstd * (gp[64 * j] * (scp[64 * j] + 1.0f)) + shp[64 * j];
                          *((unsigned*)(N28 + (size_t)row * D) + lane + 64 * j) = pk_fp8x4(y.x, y.y, y.z, y.w);
                          v2u w; w.x = cvt_pk_bf16(y.x, y.y); w.y = cvt_pk_bf16(y.z, y.w);
                          *(LAS v2u*)(At + rl * 4096 + ((((lane >> 1) + 32 * j) ^ (rl & 15)) << 4) + ((lane & 1) << 3)) = w; } } } }
            __syncthreads();
            { const int i = lane & 15, kq = lane >> 4;
                f32x4 acc[2][3];
#pragma unroll
                for (int mt = 0; mt < 2; ++mt)
#pragma unroll
                    for (int nt = 0; nt < 3; ++nt) acc[mt][nt] = (f32x4){0.f, 0.f, 0.f, 0.f};
                unsigned voff = (unsigned)((wave * 8) * (2 * 48 * 32) + i * 32 + 8 * kq) * 2u;
#pragma unroll 1
                for (int ks = 0; ks < 8; ++ks, voff += 6144u) { const int kg = wave * 8 + ks;
                    bf16x8 wh[3], wl[3];
                    const char* ph = (const char*)RT + voff; const char* pl = ph + 3072;
#pragma unroll
                    for (int nt = 0; nt < 3; ++nt) { wh[nt] = *(const bf16x8*)(ph + nt * 1024); wl[nt] = *(const bf16x8*)(pl + nt * 1024); }
#pragma unroll
                    for (int mt = 0; mt < 2; ++mt) { const bf16x8 af = *(const LAS bf16x8*)(At + (16 * mt + i) * 4096 + (((4 * kg + kq) ^ i) << 4));
#pragma unroll
                        for (int nt = 0; nt < 3; ++nt) { acc[mt][nt] = __builtin_amdgcn_mfma_f32_16x16x32_bf16(af, wh[nt], acc[mt][nt], 0, 0, 0); acc[mt][nt] = __builtin_amdgcn_mfma_f32_16x16x32_bf16(af, wl[nt], acc[mt][nt], 0, 0, 0); } } }
                __syncthreads();
                LAS float* part = (LAS float*)At + wave * 1536;
#pragma unroll
                for (int mt = 0; mt < 2; ++mt)
#pragma unroll
                    for (int nt = 0; nt < 3; ++nt)
#pragma unroll
                        for (int e = 0; e < 4; ++e) part[(16 * mt + 4 * kq + e) * 48 + nt * 16 + i] = acc[mt][nt][e];
                __syncthreads();
#pragma unroll
                for (int q = 0; q < 3; ++q) { const int idx = tid + 512 * q; float sum = 0.f;
#pragma unroll
                    for (int w8 = 0; w8 < 8; ++w8) sum += ((const LAS float*)At)[w8 * 1536 + idx];
                    lgx[ps * 1536 + idx] = sum; }
                __syncthreads(); }
        }
        if (wave == 7) {
            const LAS float* l = lgx + lane * 48; const int tokn = row0 + lane;
            float gl[4]; int gs = 0; float gmax;
#pragma unroll
            for (int q = 0; q < 4; ++q) gl[q] = l[q] + b_rg[q];
            gmax = gl[0];
#pragma unroll
            for (int q = 1; q < 4; ++q) if (gl[q] > gmax) { gmax = gl[q]; gs = q; }
            float den = 0.f;
#pragma unroll
            for (int q = 0; q < 4; ++q) den += __expf(gl[q] - gmax);
            const float pg = 1.0f / den;
            float v0 = -3.0e38f, v1 = -3.0e38f; int i0 = 0, i1 = 0;
#pragma unroll
            for (int q = 0; q < 8; ++q) { const float ev = l[4 + gs * 8 + q] + b_re[gs * 8 + q];
                if (ev > v0) { v1 = v0; i1 = i0; v0 = ev; i0 = q; } else if (ev > v1) { v1 = ev; i1 = q; } }
            const float t = __expf(v1 - v0), w0 = pg / (1.0f + t), w1 = pg * t / (1.0f + t);
            const int e0 = gs * 8 + i0, e1 = gs * 8 + i1;
            const int p0 = (int)__hip_atomic_fetch_add(ctl + CW_CNT + 64 * e0, 1u, RLX_AGENT);
            const int p1 = (int)__hip_atomic_fetch_add(ctl + CW_CNT + 64 * e1, 1u, RLX_AGENT);
            elist[e0 * LCAP + p0] = tokn; elist[e1 * LCAP + p1] = tokn;
            tok_e[2 * tokn] = e0; tok_e[2 * tokn + 1] = e1; tok_p[2 * tokn] = p0; tok_p[2 * tokn + 1] = p1; tok_w[2 * tokn] = w0; tok_w[2 * tokn + 1] = w1;
        }
    }
    GRID_BAR();
    }

    LAS int* bstart = (LAS int*)(lds + TAB_OFF); LAS int* cntl = (LAS int*)(lds + TAB_OFF + 256);
    if (ltid(wave0) == 0) { gu32* ctl = (gu32*)(kargs()->ws + WS_CTL); int acc = 0; for (int e = 0; e < NEXP; ++e) { const int c = (int)__hip_atomic_load(ctl + CW_CNT + 64 * e, RLX_AGENT); cntl[e] = c; bstart[e] = acc; acc += (c + 255) >> 8; } bstart[NEXP] = acc; }
    __syncthreads();
    const int RB = bstart[NEXP];
    DUPLOOP(7) {
        ArgsP A = kargs(); unsigned char* ws = A->ws; const int tid = ltid(wave0), lane = tid & 63, wave = __builtin_amdgcn_readfirstlane(tid >> 6); (void)lane; (void)wave;
        const int* elist = WSP(int, WS_LIST);
        pg8::MoeSched S{bstart, cntl, elist, 4, RB * 4, G, BX, D / 128, (const char*)(ws + WS_WGU8), (size_t)1024 * D, (size_t)256 * D, true};
        pg8::EpiSwiGLU E{ws + WS_HID8};
        pg8::gemm_phase<true>(lds, (const char*)(ws + WS_N2F8), D, S, E, tid);
        GRID_BAR();
    }
    DUPLOOP(8) {
        ArgsP A = kargs(); unsigned char* ws = A->ws; const int tid = ltid(wave0), lane = tid & 63, wave = __builtin_amdgcn_readfirstlane(tid >> 6); (void)lane; (void)wave;
        const int* elist = WSP(int, WS_LIST); bf16* YROW = WSP(bf16, WS_YROW);
        pg8::MoeSched S{bstart, cntl, elist, 8, RB * 8, G, BX, DFF / 128, (const char*)(ws + WS_WD8), (size_t)D * DFF, (size_t)256 * DFF, false};
        pg8::EpiStoreBf16 E{YROW};
        pg8::gemm_phase<true>(lds, (const char*)(ws + WS_HID8), DFF, S, E, tid);
        GRID_BAR();
    }

    DUPLOOP(9)
    {
        ArgsP A = kargs(); unsigned char* ws = A->ws; const int tid = ltid(wave0), lane = tid & 63, wave = __builtin_amdgcn_readfirstlane(tid >> 6); (void)lane; (void)wave;
        float* out = A->out; const float* x = A->in[0]; const bf16* DELTA = WSP(bf16, WS_DELTA); const float* g_fin = A->in[22]; const float* ada = WSP(float, WS_ADA); const bf16* YROW = WSP(bf16, WS_YROW);
        const int* tok_e = WSP(int, WS_TOKE); const int* tok_p = WSP(int, WS_TOKP); const float* tok_w = WSP(float, WS_TOKW);
        const bool poison = __hip_atomic_load((gu32*)(ws + WS_CTL) + CW_BAR + XB_TMO, RLX_AGENT) != 0u;
        for (int rr = 0; rr < 8; ++rr) {
            const int row = (VCU * NWAVES + wave) * 8 + rr, b = row >> 12;
            const int e0 = tok_e[2 * row], e1 = tok_e[2 * row + 1];
            const size_t s0 = (size_t)(bstart[e0] * 256 + tok_p[2 * row]), s1 = (size_t)(bstart[e1] * 256 + tok_p[2 * row + 1]);
            const float w0 = tok_w[2 * row], w1 = tok_w[2 * row + 1];
            f32x4* hr = (f32x4*)(out + (size_t)row * D) + lane; const f32x4* xr = (const f32x4*)(x + (size_t)row * D) + lane; const v2u* dr = (const v2u*)(DELTA + (size_t)row * D) + lane;
            const v2u* y0 = (const v2u*)(YROW + s0 * D) + lane; const v2u* y1 = (const v2u*)(YROW + s1 * D) + lane;
            const f32x4* gf = (const f32x4*)(ada + (size_t)b * 12288 + 10240) + lane;
            f32x4 v[8]; float ss = 0.f;
#pragma unroll
            for (int j = 0; j < 8; ++j) { const v2u dl = dr[64 * j]; const f32x4 hv = xr[64 * j] + (f32x4){bflo(dl.x), bfhi(dl.x), bflo(dl.y), bfhi(dl.y)}, gg = gf[64 * j]; const v2u a = y0[64 * j], c = y1[64 * j];
                f32x4 y; y.x = w0 * bflo(a.x) + w1 * bflo(c.x); y.y = w0 * bfhi(a.x) + w1 * bfhi(c.x); y.z = w0 * bflo(a.y) + w1 * bflo(c.y); y.w = w0 * bfhi(a.y) + w1 * bfhi(c.y);
                v[j] = hv + gg * y; ss += (v[j].x * v[j].x + v[j].y * v[j].y) + (v[j].z * v[j].z + v[j].w * v[j].w); }
            const float rstd = rsqrtf(wave_sum(ss) * (1.f / D) + EPS);
#pragma unroll
            for (int j = 0; j < 8; ++j) { const f32x4 gg = *((const f32x4*)g_fin + lane + 64 * j); hr[64 * j] = poison ? (f32x4){__builtin_nanf(""), __builtin_nanf(""), __builtin_nanf(""), __builtin_nanf("")} : v[j] * rstd * gg; }
        }
    }
}

extern "C" void kernel_launch(void* const* d_in, const int* in_sizes, int n_in, void* d_out, int out_size, void* d_ws, size_t ws_size, hipStream_t stream) {
    static int grid = 0;
    if (grid == 0) {
        if (n_in != 23 || in_sizes[0] != T * D || out_size != T * D || ws_size < WS_END) { fprintf(stderr, "kernel_launch: unexpected shapes (n_in %d, out %d, ws %zu)\n", n_in, out_size, ws_size); grid = -1; return; }
        int dev = 0, cus = 0, per_cu = 0;
        if (hipGetDevice(&dev) != hipSuccess || hipDeviceGetAttribute(&cus, hipDeviceAttributeMultiprocessorCount, dev) != hipSuccess) { grid = -1; return; }
        if (hipFuncSetAttribute((const void*)fwd_kernel, hipFuncAttributeMaxDynamicSharedMemorySize, LDS_BYTES) != hipSuccess) { fprintf(stderr, "kernel_launch: hipFuncSetAttribute failed\n"); grid = -1; return; }
        if (hipOccupancyMaxActiveBlocksPerMultiprocessor(&per_cu, (const void*)fwd_kernel, NWAVES * 64, LDS_BYTES) != hipSuccess || per_cu < 1) fprintf(stderr, "kernel_launch: occupancy query reports %d\n", per_cu);
        (void)hipGetLastError();
        grid = cus;
        if (grid != 256) { fprintf(stderr, "kernel_launch: this kernel is built for 256 CUs, got %d\n", grid); grid = -1; return; }
    }
    if (grid < 0) return;
    (void)hipMemsetAsync((char*)d_ws + WS_CTL, 0, CTL_ZERO_BYTES, stream);
    Args a{};
    for (int i = 0; i < 23; ++i) a.in[i] = (const float*)d_in[i];
    a.out = (float*)d_out; a.ws = (unsigned char*)d_ws;
    hipLaunchKernelGGL(fwd_kernel, dim3(grid), dim3(NWAVES * 64), LDS_BYTES, stream, a);
}
```

```cpp
#include <hip/hip_runtime.h>
#include <cstdio>
#include <cstdint>

#define GAS __attribute__((address_space(1)))
#define LAS __attribute__((address_space(3)))
typedef unsigned short bf16;
typedef unsigned v4u __attribute__((ext_vector_type(4)));
typedef unsigned v2u __attribute__((ext_vector_type(2)));
typedef float f32x2 __attribute__((ext_vector_type(2)));
typedef float f32x4 __attribute__((ext_vector_type(4)));
typedef float f32x16 __attribute__((ext_vector_type(16)));
typedef short bf16x8 __attribute__((ext_vector_type(8)));
typedef short s16x4 __attribute__((ext_vector_type(4)));
typedef GAS unsigned gu32;
#define RLX_AGENT __ATOMIC_RELAXED, __HIP_MEMORY_SCOPE_AGENT
#define LDS_WAIT() asm volatile("s_waitcnt lgkmcnt(0)" ::: "memory")
#define VM_WAIT() asm volatile("s_waitcnt vmcnt(0)" ::: "memory")

constexpr int BATCH = 4, SEQ = 4096, T = BATCH * SEQ, D = 2048;
constexpr int SGW = 1024, NHEAD = 16, HD = 128, INC = 12288;
constexpr int NEXP = 32, DFF = 512, LCAP = 16384;
constexpr float EPS = 1e-6f;
constexpr int NWAVES = 8;
#ifndef PROBE_DUP
#define PROBE_DUP 0
#endif
#define DUPLOOP(k) for (int rep_ = 0; rep_ < (((PROBE_DUP) >> (k)) & 1) + 1; ++rep_)

constexpr size_t MiB = 1u << 20;
constexpr size_t WS_CTL = 0, CTL_ZERO_BYTES = 1 * MiB;
constexpr size_t WS_ADAP = 1 * MiB;
constexpr size_t WS_ADA = 1 * MiB + 786432;
constexpr size_t WS_COS = 2 * MiB, WS_SIN = 6 * MiB;
constexpr size_t WS_KM = 10 * MiB;
constexpr size_t WS_WS = 10 * MiB + 512 * 1024;
constexpr size_t WS_RT = 11 * MiB;
constexpr size_t WS_TOKE = 12 * MiB, WS_TOKP = WS_TOKE + 128 * 1024, WS_TOKW = WS_TOKP + 128 * 1024;
constexpr size_t WS_LIST = 13 * MiB;
constexpr size_t WS_WINZ = 16 * MiB;
constexpr size_t WS_WIN8 = 24 * MiB;
constexpr size_t WS_WSO = 48 * MiB;
constexpr size_t WS_WMO8 = 52 * MiB;
constexpr size_t WS_WOUT = 60 * MiB;
constexpr size_t WS_WGU8 = 68 * MiB;
constexpr size_t WS_WD8 = 132 * MiB;
constexpr size_t WS_N = 164 * MiB;
constexpr size_t WS_N1F8 = 228 * MiB;
constexpr size_t WS_UV = 260 * MiB;
constexpr size_t WS_Q = 324 * MiB, WS_K = 388 * MiB, WS_V = 452 * MiB;
constexpr size_t WS_SA = 516 * MiB, WS_SB = 580 * MiB;
constexpr size_t WS_END = 644 * MiB;
constexpr size_t WS_Q8 = WS_Q, WS_K8 = WS_K, WS_VT8 = WS_V;
constexpr size_t WS_SGUO = WS_N, WS_O8 = WS_N + 32 * MiB, WS_N2F8 = WS_UV, WS_MERGED = WS_UV, WS_HID8 = WS_N, WS_YROW = WS_Q, WS_DELTA = WS_SA;
constexpr int CW_BAR = 4096, CW_QUEUE = 8192, CW_CNT = 8192 + 64;

constexpr int RING_BYTES = 131072, LDSCTL_OFF = RING_BYTES, MISC_OFF = LDSCTL_OFF + 320, TAB_OFF = LDSCTL_OFF + 1024;
constexpr int LDS_BYTES = 163840;

__device__ __forceinline__ unsigned f2bf(float f) { unsigned u = __builtin_bit_cast(unsigned, f); return (u + 0x7fffu + ((u >> 16) & 1u)) >> 16; }
__device__ __forceinline__ unsigned pk2(float lo, float hi) { return f2bf(lo) | (f2bf(hi) << 16); }
typedef __bf16 bf16x2_t __attribute__((ext_vector_type(2)));
__device__ __forceinline__ unsigned cvt_pk_bf16(float lo, float hi) { f32x2 v = {lo, hi}; bf16x2_t b = __builtin_convertvector(v, bf16x2_t); return __builtin_bit_cast(unsigned, b); }
__device__ __forceinline__ unsigned pk_fp8x4(float a, float b, float c, float d) { unsigned w = 0u; w = __builtin_amdgcn_cvt_pk_fp8_f32(a, b, w, false); w = __builtin_amdgcn_cvt_pk_fp8_f32(c, d, w, true); return w; }
__device__ __forceinline__ float bflo(unsigned w) { return __builtin_bit_cast(float, w << 16); }
__device__ __forceinline__ float bfhi(unsigned w) { return __builtin_bit_cast(float, w & 0xffff0000u); }
__device__ __forceinline__ float wave_sum(float v) {
#pragma unroll
    for (int o = 1; o < 64; o <<= 1) v += __shfl_xor(v, o);
    return v;
}
__device__ __forceinline__ float fast_sigmoid(float x) { return __builtin_amdgcn_rcpf(1.0f + __builtin_amdgcn_exp2f(-1.4426950408889634f * x)); }
__device__ __forceinline__ float gelu_tanh(float x) { const float u = x * (1.0f + 0.044715f * x * x); return x * __builtin_amdgcn_rcpf(1.0f + __builtin_amdgcn_exp2f(-2.3022081985f * u)); }

#define XB_TMO      128
#define XB_XCNT(j)  (256  + 64 * (j))
#define XB_XSUB(j)  (1280 + 64 * (j))
#define XB_XGEN(j)  (2304 + 64 * (j))
#define XB_TOP      3328
#define XB_TOPGEN   3392
#define XCD_BAR_WORDS 3456
#define XB_SPIN_CAP (1u << 18)
__device__ __forceinline__ unsigned xb_ld(unsigned* p)              { return __hip_atomic_load(p, __ATOMIC_RELAXED, __HIP_MEMORY_SCOPE_AGENT); }
__device__ __forceinline__ unsigned xb_add(unsigned* p, unsigned v) { return __hip_atomic_fetch_add(p, v, __ATOMIC_RELAXED, __HIP_MEMORY_SCOPE_AGENT); }
__device__ __forceinline__ unsigned xb_xcc_id() { return (unsigned)__builtin_amdgcn_s_getreg((3 << 11) | 20) & 0xFu; }
#define XB_SPIN(cond, bar) do { unsigned _sp = 0; while (cond) { __builtin_amdgcn_s_sleep(1); \
    if ((++_sp & 255u) == 0u) { if (xb_ld(&(bar)[XB_TMO])) break; if (_sp > XB_SPIN_CAP) { atomicAdd(&(bar)[XB_TMO], 1u); break; } } } } while (0)
struct XcdBarrier { unsigned* bar; unsigned x; volatile LAS unsigned* st; };
__device__ __forceinline__ XcdBarrier xcd_barrier_post(unsigned* bar, volatile LAS unsigned* st, int tid) {
    XcdBarrier b; b.bar = bar; b.x = xb_xcc_id(); b.st = st;
    if (tid == 0) (void)xb_add(&bar[XB_XCNT(b.x)], 1u);
    return b;
}
__device__ __forceinline__ void xcd_barrier_complete(unsigned* bar, unsigned x, unsigned& nloc, unsigned& nx) {
    const unsigned G = gridDim.x * gridDim.y * gridDim.z;
    unsigned sum, cnt, mine, sp = 0u;
    for (;;) {
        sum = 0u; cnt = 0u; mine = 0u;
#pragma unroll
        for (unsigned j = 0; j < 16; ++j) { const unsigned c = xb_ld(&bar[XB_XCNT(j)]); sum += c; cnt += (c > 0u) ? 1u : 0u; mine = (j == x) ? c : mine; }
        if (sum == G) break;
        __builtin_amdgcn_s_sleep(1);
        if ((++sp & 255u) == 0u) { if (xb_ld(&bar[XB_TMO])) break; if (sp > XB_SPIN_CAP) { atomicAdd(&bar[XB_TMO], 1u); break; } }
    }
    nloc = mine > 0u ? mine : 1u; nx = cnt > 0u ? cnt : 1u;
}
__device__ __forceinline__ void xcd_barrier(const XcdBarrier& b, int tid) {
    asm volatile("s_waitcnt vmcnt(0)" ::: "memory");
    __syncthreads();
    if (tid == 0) {
        unsigned* bar = b.bar;
        __builtin_amdgcn_s_waitcnt(0);
        unsigned nloc = b.st[0], nx = b.st[1];
        if (nloc == 0u) { xcd_barrier_complete(bar, b.x, nloc, nx); b.st[0] = nloc; b.st[1] = nx; }
        const unsigned old = xb_add(&bar[XB_XSUB(b.x)], 1u);
        const unsigned gen = old / nloc;
        if (old + 1u == (gen + 1u) * nloc) {
            __builtin_amdgcn_fence(__ATOMIC_RELEASE, "agent");
            asm volatile("s_waitcnt vmcnt(0)" ::: "memory");
            const unsigned og = xb_add(&bar[XB_TOP], 1u);
            const unsigned tg = og / nx;
            if (og + 1u == (tg + 1u) * nx) xb_add(&bar[XB_TOPGEN], 1u);
            else XB_SPIN(xb_ld(&bar[XB_TOPGEN]) == tg, bar);
            __builtin_amdgcn_fence(__ATOMIC_ACQUIRE, "agent");
            xb_add(&bar[XB_XGEN(b.x)], 1u);
            asm volatile("s_waitcnt vmcnt(0)" ::: "memory");
        } else {
            XB_SPIN(xb_ld(&bar[XB_XGEN(b.x)]) == gen, bar);
            __builtin_amdgcn_fence(__ATOMIC_ACQUIRE, "agent");
            asm volatile("s_waitcnt vmcnt(0)" ::: "memory");
        }
    }
    __syncthreads();
}

namespace pg8 {
constexpr int BM = 256, BK = 64, HALF = 128, HTB = HALF * BK * 2, STAGE_BYTES = 8 * HTB, NXCD = 8, WGM = 8;
__device__ __forceinline__ int lds_byte(int r, int c) { const int st = (r >> 4) * 2 + (c >> 5), rr = r & 15, cc = c & 31, ob = rr * 64 + cc * 2; return st * 1024 + (ob ^ (((ob >> 9) & 1) << 5)); }
__device__ __forceinline__ void stage_rc(int b, int& R, int& C) { const int st = b / 1024, sb = b % 1024, swz = sb ^ (((sb >> 9) & 1) << 5); R = (st >> 1) * 16 + swz / 64; C = (st & 1) * 32 + (swz % 64) / 2; }
__device__ __forceinline__ int perm32(int rho) { const int n = rho >> 4, i = rho & 15; return 8 * (i >> 2) + 4 * n + (i & 3); }
typedef int v8i __attribute__((ext_vector_type(8)));
typedef int v4i __attribute__((ext_vector_type(4)));
constexpr int M8_SHIFT = 4;
constexpr int W8_SHIFT = 5;
__device__ __forceinline__ v8i cat8(bf16x8 lo, bf16x8 hi) { const v4i a = __builtin_bit_cast(v4i, lo), b = __builtin_bit_cast(v4i, hi); return __builtin_shufflevector(a, b, 0, 1, 2, 3, 4, 5, 6, 7); }
struct Unit { int pm, pn, ex, kt0, nkt; };

struct StaticOrder {
    int nM, nN, nwg, G, c, nkt; const char* Bt; size_t tstepB;
    __device__ __forceinline__ void init(int M, int N, int rowbytes, int G_, int c_, const void* Bt_) { nM = M / BM; nN = N / BM; nwg = nM * nN; G = G_; c = c_; Bt = (const char*)Bt_; tstepB = (size_t)BM * rowbytes; nkt = rowbytes / 128; }
    __device__ __forceinline__ bool next(int i, Unit& u) const {
        const long L = (long)i * G + c; if (L >= nwg) return false;
        int wgid = (int)L; { const int q = nwg / NXCD, r = nwg % NXCD, xcd = wgid % NXCD, off = wgid / NXCD; wgid = (xcd < r ? xcd * (q + 1) : r * (q + 1) + (xcd - r) * q) + off; }
        const int nig = WGM * nN, gid = wgid / nig, fm = gid * WGM, gsz = (nM - fm) < WGM ? (nM - fm) : WGM;
        u.pm = fm + ((wgid % nig) % gsz); u.pn = (wgid % nig) / gsz; u.ex = 0; u.kt0 = 0; u.nkt = nkt; return true;
    }
    __device__ __forceinline__ const char* b_ptr(const Unit& u) const { return Bt + (size_t)u.pn * tstepB; }
    __device__ __forceinline__ unsigned a_row(const Unit& u, int r) const { return (unsigned)(u.pm * BM + r); }
};

template <bool F8, class Epi, class Sched>
__device__ __forceinline__ void gemm_phase(LAS unsigned char* lds, const char* Ab, const int rowbytes, const Sched& S, const Epi& E, const int tid, const int a8shift = 0) {
    const int wid = __builtin_amdgcn_readfirstlane(tid >> 6), lane = tid & 63, wr = wid >> 2, wc = wid & 3, fr = lane & 15, fq = lane >> 4;
    int Rs[2]; unsigned Cs[2], voffB[2];
#pragma unroll
    for (int i = 0; i < 2; ++i) { int R, C; stage_rc(tid * 16 + i * 8192, R, C); const int Rb = Epi::PERM ? ((R & ~31) + perm32(R & 31)) : R;
        Rs[i] = R; Cs[i] = (unsigned)C * 2u; voffB[i] = (unsigned)(Rb * rowbytes + C * 2); }
    const size_t kstep = (size_t)(BK * 2);
    const size_t hstep = (size_t)HALF * rowbytes;
    const unsigned rowb = (unsigned)rowbytes;
    const unsigned ldsw = (unsigned)wid * 1024u;
    const int aoff = lds_byte(wr * 64 + fr, fq * 8), boff = lds_byte(wc * 32 + fr, fq * 8);
#define PG8_SA(b, h) (((b) * 2 + (h)) * HTB)
#define PG8_SB(b, h) ((4 + (b) * 2 + (h)) * HTB)
#define PG8_STAGE_B(bufoff, gbase) do { _Pragma("unroll") for (int _i = 0; _i < 2; ++_i) \
        __builtin_amdgcn_global_load_lds((const unsigned*)((const char*)(gbase) + voffB[_i]), (LAS unsigned*)(lds + (bufoff) + ldsw + _i * 8192), 16, 0, 0); } while (0)
#define PG8_STAGE_A(bufoff, kbyte, h) do { _Pragma("unroll") for (int _i = 0; _i < 2; ++_i) \
        __builtin_amdgcn_global_load_lds((const unsigned*)(Ab + (kbyte) + vC[h][_i]), (LAS unsigned*)(lds + (bufoff) + ldsw + _i * 8192), 16, 0, 0); } while (0)
#define PG8_LDA(dst, b, h) do { _Pragma("unroll") for (int m = 0; m < 4; ++m) _Pragma("unroll") for (int k = 0; k < 2; ++k) dst[m][k] = *(const LAS bf16x8*)(lds + PG8_SA(b, h) + aoff + m * 2048 + k * 1024); } while (0)
#define PG8_LDB(dst, b, h) do { _Pragma("unroll") for (int n = 0; n < 2; ++n) _Pragma("unroll") for (int k = 0; k < 2; ++k) dst[n][k] = *(const LAS bf16x8*)(lds + PG8_SB(b, h) + boff + n * 2048 + k * 1024); } while (0)
#define PG8_MMA(ai, bj, At, Bt) do { __builtin_amdgcn_s_setprio(1); _Pragma("unroll") for (int m = 0; m < 4; ++m) _Pragma("unroll") for (int n = 0; n < 2; ++n) { \
        if constexpr (F8) acc[ai][bj][m][n] = __builtin_amdgcn_mfma_scale_f32_16x16x128_f8f6f4(cat8(Bt[n][0], Bt[n][1]), cat8(At[m][0], At[m][1]), acc[ai][bj][m][n], 0, 0, 0, 127 - W8_SHIFT, 0, 127 - a8shift); \
        else { _Pragma("unroll") for (int k = 0; k < 2; ++k) acc[ai][bj][m][n] = __builtin_amdgcn_mfma_f32_16x16x32_bf16(Bt[n][k], At[m][k], acc[ai][bj][m][n], 0, 0, 0); } } __builtin_amdgcn_s_setprio(0); } while (0)
#define PG8_WAIT_V(n) asm volatile("s_waitcnt vmcnt(" #n ")" ::: "memory")
#define PG8_WAIT_L(n) asm volatile("s_waitcnt lgkmcnt(" #n ")" ::: "memory")
#define PG8_BAR __builtin_amdgcn_s_barrier()
#define PG8_SCHED __builtin_amdgcn_sched_barrier(0)
    Unit cur, nxt; int ui = 0;
    if (!S.next(0, cur)) return;
    f32x4 acc[2][2][4][2];
#pragma unroll
    for (int a = 0; a < 2; ++a)
#pragma unroll
        for (int b = 0; b < 2; ++b)
#pragma unroll
            for (int m = 0; m < 4; ++m)
#pragma unroll
                for (int n = 0; n < 2; ++n) acc[a][b][m][n] = (f32x4){0.f, 0.f, 0.f, 0.f};
    bf16x8 At[4][2], B0[2][2], B1[2][2];
    unsigned vC[2][2], vN[2][2];
#pragma unroll
    for (int h = 0; h < 2; ++h)
#pragma unroll
        for (int i = 0; i < 2; ++i) vC[h][i] = S.a_row(cur, h * HALF + Rs[i]) * rowb + Cs[i];
    const char* cB = S.b_ptr(cur) + (size_t)cur.kt0 * kstep; size_t kc = (size_t)cur.kt0 * kstep; int nt = cur.nkt;
    PG8_STAGE_B(PG8_SB(0, 0), cB); PG8_STAGE_B(PG8_SB(0, 1), cB + hstep); PG8_STAGE_A(PG8_SA(0, 0), kc, 0); PG8_STAGE_A(PG8_SA(0, 1), kc, 1);
    if (wr == 1) PG8_BAR;
    PG8_WAIT_V(2); PG8_BAR;
    PG8_STAGE_B(PG8_SB(1, 0), cB + kstep); PG8_STAGE_A(PG8_SA(1, 0), kc + kstep, 0); PG8_STAGE_B(PG8_SB(1, 1), cB + hstep + kstep);
    PG8_WAIT_V(6); PG8_BAR;
    for (;;) {
        const bool has_next = S.next(ui + 1, nxt);
        const char* nB = has_next ? S.b_ptr(nxt) + (size_t)nxt.kt0 * kstep : cB; const size_t kn = has_next ? (size_t)nxt.kt0 * kstep : kc;
#pragma unroll
        for (int h = 0; h < 2; ++h)
#pragma unroll
            for (int i = 0; i < 2; ++i) vN[h][i] = has_next ? (S.a_row(nxt, h * HALF + Rs[i]) * rowb + Cs[i]) : vC[h][i];
        for (int t = 0; t < nt; t += 2) {
            const bool last = (t == nt - 2);
            const size_t ka1 = kc + (size_t)(t + 1) * kstep;
            const size_t ka2 = last ? kn : kc + (size_t)(t + 2) * kstep;
            const char* b2 = last ? nB : cB + (size_t)(t + 2) * kstep; const char* b3 = b2 + kstep;
            PG8_LDB(B0, 0, 0); PG8_LDB(B1, 0, 1); PG8_SCHED; PG8_LDA(At, 0, 0); PG8_STAGE_A(PG8_SA(1, 1), ka1, 1);
            if (last) {
#pragma unroll
                for (int h = 0; h < 2; ++h)
#pragma unroll
                    for (int i = 0; i < 2; ++i) vC[h][i] = vN[h][i];
            }
            PG8_WAIT_V(8); PG8_WAIT_L(0); PG8_BAR; PG8_MMA(0, 0, At, B0); PG8_MMA(0, 1, At, B1); PG8_BAR; PG8_SCHED;
            PG8_LDA(At, 0, 1); PG8_STAGE_B(PG8_SB(0, 0), b2); PG8_STAGE_B(PG8_SB(0, 1), b2 + hstep); PG8_STAGE_A(PG8_SA(0, 0), ka2, 0);
            PG8_WAIT_V(8); PG8_WAIT_L(0); PG8_BAR; PG8_MMA(1, 0, At, B0); PG8_MMA(1, 1, At, B1); PG8_BAR; PG8_SCHED;
            PG8_LDB(B0, 1, 0); PG8_LDB(B1, 1, 1); PG8_SCHED; PG8_LDA(At, 1, 0); PG8_STAGE_A(PG8_SA(0, 1), ka2, 1);
            PG8_WAIT_V(8); PG8_WAIT_L(0); PG8_BAR; PG8_MMA(0, 0, At, B0); PG8_MMA(0, 1, At, B1); PG8_BAR; PG8_SCHED;
            PG8_LDA(At, 1, 1); PG8_STAGE_B(PG8_SB(1, 0), b3); PG8_STAGE_B(PG8_SB(1, 1), b3 + hstep); PG8_STAGE_A(PG8_SA(1, 0), ka2 + kstep, 0);
            PG8_WAIT_V(8); PG8_WAIT_L(0); PG8_BAR; PG8_MMA(1, 0, At, B0); PG8_MMA(1, 1, At, B1); PG8_BAR; PG8_SCHED;
        }
        if (wr == 0) PG8_BAR;
        E(acc, cur, wr, wc, fr, fq);
        if (!has_next) break;
#pragma unroll
        for (int a = 0; a < 2; ++a)
#pragma unroll
            for (int b = 0; b < 2; ++b)
#pragma unroll
                for (int m = 0; m < 4; ++m)
#pragma unroll
                    for (int n = 0; n < 2; ++n) acc[a][b][m][n] = (f32x4){0.f, 0.f, 0.f, 0.f};
        cur = nxt; cB = nB; kc = kn; nt = cur.nkt; ++ui;
        if (wr == 1) PG8_BAR;
    }
    PG8_WAIT_V(0);
    PG8_BAR;
#undef PG8_SA
#undef PG8_SB
#undef PG8_STAGE_A
#undef PG8_STAGE_B
#undef PG8_LDA
#undef PG8_LDB
#undef PG8_MMA
#undef PG8_WAIT_V
#undef PG8_WAIT_L
#undef PG8_BAR
#undef PG8_SCHED
}

typedef const f32x4 (&AccRef)[2][2][4][2];

struct EpiInProj {
    static constexpr bool PERM = true;
    bf16* UV; unsigned char* Q8; unsigned char* K8; unsigned char* VT8; bf16* SA; bf16* SB; const float* cosT; const float* sinT; int pn_off;
    __device__ __forceinline__ void operator()(AccRef acc, const Unit& u, int wr, int wc, int fr, int fq) const {
        asm volatile("" : "+v"(fr), "+v"(fq));
        const int pn = u.pn + pn_off, rbase = u.pm * BM + wr * 64 + fr, cl = wc * 32 + 8 * fq;
        if (pn < 8) {
#pragma unroll
            for (int ai = 0; ai < 2; ++ai)
#pragma unroll
                for (int m = 0; m < 4; ++m) { bf16* rp = UV + (size_t)(rbase + ai * HALF + m * 16) * D + pn * BM + cl;
#pragma unroll
                    for (int bj = 0; bj < 2; ++bj) { const f32x4 a = acc[ai][bj][m][0], b = acc[ai][bj][m][1];
                        v4u w; w.x = cvt_pk_bf16(gelu_tanh(a[0]), gelu_tanh(a[1])); w.y = cvt_pk_bf16(gelu_tanh(a[2]), gelu_tanh(a[3]));
                        w.z = cvt_pk_bf16(gelu_tanh(b[0]), gelu_tanh(b[1])); w.w = cvt_pk_bf16(gelu_tanh(b[2]), gelu_tanh(b[3]));
                        *(v4u*)(rp + bj * HALF) = w; } }
        } else if (pn < 24) {
            unsigned char* dst = (pn < 16) ? Q8 : K8; const int hp = ((pn - 8) & 7) * 2, j0 = cl >> 1;
#pragma unroll
            for (int ai = 0; ai < 2; ++ai)
#pragma unroll
                for (int m = 0; m < 4; ++m) { const int row = rbase + ai * HALF + m * 16, b = row >> 12, s = row & 4095;
                    const f32x4 c4 = *(const f32x4*)(cosT + (size_t)row * 64 + j0), s4 = *(const f32x4*)(sinT + (size_t)row * 64 + j0);
#pragma unroll
                    for (int bj = 0; bj < 2; ++bj) { const f32x4 x0 = acc[ai][bj][m][0], x1 = acc[ai][bj][m][1];
                        v2u w;
                        w.x = pk_fp8x4(x0[0] * c4[0] - x0[1] * s4[0], x0[1] * c4[0] + x0[0] * s4[0], x0[2] * c4[1] - x0[3] * s4[1], x0[3] * c4[1] + x0[2] * s4[1]);
                        w.y = pk_fp8x4(x1[0] * c4[2] - x1[1] * s4[2], x1[1] * c4[2] + x1[0] * s4[2], x1[2] * c4[3] - x1[3] * s4[3], x1[3] * c4[3] + x1[2] * s4[3]);
                        *(v2u*)(dst + ((size_t)(b * NHEAD + hp + bj) * SEQ + s) * HD + cl) = w; } }
        } else if (pn < 32) {
            const int hp = (pn - 24) * 2, lane = fr + 16 * fq, jq = lane & 3;
#pragma unroll
            for (int ai = 0; ai < 2; ++ai)
#pragma unroll
                for (int m = 0; m < 4; ++m) { const int row = rbase + ai * HALF + m * 16, b = row >> 12, s0 = (row & 4095) & ~3;
#pragma unroll
                    for (int bj = 0; bj < 2; ++bj) { const f32x4 a = acc[ai][bj][m][0], c = acc[ai][bj][m][1];
                        const unsigned w0 = pk_fp8x4(a[0], a[1], a[2], a[3]), w1 = pk_fp8x4(c[0], c[1], c[2], c[3]);
                        unsigned o0 = 0u, o1 = 0u;
#define VQ(q) { const unsigned t0 = (unsigned)__builtin_amdgcn_mov_dpp((int)w0, (q) * 0x55, 0xf, 0xf, true), t1 = (unsigned)__builtin_amdgcn_mov_dpp((int)w1, (q) * 0x55, 0xf, 0xf, true); \
                            o0 |= ((t0 >> (8 * jq)) & 0xffu) << (8 * (q)); o1 |= ((t1 >> (8 * jq)) & 0xffu) << (8 * (q)); }
                        VQ(0) VQ(1) VQ(2) VQ(3)
#undef VQ
                        unsigned char* vp = VT8 + ((size_t)(b * NHEAD + hp + bj) * HD + cl + jq) * SEQ + s0;
                        *(unsigned*)vp = o0; *(unsigned*)(vp + 4 * SEQ) = o1; } }
        } else {
            bf16* dst = (pn < 40) ? SA : SB; const int colt = ((pn - 32) & 7) * BM;
#pragma unroll
            for (int ai = 0; ai < 2; ++ai)
#pragma unroll
                for (int m = 0; m < 4; ++m) { bf16* rp = dst + (size_t)(rbase + ai * HALF + m * 16) * D + colt + cl;
#pragma unroll
                    for (int bj = 0; bj < 2; ++bj) { const f32x4 a = acc[ai][bj][m][0], b = acc[ai][bj][m][1];
                        v4u w; w.x = cvt_pk_bf16(fast_sigmoid(a[0]), fast_sigmoid(a[1])); w.y = cvt_pk_bf16(fast_sigmoid(a[2]), fast_sigmoid(a[3]));
                        w.z = cvt_pk_bf16(fast_sigmoid(b[0]), fast_sigmoid(b[1])); w.w = cvt_pk_bf16(fast_sigmoid(b[2]), fast_sigmoid(b[3]));
                        *(v4u*)(rp + bj * HALF) = w; } }
        }
    }
};
struct EpiGateSeg {
    static constexpr bool PERM = true;
    const bf16* SAg; const bf16* SBg; bf16* T1; unsigned char* Mg; int seg;
    __device__ __forceinline__ void operator()(AccRef acc, const Unit& u, int wr, int wc, int fr, int fq) const {
        const int rbase = u.pm * BM + wr * 64 + fr, col0 = u.pn * BM + wc * 32 + 8 * fq;
        if (seg == 0) {
#pragma unroll
            for (int ai = 0; ai < 2; ++ai) {
                v4u g[4][2];
#pragma unroll
                for (int m = 0; m < 4; ++m)
#pragma unroll
                    for (int bj = 0; bj < 2; ++bj) g[m][bj] = *(const v4u*)(SAg + (size_t)(rbase + ai * HALF + m * 16) * D + col0 + bj * HALF);
#pragma unroll
                for (int m = 0; m < 4; ++m) { const size_t off = (size_t)(rbase + ai * HALF + m * 16) * D + col0;
#pragma unroll
                    for (int bj = 0; bj < 2; ++bj) { const v4u gg = g[m][bj]; const f32x4 a = acc[ai][bj][m][0], b = acc[ai][bj][m][1];
                        v4u w; w.x = cvt_pk_bf16(bflo(gg.x) * a[0], bfhi(gg.x) * a[1]); w.y = cvt_pk_bf16(bflo(gg.y) * a[2], bfhi(gg.y) * a[3]);
                        w.z = cvt_pk_bf16(bflo(gg.z) * b[0], bfhi(gg.z) * b[1]); w.w = cvt_pk_bf16(bflo(gg.w) * b[2], bfhi(gg.w) * b[3]);
                        *(v4u*)(T1 + off + bj * HALF) = w; } }
            }
        } else {
#pragma unroll
            for (int ai = 0; ai < 2; ++ai)
#pragma unroll
                for (int mp = 0; mp < 2; ++mp) {
                    v4u tt[2][2], g[2][2];
#pragma unroll
                    for (int mm = 0; mm < 2; ++mm)
#pragma unroll
                        for (int bj = 0; bj < 2; ++bj) { const size_t off = (size_t)(rbase + ai * HALF + (2 * mp + mm) * 16) * D + col0 + bj * HALF; tt[mm][bj] = *(const v4u*)(T1 + off); g[mm][bj] = *(const v4u*)(SBg + off); }
#pragma unroll
                    for (int mm = 0; mm < 2; ++mm) { const int m = 2 * mp + mm; const size_t off = (size_t)(rbase + ai * HALF + m * 16) * D + col0;
#pragma unroll
                        for (int bj = 0; bj < 2; ++bj) { const v4u t = tt[mm][bj], gg = g[mm][bj]; const f32x4 a = acc[ai][bj][m][0], b = acc[ai][bj][m][1];
                            constexpr float MS = (float)(1 << M8_SHIFT);
                            v2u w; w.x = pk_fp8x4((bflo(t.x) + bflo(gg.x) * a[0]) * MS, (bfhi(t.x) + bfhi(gg.x) * a[1]) * MS, (bflo(t.y) + bflo(gg.y) * a[2]) * MS, (bfhi(t.y) + bfhi(gg.y) * a[3]) * MS);
                            w.y = pk_fp8x4((bflo(t.z) + bflo(gg.z) * b[0]) * MS, (bfhi(t.z) + bfhi(gg.z) * b[1]) * MS, (bflo(t.w) + bflo(gg.w) * b[2]) * MS, (bfhi(t.w) + bfhi(gg.w) * b[3]) * MS);
                            *(v2u*)(Mg + off + bj * HALF) = w; } }
                }
        }
    }
};
struct EpiDelta {
    static constexpr bool PERM = true;
    const float* gm; bf16* Dl;
    __device__ __forceinline__ void operator()(AccRef acc, const Unit& u, int wr, int wc, int fr, int fq) const {
        const int rbase = u.pm * BM + wr * 64 + fr, col0 = u.pn * BM + wc * 32 + 8 * fq, b = (u.pm * BM) >> 12;
        f32x4 gv[2][2];
#pragma unroll
        for (int bj = 0; bj < 2; ++bj)
#pragma unroll
            for (int n = 0; n < 2; ++n) gv[bj][n] = *(const f32x4*)(gm + (size_t)b * 12288 + col0 + bj * HALF + 4 * n);
#pragma unroll
        for (int ai = 0; ai < 2; ++ai)
#pragma unroll
            for (int m = 0; m < 4; ++m) { bf16* rp = Dl + (size_t)(rbase + ai * HALF + m * 16) * D + col0;
#pragma unroll
                for (int bj = 0; bj < 2; ++bj) { const f32x4 a = acc[ai][bj][m][0] * gv[bj][0], c = acc[ai][bj][m][1] * gv[bj][1];
                    v4u w; w.x = cvt_pk_bf16(a[0], a[1]); w.y = cvt_pk_bf16(a[2], a[3]); w.z = cvt_pk_bf16(c[0], c[1]); w.w = cvt_pk_bf16(c[2], c[3]);
                    *(v4u*)(rp + bj * HALF) = w; } }
    }
};
struct MoeSched {
    const LAS int* bstart; const LAS int* cntl; const int* list; int npn, total, G, c, nkt; const char* Bt; size_t estride, tstepB; bool gather;
    __device__ __forceinline__ bool next(int i, Unit& u) const {
        const int L = i * G + c; if (L >= total) return false;
        const int rb = L / npn; int e = 0;
        for (int j = 1; j < NEXP; ++j) e += (bstart[j] <= rb) ? 1 : 0;
        u.pm = rb; u.pn = L - rb * npn; u.ex = e; u.kt0 = 0; u.nkt = nkt; return true;
    }
    __device__ __forceinline__ const char* b_ptr(const Unit& u) const { return Bt + (size_t)u.ex * estride + (size_t)u.pn * tstepB; }
    __device__ __forceinline__ unsigned a_row(const Unit& u, int r) const {
        if (!gather) return (unsigned)(u.pm * BM + r);
        const int pos = (u.pm - bstart[u.ex]) * BM + r;
        return (pos < cntl[u.ex]) ? (unsigned)list[u.ex * LCAP + pos] : 0u;
    }
};
struct EpiSwiGLU {
    static constexpr bool PERM = true;
    unsigned char* HID;
    __device__ __forceinline__ void operator()(AccRef acc, const Unit& u, int wr, int wc, int fr, int fq) const {
        const int rbase = u.pm * BM + wr * 64 + fr, hc0 = u.pn * 128 + wc * 16 + 4 * fq;
#pragma unroll
        for (int ai = 0; ai < 2; ++ai)
#pragma unroll
            for (int m = 0; m < 4; ++m) { unsigned char* rp = HID + (size_t)(rbase + ai * HALF + m * 16) * DFF + hc0;
#pragma unroll
                for (int bj = 0; bj < 2; ++bj) { const f32x4 g = acc[ai][bj][m][0], up = acc[ai][bj][m][1];
                    *(unsigned*)(rp + bj * 64) = pk_fp8x4(g[0] * fast_sigmoid(g[0]) * up[0], g[1] * fast_sigmoid(g[1]) * up[1], g[2] * fast_sigmoid(g[2]) * up[2], g[3] * fast_sigmoid(g[3]) * up[3]); } }
    }
};
struct EpiStoreBf16 {
    static constexpr bool PERM = true;
    bf16* Y;
    __device__ __forceinline__ void operator()(AccRef acc, const Unit& u, int wr, int wc, int fr, int fq) const {
        const int rbase = u.pm * BM + wr * 64 + fr, col0 = u.pn * BM + wc * 32 + 8 * fq;
#pragma unroll
        for (int ai = 0; ai < 2; ++ai)
#pragma unroll
            for (int m = 0; m < 4; ++m) { bf16* rp = Y + (size_t)(rbase + ai * HALF + m * 16) * D + col0;
#pragma unroll
                for (int bj = 0; bj < 2; ++bj) { const f32x4 a = acc[ai][bj][m][0], b = acc[ai][bj][m][1];
                    v4u w; w.x = cvt_pk_bf16(a[0], a[1]); w.y = cvt_pk_bf16(a[2], a[3]); w.z = cvt_pk_bf16(b[0], b[1]); w.w = cvt_pk_bf16(b[2], b[3]);
                    *(v4u*)(rp + bj * HALF) = w; } }
    }
};
}

namespace att {
constexpr int NW = 8, QBLK = 32, KVBLK = 64, QB = 256, OP = 2048;
constexpr int KPITCH = 144, VPITCH = 144;
constexpr int SHM_K = 2 * KVBLK * KPITCH, SHM_V = HD * VPITCH;
constexpr int LDS_BYTES = 2 * SHM_V + 2 * SHM_K + NW * 64 * 4;
constexpr float SCALE = 0.08838834764831845f, THR = 4.f;
constexpr int O8_SHIFT = 4;
constexpr int KM_SHIFT = 4;
#define SBAR() __builtin_amdgcn_sched_barrier(0)
typedef pg8::v8i v8i; typedef pg8::v4i v4i;
__device__ __forceinline__ v8i cat32(v4i a, v4i b) { return __builtin_shufflevector(a, b, 0, 1, 2, 3, 4, 5, 6, 7); }
__device__ __forceinline__ v4i ld16(const unsigned char* p) { return *reinterpret_cast<const v4i*>(p); }
__device__ __forceinline__ f32x16 mma8(v8i a, v8i b, f32x16 c) { return __builtin_amdgcn_mfma_scale_f32_32x32x64_f8f6f4(a, b, c, 0, 0, 0, 127, 0, 127); }
__device__ __forceinline__ int crow(int r, int hi) { return (r & 3) + 8 * (r >> 2) + 4 * hi; }
__device__ __forceinline__ void mask_tile(f32x16& p0, f32x16& p1, int dq) {
    const float NEG = -__builtin_inff();
#pragma unroll
    for (int r = 0; r < 16; ++r) {
        const int c = (r & 3) + 8 * (r >> 2);
        if (dq - c < 0) p0[r] = NEG;
        if (dq - c - 32 < 0) p1[r] = NEG;
    }
}
__device__ __forceinline__ void partialSM(f32x16& p0, f32x16& p1, float& m_reg, float& mn, float& alpha, bool keep) {
    float pmax = p0[0];
#pragma unroll
    for (int r = 1; r < 16; ++r) pmax = fmaxf(pmax, p0[r]);
#pragma unroll
    for (int r = 0; r < 16; ++r) pmax = fmaxf(pmax, p1[r]);
    { auto rr = __builtin_amdgcn_permlane32_swap(__float_as_uint(pmax), __float_as_uint(pmax), false, false);
      pmax = fmaxf(__uint_as_float(rr[0]), __uint_as_float(rr[1])); }
    const float NEG = -__builtin_inff();
    pmax = keep ? pmax : NEG;
    constexpr float C2 = 1.4426950408889634f * SCALE;
    if (__builtin_expect(__all((pmax - m_reg) * SCALE <= THR), 1)) { mn = m_reg; alpha = 1.f; }
    else { mn = fmaxf(m_reg, pmax); alpha = __builtin_amdgcn_exp2f((m_reg - mn) * C2); m_reg = mn; }
    const float c2l = keep ? C2 : 0.f;
    const float mnL = keep ? -mn * C2 : NEG;
#pragma unroll
    for (int r = 0; r < 16; ++r) p0[r] = fmaf(p0[r], c2l, mnL);
#pragma unroll
    for (int r = 0; r < 16; ++r) p1[r] = fmaf(p1[r], c2l, mnL);
#pragma unroll
    for (int r = 0; r < 16; ++r) p0[r] = __builtin_amdgcn_exp2f(p0[r]);
}
__device__ __forceinline__ void finishSM(f32x16& p0, f32x16& p1, float alpha, float& l_reg, v8i& pf) {
#pragma unroll
    for (int r = 0; r < 16; ++r) p1[r] = __builtin_amdgcn_exp2f(p1[r]);
    float ps = 0;
#pragma unroll
    for (int r = 0; r < 16; ++r) ps += p0[r];
#pragma unroll
    for (int r = 0; r < 16; ++r) ps += p1[r];
    { auto rr = __builtin_amdgcn_permlane32_swap(__float_as_uint(ps), __float_as_uint(ps), false, false);
      ps = __uint_as_float(rr[0]) + __uint_as_float(rr[1]); }
    l_reg = l_reg * alpha + ps;
#pragma unroll
    for (int q = 0; q < 4; ++q) { pf[q] = (int)pk_fp8x4(p0[4 * q], p0[4 * q + 1], p0[4 * q + 2], p0[4 * q + 3]); pf[4 + q] = (int)pk_fp8x4(p1[4 * q], p1[4 * q + 1], p1[4 * q + 2], p1[4 * q + 3]); }
}
template <int SUB>
__device__ __forceinline__ void qkt(int KB, f32x16& p0, f32x16& p1, const unsigned char* K_lds, int r32, int hi, const v8i* qf) {
    p0 = f32x16{}; p1 = f32x16{};
    const unsigned char* kb = K_lds + KB * SHM_K + (SUB * KVBLK + r32) * KPITCH + hi * 32;
#pragma unroll
    for (int ks = 0; ks < 2; ++ks) {
        const v8i a0 = cat32(ld16(kb + ks * 64), ld16(kb + ks * 64 + 16)), a1 = cat32(ld16(kb + 32 * KPITCH + ks * 64), ld16(kb + 32 * KPITCH + ks * 64 + 16));
        p0 = mma8(a0, qf[ks], p0); p1 = mma8(a1, qf[ks], p1); }
}
template <int SUB>
__device__ __forceinline__ void pv_tile(int VB, f32x16* o, const unsigned char* V_lds, int r32, int hi, v8i pf) {
    const unsigned char* vb = V_lds + VB * SHM_V + r32 * VPITCH + SUB * KVBLK + hi * 32;
#pragma unroll
    for (int d0 = 0; d0 < 4; ++d0) { const v8i a = cat32(ld16(vb + d0 * 32 * VPITCH), ld16(vb + d0 * 32 * VPITCH + 16)); o[d0] = mma8(a, pf, o[d0]); }
}
__device__ __forceinline__ unsigned moba_sel(const v8i* qf, const unsigned char* KM, int qb, int r32, int hi) {
    f32x16 g = f32x16{}; const unsigned char* kp = KM + (r32 & 15) * HD + hi * 32;
#pragma unroll
    for (int ks = 0; ks < 2; ++ks) g = mma8(cat32(ld16(kp + ks * 64), ld16(kp + ks * 64 + 16)), qf[ks], g);
    float v[16];
#pragma unroll
    for (int r = 0; r < 8; ++r) { const float mine = g[r], oth = __shfl_xor(mine, 32); const int base = (r & 3) + 8 * (r >> 2);
        v[base] = hi ? oth : mine; v[base + 4] = hi ? mine : oth; }
#pragma unroll
    for (int n = 0; n < 16; ++n) v[n] = (n < qb) ? v[n] : -1e30f;
    unsigned sel = 0u;
#pragma unroll
    for (int pass = 0; pass < 3; ++pass) {
        float best = v[0]; int bi = 0;
#pragma unroll
        for (int n = 1; n < 16; ++n) { const bool gt = v[n] > best; best = gt ? v[n] : best; bi = gt ? n : bi; }
        if (best > -1e29f) sel |= 1u << bi;
#pragma unroll
        for (int n = 0; n < 16; ++n) v[n] = (n == bi) ? -__builtin_inff() : v[n];
    }
    return sel;
}
struct BlockRef { const unsigned char* Q; const unsigned char* K; const unsigned char* V; unsigned char* O; const unsigned char* KM; int qb; };
struct Seam { v8i qf[2]; v4i st_k[2], st_v[2]; };
__device__ __forceinline__ BlockRef make_ref(unsigned char* ws, int vcu, int k) {
    const int x8 = vcu & 7, bh = (k < 2) ? (vcu >> 3) : 32 + (vcu >> 3), qb = (k & 1) ? 15 - x8 : x8, b = bh >> 4, h = bh & 15;
    BlockRef r; r.Q = ws + WS_Q8 + ((size_t)bh * SEQ + (size_t)qb * 256) * HD; r.K = ws + WS_K8 + (size_t)bh * SEQ * HD; r.V = ws + WS_VT8 + (size_t)bh * HD * SEQ;
    r.O = ws + WS_O8 + ((size_t)(b * SEQ + qb * 256)) * OP + h * HD; r.KM = ws + WS_KM + (size_t)bh * 16 * HD; r.qb = qb; return r;
}
#define VMW() asm volatile("s_waitcnt vmcnt(0)" ::: "memory")
#define VMWN(n) asm volatile("s_waitcnt vmcnt(%0)" :: "i"(n) : "memory")
#define SLOAD_H(Kp, Vp, k0) do { const unsigned char* kp_ = (Kp) + (size_t)(k0) * HD + klo; const unsigned char* vp_ = (Vp) + (size_t)(k0) + vlo; \
        S.st_k[0] = ld16(kp_); S.st_k[1] = ld16(kp_ + KVBLK * HD); S.st_v[0] = ld16(vp_); S.st_v[1] = ld16(vp_ + KVBLK); } while (0)
#define SWRITE_HK(bf) do { *(v4i*)(K_lds + (bf) * SHM_K + kws) = S.st_k[0]; *(v4i*)(K_lds + (bf) * SHM_K + kws + KVBLK * KPITCH) = S.st_k[1]; } while (0)
#define SWRITE_HV(bf) do { _Pragma("unroll") for (int i_ = 0; i_ < 2; ++i_) { unsigned char* vd_ = V_lds + (bf) * SHM_V + vws + i_ * KVBLK; \
        *(int*)(vd_) = S.st_v[i_][0]; *(int*)(vd_ + 32) = S.st_v[i_][1]; *(int*)(vd_ + 4) = S.st_v[i_][2]; *(int*)(vd_ + 36) = S.st_v[i_][3]; } } while (0)
#define SWRITE_H(bf) do { SWRITE_HV(bf); SWRITE_HK(bf); } while (0)
#define QLOAD(Qp) do { const unsigned char* qp_ = (Qp) + qoff; S.qf[0] = cat32(ld16(qp_), ld16(qp_ + 16)); S.qf[1] = cat32(ld16(qp_ + 64), ld16(qp_ + 80)); } while (0)
#define ATT_GEOM() const int wid = __builtin_amdgcn_readfirstlane(tid >> 6), lane = tid & 63, r32 = lane & 31, hi = lane >> 5; \
    const unsigned klo = (unsigned)((tid >> 3) * HD + (tid & 7) * 16), kws = (unsigned)((tid >> 3) * KPITCH + (tid & 7) * 16); \
    const unsigned vlo = (unsigned)((tid >> 2) * SEQ + (tid & 3) * 16), vws = (unsigned)((tid >> 2) * VPITCH + (tid & 3) * 8); \
    const unsigned qoff = (unsigned)((wid * QBLK + r32) * HD + hi * 32); \
    unsigned char* V_lds = (unsigned char*)lds; unsigned char* K_lds = (unsigned char*)lds + 2 * SHM_V
__device__ __forceinline__ void moba_prime(const BlockRef& cur, char* lds, Seam& S, const int tid) {
    ATT_GEOM(); (void)V_lds; (void)vws;
    QLOAD(cur.Q);
    SLOAD_H(cur.K, cur.V, 0); VMW(); SWRITE_HK(0);
    __syncthreads();
}
__device__ __forceinline__ void moba_block(const BlockRef& cur, const BlockRef& nxt, char* lds, Seam& S, const int tid) {
    ATT_GEOM();
    const int qb = cur.qb, NS = 2 * (qb + 1);
    const int qlo = qb * QB + wid * QBLK;
    unsigned* sel_l = (unsigned*)(lds + 2 * SHM_V + 2 * SHM_K) + wid * 64;
    { const unsigned sel0 = (qb > 0) ? moba_sel(S.qf, cur.KM, qb, r32, hi) : 0u; if (hi == 0) sel_l[r32] = sel0; }
    float m_reg = -1e30f, l_reg = 0; f32x16 o[4] = {};
    const unsigned char* Kh = cur.K; const unsigned char* Vh = cur.V;
#define RESC(a) do { if (__any((a) < 1.f)) { for (int d_ = 0; d_ < 4; ++d_) for (int r = 0; r < 16; ++r) o[d_][r] *= (a); } } while (0)
#define KBASE(t) ((t) * KVBLK)
#define KEEP(t) ((((t) >> 2) >= qb) || (((sel_l[r32] >> ((t) >> 2)) & 1u) != 0u))
#define MASKT(P0_, P1_, t) do { const int kb_ = KBASE(t); if (kb_ + KVBLK - 1 > qlo) mask_tile(P0_, P1_, qlo - kb_ + r32 - 4 * hi); } while (0)
    f32x16 pA0, pA1, pB0, pB1; float mnA, mnB, alA, alB; v8i pf;
#define STEP_A(T_, B_, LOADNEXT) do { SBAR(); qkt<0>(B_, pA0, pA1, K_lds, r32, hi, S.qf); finishSM(pB0, pB1, alB, l_reg, pf); SBAR(); \
        if (LOADNEXT) { SLOAD_H(Kh, Vh, KBASE(2 * (T_) + 2)); SBAR(); } \
        pv_tile<1>(1 - (B_), o, V_lds, r32, hi, pf); MASKT(pA0, pA1, 2 * (T_)); partialSM(pA0, pA1, m_reg, mnA, alA, KEEP(2 * (T_))); RESC(alA); } while (0)
#define STEP_B(T_, B_, WRITENEXT) do { SBAR(); qkt<1>(B_, pB0, pB1, K_lds, r32, hi, S.qf); finishSM(pA0, pA1, alA, l_reg, pf); SBAR(); \
        pv_tile<0>(B_, o, V_lds, r32, hi, pf); MASKT(pB0, pB1, 2 * (T_) + 1); partialSM(pB0, pB1, m_reg, mnB, alB, KEEP(2 * (T_) + 1)); \
        if (WRITENEXT) { __syncthreads(); VMW(); SWRITE_H(1 - (B_)); RESC(alB); __syncthreads(); } else { RESC(alB); } } while (0)
    SWRITE_HV(0); SBAR();
    SLOAD_H(Kh, Vh, KBASE(2));
    SBAR(); qkt<0>(0, pA0, pA1, K_lds, r32, hi, S.qf);
    MASKT(pA0, pA1, 0); partialSM(pA0, pA1, m_reg, mnA, alA, KEEP(0));
    __syncthreads();
    STEP_B(0, 0, true);
    for (int T_ = 1; T_ + 1 < NS; ++T_) { const int bsel = T_ & 1; STEP_A(T_, bsel, true); STEP_B(T_, bsel, true); }
    STEP_A(NS - 1, 1, false);
    SBAR(); qkt<1>(1, pB0, pB1, K_lds, r32, hi, S.qf); SBAR();
    SLOAD_H(nxt.K, nxt.V, 0); SBAR();
    QLOAD(nxt.Q);
    SBAR();
    finishSM(pA0, pA1, alA, l_reg, pf); SBAR();
    pv_tile<0>(1, o, V_lds, r32, hi, pf);
    MASKT(pB0, pB1, 2 * NS - 1); partialSM(pB0, pB1, m_reg, mnB, alB, true); RESC(alB);
    finishSM(pB0, pB1, alB, l_reg, pf); SBAR(); pv_tile<1>(1, o, V_lds, r32, hi, pf);
    SBAR(); VMWN(4); SWRITE_HK(0); SBAR();
    { const float rl = __builtin_amdgcn_rcpf(l_reg) * (float)(1 << O8_SHIFT);
      int r32e = r32, hie = hi; asm volatile("" : "+v"(r32e), "+v"(hie));
      unsigned char* Ow = cur.O + (size_t)(wid * QBLK + r32e) * OP + 4 * hie;
#pragma unroll
      for (int d0 = 0; d0 < 4; ++d0)
#pragma unroll
          for (int g4 = 0; g4 < 4; ++g4) *(unsigned*)(Ow + d0 * 32 + 8 * g4) = pk_fp8x4(o[d0][4 * g4] * rl, o[d0][4 * g4 + 1] * rl, o[d0][4 * g4 + 2] * rl, o[d0][4 * g4 + 3] * rl); }
    __syncthreads();
#undef RESC
#undef KBASE
#undef KEEP
#undef MASKT
#undef STEP_A
#undef STEP_B
}
#undef VMW
#undef VMWN
#undef SLOAD_H
#undef SWRITE_HK
#undef SWRITE_HV
#undef SWRITE_H
#undef QLOAD
#undef ATT_GEOM
}

struct Args { const float* in[23]; float* out; unsigned char* ws; };
typedef const __attribute__((address_space(4))) Args* ArgsP;
__device__ __forceinline__ int ltid(int wave0) { int l; asm volatile("v_mbcnt_lo_u32_b32 %0, -1, 0\n\tv_mbcnt_hi_u32_b32 %0, -1, %0" : "=v"(l)); return (wave0 << 6) | l; }
__device__ __forceinline__ ArgsP kargs() { ArgsP p = (ArgsP)__builtin_amdgcn_kernarg_segment_ptr(); asm volatile("" : "+s"(p)); return p; }
#define WSP(T_, off) ((T_*)(ws + (off)))

struct ConvUnit { const float* W; void* WT; int ldw, ldt, k0, n0, kind, add; };
__device__ __forceinline__ int conv_row(const ConvUnit& c, int n) {
    if (c.kind == 2) { if (n >= 6144) return n - 2048; const int p = n & 127; return (n & ~127) + 2 * (p & 63) + (p >> 6) - 2048; }
    if (c.kind == 3) return (n >> 2) * 8 + (n & 3) + c.add;
    return n;
}
constexpr int CBUF = 65536, OP8 = 144, OP16 = 272;
__device__ __forceinline__ void conv_dma(const ConvUnit& c, int wave, int lane, LAS unsigned char* buf) {
    const float* Wl = c.W + (size_t)(c.k0 + 16 * wave + (lane >> 5)) * c.ldw + c.n0 + 4 * (lane & 31);
#pragma unroll
    for (int i = 0; i < 8; ++i) __builtin_amdgcn_global_load_lds((const unsigned*)(Wl + (size_t)(2 * i) * c.ldw), (LAS unsigned*)(buf + (16 * wave + 2 * i) * 512), 16, 0, 0);
}
__device__ __forceinline__ void conv_read(int wave, int lane, const LAS unsigned char* buf, float (&f)[32]) {
    const LAS float* p = (const LAS float*)(buf + (16 * wave) * 512 + 4 * lane);
#pragma unroll
    for (int i = 0; i < 16; ++i) { f[i] = p[i * 128]; f[16 + i] = p[i * 128 + 64]; }
}
__device__ __forceinline__ void conv_park8(int wave, int lane, LAS unsigned char* img, const float (&f)[32]) {
    constexpr float SC = (float)(1 << pg8::W8_SHIFT);
#pragma unroll
    for (int h = 0; h < 2; ++h) { v4u o; o.x = pk_fp8x4(f[16 * h] * SC, f[16 * h + 1] * SC, f[16 * h + 2] * SC, f[16 * h + 3] * SC); o.y = pk_fp8x4(f[16 * h + 4] * SC, f[16 * h + 5] * SC, f[16 * h + 6] * SC, f[16 * h + 7] * SC);
        o.z = pk_fp8x4(f[16 * h + 8] * SC, f[16 * h + 9] * SC, f[16 * h + 10] * SC, f[16 * h + 11] * SC); o.w = pk_fp8x4(f[16 * h + 12] * SC, f[16 * h + 13] * SC, f[16 * h + 14] * SC, f[16 * h + 15] * SC);
        *(LAS v4u*)(img + (lane + 64 * h) * OP8 + 16 * wave) = o; }
}
__device__ __forceinline__ void conv_out8(const ConvUnit& c, int tid, const LAS unsigned char* img) {
#pragma unroll
    for (int j = 0; j < 2; ++j) { const int row = (tid >> 3) + 64 * j, ch = tid & 7; const v4u v = *(const LAS v4u*)(img + row * OP8 + 16 * ch);
        *(v4u*)((unsigned char*)c.WT + (size_t)conv_row(c, c.n0 + row) * c.ldt + c.k0 + 16 * ch) = v; }
}
__device__ __forceinline__ void conv_park16(int wave, int lane, LAS unsigned char* img, const float (&f)[32], const int h) {
    v4u o0, o1; o0.x = pk2(f[16 * h], f[16 * h + 1]); o0.y = pk2(f[16 * h + 2], f[16 * h + 3]); o0.z = pk2(f[16 * h + 4], f[16 * h + 5]); o0.w = pk2(f[16 * h + 6], f[16 * h + 7]);
    o1.x = pk2(f[16 * h + 8], f[16 * h + 9]); o1.y = pk2(f[16 * h + 10], f[16 * h + 11]); o1.z = pk2(f[16 * h + 12], f[16 * h + 13]); o1.w = pk2(f[16 * h + 14], f[16 * h + 15]);
    LAS unsigned char* q = img + lane * OP16 + 32 * wave; *(LAS v4u*)q = o0; *(LAS v4u*)(q + 16) = o1;
}
__device__ __forceinline__ void conv_out16(const ConvUnit& c, int tid, const LAS unsigned char* img, const int h) {
#pragma unroll
    for (int j = 0; j < 2; ++j) { const int row = (tid >> 4) + 32 * j, ch = tid & 15; const v4u v = *(const LAS v4u*)(img + row * OP16 + 16 * ch);
        *(v4u*)((bf16*)c.WT + (size_t)conv_row(c, c.n0 + 64 * h + row) * c.ldt + c.k0 + 8 * ch) = v; }
}
constexpr int NCONV = 8320;
__device__ __forceinline__ ConvUnit conv_decode(int u, ArgsP A, unsigned char* ws) {
    ConvUnit c; c.add = 0;
    if (u < 1536) { const int kp = u / 96, g = u - kp * 96; c.W = A->in[6]; c.ldw = INC; c.k0 = kp * 128; c.n0 = g * 128; c.ldt = D;
        if (g < 16) { c.WT = ws + WS_WINZ; c.kind = 0; } else { c.WT = ws + WS_WIN8; c.kind = 2; } return c; }
    u -= 1536;
    if (u < 128) { c.W = A->in[11]; c.ldw = D; c.k0 = (u >> 4) * 128; c.n0 = (u & 15) * 128; c.WT = ws + WS_WSO; c.ldt = SGW; c.kind = 0; return c; }
    u -= 128;
    if (u < 256) { c.W = A->in[12]; c.ldw = D; c.k0 = (u >> 4) * 128; c.n0 = (u & 15) * 128; c.WT = ws + WS_WMO8; c.ldt = D; c.kind = 1; return c; }
    u -= 256;
    if (u < 256) { c.W = A->in[13]; c.ldw = D; c.k0 = (u >> 4) * 128; c.n0 = (u & 15) * 128; c.WT = ws + WS_WOUT; c.ldt = D; c.kind = 1; return c; }
    u -= 256;
    const int m = u >> 11, r = u & 2047, e = r >> 6, q = r & 63;
    if (m < 2) { c.W = A->in[19 + m] + (size_t)e * D * DFF; c.ldw = DFF; c.k0 = (q >> 2) * 128; c.n0 = (q & 3) * 128; c.WT = ws + WS_WGU8 + (size_t)e * 1024 * D; c.ldt = D; c.kind = 3; c.add = 4 * m; return c; }
    c.W = A->in[21] + (size_t)e * DFF * D; c.ldw = D; c.k0 = (q >> 4) * 128; c.n0 = (q & 15) * 128; c.WT = ws + WS_WD8 + (size_t)e * D * DFF; c.ldt = DFF; c.kind = 1; return c;
}
constexpr int NCONV_EARLY = 1536;
__device__ __forceinline__ void conv_run(LAS unsigned char* lds, const int tid, const int wave, const int lane, int u, const int uend) {
    float f[32];
    LAS unsigned char* b0 = lds; LAS unsigned char* b1 = lds + CBUF; LAS unsigned char* img = lds + TAB_OFF;
#define CONV_CLAMP(x) ((x) < uend ? (x) : uend - 1)
#define CONV_BAR() do { asm volatile("s_waitcnt lgkmcnt(0)" ::: "memory"); __builtin_amdgcn_s_barrier(); asm volatile("" ::: "memory"); } while (0)
#define CONV_STEP(N, buf) do { \
        asm volatile("s_waitcnt vmcnt(" #N ")" ::: "memory"); __builtin_amdgcn_s_barrier(); asm volatile("" ::: "memory"); \
        conv_read(wave, lane, buf, f); CONV_BAR(); \
        { ArgsP Ai = kargs(); const ConvUnit cn = conv_decode(CONV_CLAMP(u + 512), Ai, Ai->ws); conv_dma(cn, wave, lane, buf); } \
        { ArgsP Ai = kargs(); const ConvUnit c = conv_decode(u, Ai, Ai->ws); \
          if (c.kind != 0) { conv_park8(wave, lane, img, f); CONV_BAR(); conv_out8(c, tid, img); } \
          else { conv_park16(wave, lane, img, f, 0); CONV_BAR(); conv_out16(c, tid, img, 0); CONV_BAR(); conv_park16(wave, lane, img, f, 1); CONV_BAR(); conv_out16(c, tid, img, 1); } } \
        u += 256; } while (0)
    { ArgsP Ai = kargs(); const ConvUnit c = conv_decode(u, Ai, Ai->ws); conv_dma(c, wave, lane, b0); }
    { ArgsP Ai = kargs(); const ConvUnit c = conv_decode(CONV_CLAMP(u + 256), Ai, Ai->ws); conv_dma(c, wave, lane, b1); }
    CONV_STEP(8, b0);
    if (u < uend) { CONV_STEP(10, b1);
        for (;;) {
            if (u >= uend) break; CONV_STEP(12, b0);
            if (u >= uend) break; CONV_STEP(12, b1);
        } }
    asm volatile("s_waitcnt vmcnt(0)" ::: "memory");
    __builtin_amdgcn_s_barrier();
#undef CONV_STEP
#undef CONV_BAR
#undef CONV_CLAMP
}

__global__ void __launch_bounds__(NWAVES * 64, 2) fwd_kernel(Args args) {
    extern __shared__ __attribute__((aligned(16))) unsigned char lds_raw[];
    LAS unsigned char* lds = (LAS unsigned char*)lds_raw;
    const int wave0 = __builtin_amdgcn_readfirstlane((int)threadIdx.x >> 6);
    constexpr int G = 256;
#define BX ((int)blockIdx.x)
#define VCU (((int)blockIdx.x & 7) * 32 + ((int)blockIdx.x >> 3))
    volatile LAS unsigned* MISC = (volatile LAS unsigned*)(lds + MISC_OFF);
    for (int u = ltid(wave0); u < (LDS_BYTES - LDSCTL_OFF) / 4; u += NWAVES * 64) ((LAS unsigned*)(lds + LDSCTL_OFF))[u] = 0u;
    __syncthreads();
    (void)xcd_barrier_post((unsigned*)(args.ws + WS_CTL) + CW_BAR, MISC + 8, ltid(wave0));
#define GRID_BAR() do { XcdBarrier b_; b_.bar = (unsigned*)(kargs()->ws + WS_CTL) + CW_BAR; b_.x = xb_xcc_id(); b_.st = (volatile LAS unsigned*)(lds + MISC_OFF) + 8; xcd_barrier(b_, ltid(wave0)); } while (0)

    DUPLOOP(0) {
    {
        ArgsP A = kargs(); unsigned char* ws = A->ws; const int tid = ltid(wave0), lane = tid & 63, wave = __builtin_amdgcn_readfirstlane(tid >> 6); (void)lane; (void)wave; gu32* ctl = (gu32*)(ws + WS_CTL);
        const float* cin = A->in[1];
        LAS float* cact = (LAS float*)(lds + 98304);
        for (int i = tid; i < BATCH * D; i += NWAVES * 64) { const float v = cin[i]; cact[i] = v / (1.0f + __expf(-v)); }
        __syncthreads();
        { const int it = (wave < 6) ? VCU * 6 + wave : 1536 + VCU * 2 + (wave - 6); ArgsP Ai = kargs(); unsigned char* wsi = Ai->ws;
            if (it < 1536) {
                const int qd = it / 384, col = (it - qd * 384) * 32 + 4 * (lane & 7), rq = lane >> 3;
                f32x4 a0 = {0.f, 0.f, 0.f, 0.f}, a1 = a0, a2 = a0, a3 = a0;
                for (int k0 = qd * 512; k0 < qd * 512 + 512; k0 += 256) {
                    f32x4 w[32];
#pragma unroll
                    for (int i = 0; i < 32; ++i) w[i] = *(const f32x4*)(Ai->in[3] + (size_t)(k0 + rq + 8 * i) * 12288 + col);
#pragma unroll
                    for (int i = 0; i < 32; ++i) { const int k = k0 + rq + 8 * i;
                        a0 += cact[k] * w[i]; a1 += cact[D + k] * w[i]; a2 += cact[2 * D + k] * w[i]; a3 += cact[3 * D + k] * w[i]; }
                }
#pragma unroll
                for (int e = 0; e < 4; ++e)
#pragma unroll
                    for (int o = 8; o < 64; o <<= 1) { a0[e] += __shfl_xor(a0[e], o); a1[e] += __shfl_xor(a1[e], o); a2[e] += __shfl_xor(a2[e], o); a3[e] += __shfl_xor(a3[e], o); }
                if (rq == 0) { const f32x4 bb = (qd == 0) ? *(const f32x4*)(Ai->in[4] + col) : (f32x4){0.f, 0.f, 0.f, 0.f}; float* ap = ((float*)(wsi + WS_ADAP)) + (size_t)qd * 49152 + col;
                    *(f32x4*)(ap) = a0 + bb; *(f32x4*)(ap + 12288) = a1 + bb; *(f32x4*)(ap + 2 * 12288) = a2 + bb; *(f32x4*)(ap + 3 * 12288) = a3 + bb; }
            } else if (it < 1792) {
                const int tok = (it - 1536) * 64 + lane; const double pos = (double)((const int*)Ai->in[2])[tok];
                float* cosT = (float*)(wsi + WS_COS); float* sinT = (float*)(wsi + WS_SIN);
                double inv = 1.0;
                for (int j = 0; j < 64; ++j) {
                    const double rev = pos * inv * 0.15915494309189535;
                    const float fr = (float)(rev - __builtin_floor(rev));
                    cosT[(size_t)tok * 64 + j] = __builtin_amdgcn_cosf(fr); sinT[(size_t)tok * 64 + j] = __builtin_amdgcn_sinf(fr);
                    inv *= 0.8659643233600653;
                }
            } else if (it < 1824) {
                const int g = (it - 1792) >> 2, part = (it - 1792) & 3; bf16* WSb = (bf16*)(wsi + WS_WS);
                for (int i = part * 4096 + lane; i < part * 4096 + 4096; i += 64) { const int r = i >> 7, c = i & 127; WSb[g * 16384 + i] = (c <= r) ? (bf16)f2bf(Ai->in[9][g * 16384 + i]) : (bf16)0; }
            } else if (it < 2016) {
                const int q = it - 1824, u = q & 7, n0 = (q >> 3) * 2; bf16* RT = (bf16*)(wsi + WS_RT);
#pragma unroll
                for (int nn = 0; nn < 2; ++nn) { const int n = n0 + nn;
#pragma unroll
                    for (int i = 0; i < 4; ++i) { const int k = u * 256 + lane + 64 * i; const float w = (n < 4) ? Ai->in[15][k * 4 + n] : (n < 36) ? Ai->in[17][k * 32 + (n - 4)] : 0.f;
                        const unsigned hi = f2bf(w); const int ks = k >> 5, kk = k & 31; RT[((ks * 2) * 48 + n) * 32 + kk] = (bf16)hi; RT[((ks * 2 + 1) * 48 + n) * 32 + kk] = (bf16)f2bf(w - __builtin_bit_cast(float, hi << 16)); } }
            }
        }
        __syncthreads();
        conv_run(lds, tid, wave, lane, VCU, NCONV_EARLY);
    }
    GRID_BAR();
    }

    DUPLOOP(1) {
    {
        ArgsP A = kargs(); unsigned char* ws = A->ws; const int tid = ltid(wave0), lane = tid & 63, wave = __builtin_amdgcn_readfirstlane(tid >> 6); (void)lane; (void)wave;
        const float* x = A->in[0]; const float* g_mix = A->in[5]; const float* adap = WSP(float, WS_ADAP); float* adaf = WSP(float, WS_ADA); bf16* Nb = WSP(bf16, WS_N); unsigned char* N8 = ws + WS_N1F8;
        LAS float* tg = (LAS float*)(lds); LAS float* tb = (LAS float*)(lds + 8192);
        const int row0 = VCU * 64, b = row0 >> 12;
        for (int i = tid; i < D; i += NWAVES * 64) { const float* ap = adap + b * 12288 + i;
            tg[i] = g_mix[i] * (1.0f + ((ap[2048] + ap[49152 + 2048]) + (ap[2 * 49152 + 2048] + ap[3 * 49152 + 2048]))); tb[i] = (ap[0] + ap[49152]) + (ap[2 * 49152] + ap[3 * 49152]); }
        if (tid < 192) { const int i = VCU * 192 + tid; adaf[i] = (adap[i] + adap[49152 + i]) + (adap[2 * 49152 + i] + adap[3 * 49152 + i]); }
        __syncthreads();
        for (int rq = 0; rq < 2; ++rq) {
            f32x4 v[4][8];
#pragma unroll
            for (int q = 0; q < 4; ++q) { const f32x4* xr = (const f32x4*)(x + (size_t)(row0 + wave * 8 + rq * 4 + q) * D) + lane;
#pragma unroll
                for (int j = 0; j < 8; ++j) v[q][j] = xr[64 * j]; }
#pragma unroll
            for (int q = 0; q < 4; ++q) { const int row = row0 + wave * 8 + rq * 4 + q; float ss = 0.f;
#pragma unroll
                for (int j = 0; j < 8; ++j) ss += (v[q][j].x * v[q][j].x + v[q][j].y * v[q][j].y) + (v[q][j].z * v[q][j].z + v[q][j].w * v[q][j].w);
                const float rstd = rsqrtf(wave_sum(ss) * (1.f / D) + EPS);
                v2u* o8 = (v2u*)(Nb + (size_t)row * D) + lane;
#pragma unroll
                for (int j = 0; j < 8; ++j) { const f32x4 gg = *(const LAS f32x4*)(tg + 4 * lane + 256 * j), bb = *(const LAS f32x4*)(tb + 4 * lane + 256 * j);
                    const f32x4 y = v[q][j] * rstd * gg + bb; v2u w; w.x = cvt_pk_bf16(y.x, y.y); w.y = cvt_pk_bf16(y.z, y.w); o8[64 * j] = w;
                    *((unsigned*)(N8 + (size_t)row * D) + lane + 64 * j) = pk_fp8x4(y.x, y.y, y.z, y.w); } }
        }
    }
    GRID_BAR();
    }

    DUPLOOP(2) {
    {
        ArgsP A = kargs(); unsigned char* ws = A->ws; const int tid = ltid(wave0), lane = tid & 63, wave = __builtin_amdgcn_readfirstlane(tid >> 6); (void)lane; (void)wave;
        bf16* Nb = WSP(bf16, WS_N); bf16* UV = WSP(bf16, WS_UV); unsigned char* Qh = ws + WS_Q8; unsigned char* Kh = ws + WS_K8; unsigned char* Vh = ws + WS_VT8;
        bf16* SAg = WSP(bf16, WS_SA); bf16* SBg = WSP(bf16, WS_SB); const float* cosT = WSP(float, WS_COS); const float* sinT = WSP(float, WS_SIN);
        { pg8::StaticOrder S; S.init(T, 2048, D * 2, G, BX, ws + WS_WINZ);
          pg8::EpiInProj E{UV, Qh, Kh, Vh, SAg, SBg, cosT, sinT, 0};
          pg8::gemm_phase<false>(lds, (const char*)Nb, D * 2, S, E, tid); }
        { pg8::StaticOrder S; S.init(T, 10240, D, G, BX, ws + WS_WIN8);
          pg8::EpiInProj E{UV, Qh, Kh, Vh, SAg, SBg, cosT, sinT, 8};
          pg8::gemm_phase<true>(lds, (const char*)(ws + WS_N1F8), D, S, E, tid); }
    }
    GRID_BAR();
    }

    DUPLOOP(3) {
    {
        ArgsP A = kargs(); unsigned char* ws = A->ws; const int tid = ltid(wave0), lane = tid & 63, wave = __builtin_amdgcn_readfirstlane(tid >> 6); (void)lane; (void)wave;
        const float* sgu_ln_g = A->in[7]; const float* sgu_ln_b = A->in[8]; const float* sgu_b_s = A->in[10];
        const bf16* UV = WSP(bf16, WS_UV); const bf16* WSb = WSP(bf16, WS_WS); bf16* SGUO = WSP(bf16, WS_SGUO); const unsigned char* K8 = ws + WS_K8; unsigned char* KM = ws + WS_KM;
        constexpr int VP = 136;
        LAS bf16* vT = (LAS bf16*)lds; LAS f32x2* st = (LAS f32x2*)(lds + 2 * 128 * VP * 2); LAS float* kx = (LAS float*)(lds + 73728);
        { const int item = VCU * NWAVES + wave, blk = item >> 1, half = item & 1, c8 = (lane & 15) * 8, r0 = lane >> 4;
          const unsigned char* kp = K8 + ((size_t)blk * 256 + half * 128 + r0) * HD + c8;
          float sacc[8] = {0.f, 0.f, 0.f, 0.f, 0.f, 0.f, 0.f, 0.f};
          { v2u w[32];
#pragma unroll
              for (int u = 0; u < 32; ++u) w[u] = *(const v2u*)(kp + (size_t)(4 * u) * HD);
#pragma unroll
              for (int u = 0; u < 32; ++u) { const f32x2 a0 = __builtin_amdgcn_cvt_pk_f32_fp8((int)w[u].x, false), a1 = __builtin_amdgcn_cvt_pk_f32_fp8((int)w[u].x, true), a2 = __builtin_amdgcn_cvt_pk_f32_fp8((int)w[u].y, false), a3 = __builtin_amdgcn_cvt_pk_f32_fp8((int)w[u].y, true);
                  sacc[0] += a0.x; sacc[1] += a0.y; sacc[2] += a1.x; sacc[3] += a1.y; sacc[4] += a2.x; sacc[5] += a2.y; sacc[6] += a3.x; sacc[7] += a3.y; } }
#pragma unroll
          for (int e = 0; e < 8; ++e) { sacc[e] += __shfl_xor(sacc[e], 16); sacc[e] += __shfl_xor(sacc[e], 32); }
          LAS float* kxp = kx + (wave >> 1) * 128 + c8;
          if (half == 1 && lane < 16) {
#pragma unroll
              for (int e = 0; e < 8; ++e) kxp[e] = sacc[e]; }
          __syncthreads();
          if (half == 0 && lane < 16) {
#pragma unroll
              for (int e = 0; e < 8; ++e) sacc[e] = (sacc[e] + kxp[e]) * ((float)(1 << att::KM_SHIFT) / 256.f);
              v2u o; o.x = pk_fp8x4(sacc[0], sacc[1], sacc[2], sacc[3]); o.y = pk_fp8x4(sacc[4], sacc[5], sacc[6], sacc[7]);
              *(v2u*)(KM + (size_t)blk * HD + c8) = o; } }
        {
            const int ch = VCU >> 1, hf = VCU & 1, R0 = ch * 128;
            v4u aa[4][8];
#pragma unroll
            for (int it4 = 0; it4 < 4; ++it4) { const v4u* vp = (const v4u*)(UV + (size_t)(R0 + wave * 16 + it4 * 4 + (lane >> 4)) * D + SGW) + (lane & 15);
#pragma unroll
                for (int q = 0; q < 8; ++q) aa[it4][q] = vp[16 * q]; }
#pragma unroll
            for (int it4 = 0; it4 < 4; ++it4) { const int j = wave * 16 + it4 * 4 + (lane >> 4);
                const v4u (&a)[8] = aa[it4];
                float s = 0.f;
#pragma unroll
                for (int q = 0; q < 8; ++q) s += ((bflo(a[q].x) + bfhi(a[q].x)) + (bflo(a[q].y) + bfhi(a[q].y))) + ((bflo(a[q].z) + bfhi(a[q].z)) + (bflo(a[q].w) + bfhi(a[q].w)));
#pragma unroll
                for (int o = 1; o < 16; o <<= 1) s += __shfl_xor(s, o);
                const float mean = s * (1.f / SGW); float qv = 0.f;
#pragma unroll
                for (int q = 0; q < 8; ++q) { float d;
                    d = bflo(a[q].x) - mean; qv += d * d; d = bfhi(a[q].x) - mean; qv += d * d; d = bflo(a[q].y) - mean; qv += d * d; d = bfhi(a[q].y) - mean; qv += d * d;
                    d = bflo(a[q].z) - mean; qv += d * d; d = bfhi(a[q].z) - mean; qv += d * d; d = bflo(a[q].w) - mean; qv += d * d; d = bfhi(a[q].w) - mean; qv += d * d; }
#pragma unroll
                for (int o = 1; o < 16; o <<= 1) qv += __shfl_xor(qv, o);
                if ((lane & 15) == 0) st[j] = (f32x2){mean, rsqrtf(qv * (1.f / SGW) + EPS)};
            }
            __syncthreads();
            for (int ps = 0; ps < 2; ++ps) {
                const int gp = hf * 2 + ps;
                { const int j = lane + 64 * (wave & 1), cb = 64 * (wave >> 1); const f32x2 ms = st[j];
                  v4u a[8];
#pragma unroll
                  for (int cq = 0; cq < 8; ++cq) a[cq] = *(const v4u*)(UV + (size_t)(R0 + j) * D + SGW + gp * 256 + cb + 8 * cq);
#pragma unroll
                  for (int cq = 0; cq < 8; ++cq) { const int c0 = cb + 8 * cq, chn = gp * 256 + c0;
                      const f32x4 g0 = *(const f32x4*)(sgu_ln_g + chn), g1 = *(const f32x4*)(sgu_ln_g + chn + 4), b0 = *(const f32x4*)(sgu_ln_b + chn), b1 = *(const f32x4*)(sgu_ln_b + chn + 4);
                      const float e[8] = {bflo(a[cq].x), bfhi(a[cq].x), bflo(a[cq].y), bfhi(a[cq].y), bflo(a[cq].z), bfhi(a[cq].z), bflo(a[cq].w), bfhi(a[cq].w)};
                      const float gg[8] = {g0[0], g0[1], g0[2], g0[3], g1[0], g1[1], g1[2], g1[3]}, bb[8] = {b0[0], b0[1], b0[2], b0[3], b1[0], b1[1], b1[2], b1[3]};
#pragma unroll
                      for (int i = 0; i < 8; ++i) vT[(c0 + i) * VP + j] = (bf16)f2bf((e[i] - ms.x) * ms.y * gg[i] + bb[i]); } }
                __syncthreads();
                { const int g = wave >> 2, ib = wave & 3, gg = gp * 2 + g, r32 = lane & 31, hi = lane >> 5; const int nks = 2 * (ib + 1);
                  const bf16* Wg = WSb + (size_t)gg * 16384 + (size_t)(ib * 32 + r32) * 128 + hi * 8;
                  f32x16 acc[4] = {};
                  const int tokr = R0 + ib * 32 + r32;
                  bf16x8 bwv[8]; v2u uu[4][4];
#pragma unroll
                  for (int ks = 0; ks < 8; ++ks) bwv[ks] = *(const bf16x8*)(Wg + (ks < nks ? ks : 0) * 16);
#pragma unroll
                  for (int db = 0; db < 4; ++db)
#pragma unroll
                      for (int q4 = 0; q4 < 4; ++q4) uu[db][q4] = *(const v2u*)(UV + (size_t)tokr * D + gg * 128 + db * 32 + 8 * q4 + 4 * hi);
                  __builtin_amdgcn_sched_barrier(0);
#pragma unroll
                  for (int ks = 0; ks < 8; ++ks) { if (ks >= nks) break;
                      const bf16x8 bw = bwv[ks];
#pragma unroll
                      for (int db = 0; db < 4; ++db) { const bf16x8 av = *(const LAS bf16x8*)(vT + (size_t)(g * 128 + db * 32 + r32) * VP + ks * 16 + hi * 8);
                          acc[db] = __builtin_amdgcn_mfma_f32_32x32x16_bf16(av, bw, acc[db], 0, 0, 0); }
                  }
                  const float bs = sgu_b_s[gg * 128 + ib * 32 + r32];
#pragma unroll
                  for (int db = 0; db < 4; ++db)
#pragma unroll
                      for (int q4 = 0; q4 < 4; ++q4) { const int d = db * 32 + 8 * q4 + 4 * hi;
                          const v2u u2 = uu[db][q4];
                          v2u w; w.x = cvt_pk_bf16(bflo(u2.x) * (acc[db][4 * q4 + 0] + bs), bfhi(u2.x) * (acc[db][4 * q4 + 1] + bs));
                          w.y = cvt_pk_bf16(bflo(u2.y) * (acc[db][4 * q4 + 2] + bs), bfhi(u2.y) * (acc[db][4 * q4 + 3] + bs));
                          *(v2u*)(SGUO + (size_t)tokr * SGW + gg * 128 + d) = w; } }
                __syncthreads();
            }
        }
    }
    GRID_BAR();
    }

    if ((BX & 1) == 0) { const int tid = ltid(wave0); conv_run(lds, tid, __builtin_amdgcn_readfirstlane(tid >> 6), tid & 63, NCONV_EARLY + VCU, NCONV); }
    {
        char* al = (char*)lds_raw;
        ArgsP A = kargs(); unsigned char* ws = A->ws; const int tid = ltid(wave0), lane = tid & 63, wave = __builtin_amdgcn_readfirstlane(tid >> 6); (void)lane; (void)wave;
        att::Seam S;
        att::moba_prime(att::make_ref(ws, VCU, 0), al, S, tid);
        constexpr int NBLK = 4 * ((((PROBE_DUP) >> 4) & 1) + 1);
        for (int k = 0; k < NBLK; ++k) att::moba_block(att::make_ref(ws, VCU, k & 3), att::make_ref(ws, VCU, (k + 1) & 3), al, S, tid);
    }
    if ((BX & 1) != 0) { asm volatile("s_waitcnt vmcnt(0)" ::: "memory"); __syncthreads(); const int tid = ltid(wave0); conv_run(lds, tid, __builtin_amdgcn_readfirstlane(tid >> 6), tid & 63, NCONV_EARLY + VCU, NCONV); }
    GRID_BAR();

    DUPLOOP(5) {
    {
        ArgsP A = kargs(); unsigned char* ws = A->ws; const int tid = ltid(wave0), lane = tid & 63, wave = __builtin_amdgcn_readfirstlane(tid >> 6); (void)lane; (void)wave;
        const bf16* SAg = WSP(bf16, WS_SA); const bf16* SBg = WSP(bf16, WS_SB); bf16* T1 = WSP(bf16, WS_Q); unsigned char* MERGED = ws + WS_MERGED;
        { pg8::StaticOrder S; S.init(T, D, SGW * 2, G, BX, ws + WS_WSO);
          pg8::EpiGateSeg E{SAg, SBg, T1, MERGED, 0};
          pg8::gemm_phase<false>(lds, (const char*)(ws + WS_SGUO), SGW * 2, S, E, tid); }
        { pg8::StaticOrder S; S.init(T, D, D, G, BX, ws + WS_WMO8);
          pg8::EpiGateSeg E{SAg, SBg, T1, MERGED, 1};
          pg8::gemm_phase<true>(lds, (const char*)(ws + WS_O8), D, S, E, tid, att::O8_SHIFT); }
    }
    GRID_BAR();
    }

    DUPLOOP(6) {
    {
        ArgsP A = kargs(); unsigned char* ws = A->ws; const int tid = ltid(wave0), lane = tid & 63, wave = __builtin_amdgcn_readfirstlane(tid >> 6); (void)lane; (void)wave;
        const float* ada = WSP(float, WS_ADA); bf16* DELTA = WSP(bf16, WS_DELTA);
        pg8::StaticOrder S; S.init(T, D, D, G, BX, ws + WS_WOUT);
        pg8::EpiDelta E{ada + 4096, DELTA};
        pg8::gemm_phase<true>(lds, (const char*)(ws + WS_MERGED), D, S, E, tid, pg8::M8_SHIFT);
    }
    GRID_BAR();
    }

    DUPLOOP(10) {
    {
        ArgsP A = kargs(); unsigned char* ws = A->ws; const int tid = ltid(wave0), lane = tid & 63, wave = __builtin_amdgcn_readfirstlane(tid >> 6); (void)lane; (void)wave; gu32* ctl = (gu32*)(ws + WS_CTL);
        const float* g_ffn = A->in[14]; const float* b_rg = A->in[16]; const float* b_re = A->in[18]; const float* __restrict__ x = A->in[0]; const bf16* __restrict__ DELTA = WSP(bf16, WS_DELTA);
        const float* ada = WSP(float, WS_ADA); const bf16* __restrict__ RT = WSP(bf16, WS_RT); unsigned char* __restrict__ N28 = ws + WS_N2F8;
        int* tok_e = WSP(int, WS_TOKE); int* tok_p = WSP(int, WS_TOKP); float* tok_w = WSP(float, WS_TOKW); int* elist = WSP(int, WS_LIST);
        if (rep_ == 1) { ctl += 32768; tok_e = WSP(int, WS_K); tok_p = tok_e + 2 * T; tok_w = (float*)(tok_p + 2 * T); elist = (int*)(ws + WS_K + 8 * MiB); }
        LAS unsigned char* At = lds;
        LAS float* lgx = (LAS float*)(lds + TAB_OFF);
        const int row0 = VCU * 64, b = row0 >> 12;
        LAS float* tgs = (LAS float*)(lds + TAB_OFF + 12288); LAS float* tsh = tgs + D;
        for (int i = tid; i < D; i += NWAVES * 64) { tgs[i] = g_ffn[i] * (ada[b * 12288 + 8192 + i] + 1.0f); tsh[i] = ada[b * 12288 + 6144 + i]; }
        __syncthreads();
        for (int ps = 0; ps < 2; ++ps) {
            { const LAS f32x4* gp = (const LAS f32x4*)tgs + lane; const LAS f32x4* shp = (const LAS f32x4*)tsh + lane;
#pragma unroll
              for (int rp = 0; rp < 2; ++rp) {
                  f32x4 v[2][8]; v2u dl[2][8];
#pragma unroll
                  for (int q = 0; q < 2; ++q) { const int row = row0 + ps * 32 + wave * 4 + rp * 2 + q;
#pragma unroll
                      for (int j = 0; j < 8; ++j) { v[q][j] = *((const f32x4*)(x + (size_t)row * D) + lane + 64 * j); dl[q][j] = *((const v2u*)(DELTA + (size_t)row * D) + lane + 64 * j); } }
#pragma unroll
                  for (int q = 0; q < 2; ++q) { const int rl = wave * 4 + rp * 2 + q, row = row0 + ps * 32 + rl; float ss = 0.f;
#pragma unroll
                      for (int j = 0; j < 8; ++j) { v[q][j] += (f32x4){bflo(dl[q][j].x), bfhi(dl[q][j].x), bflo(dl[q][j].y), bfhi(dl[q][j].y)};
                          ss += (v[q][j].x * v[q][j].x + v[q][j].y * v[q][j].y) + (v[q][j].z * v[q][j].z + v[q][j].w * v[q][j].w); }
                      const float rstd = rsqrtf(wave_sum(ss) * (1.f / D) + EPS);
#pragma unroll
                      for (int j = 0; j < 8; ++j) { const f32x4 y = v[q][j] * rstd * gp[64 * j] + shp[64 * j];
                          *((unsigned*)(N28 + (size_t)row * D) + lane + 64 * j) = pk_fp8x4(y.x, y.y, y.z, y.w);
                          v2u w; w.x = cvt_pk_bf16(y.x, y.y); w.y = cvt_pk_bf16(y.z, y.w);
                          *(LAS v2u*)(At + rl * 4096 + ((((lane >> 1) + 32 * j) ^ (rl & 15)) << 4) + ((lane & 1) << 3)) = w; } } } }
            __syncthreads();
            { const int i = lane & 15, kq = lane >> 4;
                f32x4 acc[2][3];
#pragma unroll
                for (int mt = 0; mt < 2; ++mt)
#pragma unroll
                    for (int nt = 0; nt < 3; ++nt) acc[mt][nt] = (f32x4){0.f, 0.f, 0.f, 0.f};
                unsigned voff = (unsigned)((wave * 8) * (2 * 48 * 32) + i * 32 + 8 * kq) * 2u;
#pragma unroll 1
                for (int ks = 0; ks < 8; ++ks, voff += 6144u) { const int kg = wave * 8 + ks;
                    bf16x8 wh[3], wl[3];
                    const char* ph = (const char*)RT + voff; const char* pl = ph + 3072;
#pragma unroll
                    for (int nt = 0; nt < 3; ++nt) { wh[nt] = *(const bf16x8*)(ph + nt * 1024); wl[nt] = *(const bf16x8*)(pl + nt * 1024); }
#pragma unroll
                    for (int mt = 0; mt < 2; ++mt) { const bf16x8 af = *(const LAS bf16x8*)(At + (16 * mt + i) * 4096 + (((4 * kg + kq) ^ i) << 4));
#pragma unroll
                        for (int nt = 0; nt < 3; ++nt) { acc[mt][nt] = __builtin_amdgcn_mfma_f32_16x16x32_bf16(af, wh[nt], acc[mt][nt], 0, 0, 0); acc[mt][nt] = __builtin_amdgcn_mfma_f32_16x16x32_bf16(af, wl[nt], acc[mt][nt], 0, 0, 0); } } }
                __syncthreads();
                LAS float* part = (LAS float*)At + wave * 1536;
#pragma unroll
                for (int mt = 0; mt < 2; ++mt)
#pragma unroll
                    for (int nt = 0; nt < 3; ++nt)
#pragma unroll
                        for (int e = 0; e < 4; ++e) part[(16 * mt + 4 * kq + e) * 48 + nt * 16 + i] = acc[mt][nt][e];
                __syncthreads();
#pragma unroll
                for (int q = 0; q < 3; ++q) { const int idx = tid + 512 * q; float sum = 0.f;
#pragma unroll
                    for (int w8 = 0; w8 < 8; ++w8) sum += ((const LAS float*)At)[w8 * 1536 + idx];
                    lgx[ps * 1536 + idx] = sum; }
                __syncthreads(); }
        }
        if (wave == 7) {
            const LAS float* l = lgx + lane * 48; const int tokn = row0 + lane;
            float gl[4]; int gs = 0; float gmax;
#pragma unroll
            for (int q = 0; q < 4; ++q) gl[q] = l[q] + b_rg[q];
            gmax = gl[0];
#pragma unroll
            for (int q = 1; q < 4; ++q) if (gl[q] > gmax) { gmax = gl[q]; gs = q; }
            float den = 0.f;
#pragma unroll
            for (int q = 0; q < 4; ++q) den += __expf(gl[q] - gmax);
            const float pg = 1.0f / den;
            float v0 = -3.0e38f, v1 = -3.0e38f; int i0 = 0, i1 = 0;
#pragma unroll
            for (int q = 0; q < 8; ++q) { const float ev = l[4 + gs * 8 + q] + b_re[gs * 8 + q];
                if (ev > v0) { v1 = v0; i1 = i0; v0 = ev; i0 = q; } else if (ev > v1) { v1 = ev; i1 = q; } }
            const float t = __expf(v1 - v0), w0 = pg / (1.0f + t), w1 = pg * t / (1.0f + t);
            const int e0 = gs * 8 + i0, e1 = gs * 8 + i1;
            const int p0 = (int)__hip_atomic_fetch_add(ctl + CW_CNT + 64 * e0, 1u, RLX_AGENT);
            const int p1 = (int)__hip_atomic_fetch_add(ctl + CW_CNT + 64 * e1, 1u, RLX_AGENT);
            elist[e0 * LCAP + p0] = tokn; elist[e1 * LCAP + p1] = tokn;
            tok_e[2 * tokn] = e0; tok_e[2 * tokn + 1] = e1; tok_p[2 * tokn] = p0; tok_p[2 * tokn + 1] = p1; tok_w[2 * tokn] = w0; tok_w[2 * tokn + 1] = w1;
        }
    }
    GRID_BAR();
    }

    LAS int* bstart = (LAS int*)(lds + TAB_OFF); LAS int* cntl = (LAS int*)(lds + TAB_OFF + 256);
    { const int t = ltid(wave0);
      if (t < 64) { gu32* ctl = (gu32*)(kargs()->ws + WS_CTL);
          const int c = (t < NEXP) ? (int)__hip_atomic_load(ctl + CW_CNT + 64 * (t & 31), RLX_AGENT) : 0, nb = (c + 255) >> 8;
          int incl = nb;
#pragma unroll
          for (int o = 1; o < 32; o <<= 1) { const int v = __shfl_up(incl, o); if (t >= o) incl += v; }
          if (t < NEXP) { cntl[t] = c; bstart[t] = incl - nb; if (t == NEXP - 1) bstart[NEXP] = incl; } } }
    __syncthreads();
    const int RB = bstart[NEXP];
    DUPLOOP(7) {
        ArgsP A = kargs(); unsigned char* ws = A->ws; const int tid = ltid(wave0), lane = tid & 63, wave = __builtin_amdgcn_readfirstlane(tid >> 6); (void)lane; (void)wave;
        const int* elist = WSP(int, WS_LIST);
        pg8::MoeSched S{bstart, cntl, elist, 4, RB * 4, G, BX, D / 128, (const char*)(ws + WS_WGU8), (size_t)1024 * D, (size_t)256 * D, true};
        pg8::EpiSwiGLU E{ws + WS_HID8};
        pg8::gemm_phase<true>(lds, (const char*)(ws + WS_N2F8), D, S, E, tid);
        GRID_BAR();
    }
    DUPLOOP(8) {
        ArgsP A = kargs(); unsigned char* ws = A->ws; const int tid = ltid(wave0), lane = tid & 63, wave = __builtin_amdgcn_readfirstlane(tid >> 6); (void)lane; (void)wave;
        const int* elist = WSP(int, WS_LIST); bf16* YROW = WSP(bf16, WS_YROW);
        pg8::MoeSched S{bstart, cntl, elist, 8, RB * 8, G, BX, DFF / 128, (const char*)(ws + WS_WD8), (size_t)D * DFF, (size_t)256 * DFF, false};
        pg8::EpiStoreBf16 E{YROW};
        pg8::gemm_phase<true>(lds, (const char*)(ws + WS_HID8), DFF, S, E, tid);
        GRID_BAR();
    }

    DUPLOOP(9)
    {
        ArgsP A = kargs(); unsigned char* ws = A->ws; const int tid = ltid(wave0), lane = tid & 63, wave = __builtin_amdgcn_readfirstlane(tid >> 6); (void)lane; (void)wave;
        float* out = A->out; const float* x = A->in[0]; const bf16* DELTA = WSP(bf16, WS_DELTA); const float* g_fin = A->in[22]; const float* ada = WSP(float, WS_ADA); const bf16* YROW = WSP(bf16, WS_YROW);
        const int* tok_e = WSP(int, WS_TOKE); const int* tok_p = WSP(int, WS_TOKP); const float* tok_w = WSP(float, WS_TOKW);
        const bool poison = __hip_atomic_load((gu32*)(ws + WS_CTL) + CW_BAR + XB_TMO, RLX_AGENT) != 0u;
        for (int rr = 0; rr < 8; ++rr) {
            const int row = (VCU * NWAVES + wave) * 8 + rr, b = row >> 12;
            const int e0 = tok_e[2 * row], e1 = tok_e[2 * row + 1];
            const size_t s0 = (size_t)(bstart[e0] * 256 + tok_p[2 * row]), s1 = (size_t)(bstart[e1] * 256 + tok_p[2 * row + 1]);
            const float w0 = tok_w[2 * row], w1 = tok_w[2 * row + 1];
            f32x4* hr = (f32x4*)(out + (size_t)row * D) + lane; const f32x4* xr = (const f32x4*)(x + (size_t)row * D) + lane; const v2u* dr = (const v2u*)(DELTA + (size_t)row * D) + lane;
            const v2u* y0 = (const v2u*)(YROW + s0 * D) + lane; const v2u* y1 = (const v2u*)(YROW + s1 * D) + lane;
            const f32x4* gf = (const f32x4*)(ada + (size_t)b * 12288 + 10240) + lane;
            f32x4 v[8]; float ss = 0.f;
#pragma unroll
            for (int j = 0; j < 8; ++j) { const v2u dl = dr[64 * j]; const f32x4 hv = xr[64 * j] + (f32x4){bflo(dl.x), bfhi(dl.x), bflo(dl.y), bfhi(dl.y)}, gg = gf[64 * j]; const v2u a = y0[64 * j], c = y1[64 * j];
                f32x4 y; y.x = w0 * bflo(a.x) + w1 * bflo(c.x); y.y = w0 * bfhi(a.x) + w1 * bfhi(c.x); y.z = w0 * bflo(a.y) + w1 * bflo(c.y); y.w = w0 * bfhi(a.y) + w1 * bfhi(c.y);
                v[j] = hv + gg * y; ss += (v[j].x * v[j].x + v[j].y * v[j].y) + (v[j].z * v[j].z + v[j].w * v[j].w); }
            const float rstd = rsqrtf(wave_sum(ss) * (1.f / D) + EPS);
#pragma unroll
            for (int j = 0; j < 8; ++j) { const f32x4 gg = *((const f32x4*)g_fin + lane + 64 * j); hr[64 * j] = poison ? (f32x4){__builtin_nanf(""), __builtin_nanf(""), __builtin_nanf(""), __builtin_nanf("")} : v[j] * rstd * gg; }
        }
    }
}

extern "C" void kernel_launch(void* const* d_in, const int* in_sizes, int n_in, void* d_out, int out_size, void* d_ws, size_t ws_size, hipStream_t stream) {
    static int grid = 0;
    if (grid == 0) {
        if (n_in != 23 || in_sizes[0] != T * D || out_size != T * D || ws_size < WS_END) { fprintf(stderr, "kernel_launch: unexpected shapes (n_in %d, out %d, ws %zu)\n", n_in, out_size, ws_size); grid = -1; return; }
        int dev = 0, cus = 0, per_cu = 0;
        if (hipGetDevice(&dev) != hipSuccess || hipDeviceGetAttribute(&cus, hipDeviceAttributeMultiprocessorCount, dev) != hipSuccess) { grid = -1; return; }
        if (hipFuncSetAttribute((const void*)fwd_kernel, hipFuncAttributeMaxDynamicSharedMemorySize, LDS_BYTES) != hipSuccess) { fprintf(stderr, "kernel_launch: hipFuncSetAttribute failed\n"); grid = -1; return; }
        if (hipOccupancyMaxActiveBlocksPerMultiprocessor(&per_cu, (const void*)fwd_kernel, NWAVES * 64, LDS_BYTES) != hipSuccess || per_cu < 1) fprintf(stderr, "kernel_launch: occupancy query reports %d\n", per_cu);
        (void)hipGetLastError();
        grid = cus;
        if (grid != 256) { fprintf(stderr, "kernel_launch: this kernel is built for 256 CUs, got %d\n", grid); grid = -1; return; }
    }
    if (grid < 0) return;
    (void)hipMemsetAsync((char*)d_ws + WS_CTL, 0, CTL_ZERO_BYTES, stream);
    Args a{};
    for (int i = 0; i < 23; ++i) a.in[i] = (const float*)d_in[i];
    a.out = (float*)d_out; a.ws = (unsigned char*)d_ws;
    hipLaunchKernelGGL(fwd_kernel, dim3(grid), dim3(NWAVES * 64), LDS_BYTES, stream, a);
}
```

```cpp
#include <hip/hip_runtime.h>
#include <cstdio>
#include <cstdint>

#define GAS __attribute__((address_space(1)))
#define LAS __attribute__((address_space(3)))
typedef unsigned short bf16;
typedef unsigned v4u __attribute__((ext_vector_type(4)));
typedef unsigned v2u __attribute__((ext_vector_type(2)));
typedef float f32x2 __attribute__((ext_vector_type(2)));
typedef float f32x4 __attribute__((ext_vector_type(4)));
typedef float f32x16 __attribute__((ext_vector_type(16)));
typedef short bf16x8 __attribute__((ext_vector_type(8)));
typedef short s16x4 __attribute__((ext_vector_type(4)));
typedef GAS unsigned gu32;
#define RLX_AGENT __ATOMIC_RELAXED, __HIP_MEMORY_SCOPE_AGENT
#define LDS_WAIT() asm volatile("s_waitcnt lgkmcnt(0)" ::: "memory")
#define VM_WAIT() asm volatile("s_waitcnt vmcnt(0)" ::: "memory")

constexpr int BATCH = 4, SEQ = 4096, T = BATCH * SEQ, D = 2048;
constexpr int SGW = 1024, NHEAD = 16, HD = 128, INC = 12288;
constexpr int NEXP = 32, DFF = 512, LCAP = 16384;
constexpr float EPS = 1e-6f;
constexpr int NWAVES = 8;
#ifndef PROBE_DUP
#define PROBE_DUP 0
#endif
#define DUPLOOP(k) for (int rep_ = 0; rep_ < (((PROBE_DUP) >> (k)) & 1) + 1; ++rep_)

constexpr size_t MiB = 1u << 20;
constexpr size_t WS_CTL = 0, CTL_ZERO_BYTES = 1 * MiB;
constexpr size_t WS_ADAP = 1 * MiB;
constexpr size_t WS_ADA = 1 * MiB + 786432;
constexpr size_t WS_COS = 2 * MiB, WS_SIN = 6 * MiB;
constexpr size_t WS_KM = 10 * MiB;
constexpr size_t WS_WS = 10 * MiB + 512 * 1024;
constexpr size_t WS_RT = 11 * MiB;
constexpr size_t WS_TOKE = 12 * MiB, WS_TOKP = WS_TOKE + 128 * 1024, WS_TOKW = WS_TOKP + 128 * 1024;
constexpr size_t WS_LIST = 13 * MiB;
constexpr size_t WS_WINZ = 16 * MiB;
constexpr size_t WS_WIN8 = 24 * MiB;
constexpr size_t WS_WSO = 48 * MiB;
constexpr size_t WS_WMO8 = 52 * MiB;
constexpr size_t WS_WOUT = 60 * MiB;
constexpr size_t WS_WGU8 = 68 * MiB;
constexpr size_t WS_WD8 = 132 * MiB;
constexpr size_t WS_N = 164 * MiB;
constexpr size_t WS_N1F8 = 228 * MiB;
constexpr size_t WS_UV = 260 * MiB;
constexpr size_t WS_Q = 324 * MiB, WS_K = 388 * MiB, WS_V = 452 * MiB;
constexpr size_t WS_SA = 516 * MiB, WS_SB = 580 * MiB;
constexpr size_t WS_END = 644 * MiB;
constexpr size_t WS_Q8 = WS_Q, WS_K8 = WS_K, WS_VT8 = WS_V;
constexpr size_t WS_SGUO = WS_N, WS_O8 = WS_N + 32 * MiB, WS_N2F8 = WS_UV, WS_MERGED = WS_UV, WS_HID8 = WS_N, WS_YROW = WS_Q, WS_DELTA = WS_SA;
constexpr int CW_BAR = 4096, CW_QUEUE = 8192, CW_CNT = 8192 + 64;

constexpr int RING_BYTES = 131072, LDSCTL_OFF = RING_BYTES, MISC_OFF = LDSCTL_OFF + 320, TAB_OFF = LDSCTL_OFF + 1024;
constexpr int LDS_BYTES = 163840;

__device__ __forceinline__ unsigned f2bf(float f) { unsigned u = __builtin_bit_cast(unsigned, f); return (u + 0x7fffu + ((u >> 16) & 1u)) >> 16; }
__device__ __forceinline__ unsigned pk2(float lo, float hi) { return f2bf(lo) | (f2bf(hi) << 16); }
typedef __bf16 bf16x2_t __attribute__((ext_vector_type(2)));
__device__ __forceinline__ unsigned cvt_pk_bf16(float lo, float hi) { f32x2 v = {lo, hi}; bf16x2_t b = __builtin_convertvector(v, bf16x2_t); return __builtin_bit_cast(unsigned, b); }
__device__ __forceinline__ unsigned pk_fp8x4(float a, float b, float c, float d) { unsigned w = 0u; w = __builtin_amdgcn_cvt_pk_fp8_f32(a, b, w, false); w = __builtin_amdgcn_cvt_pk_fp8_f32(c, d, w, true); return w; }
__device__ __forceinline__ float bflo(unsigned w) { return __builtin_bit_cast(float, w << 16); }
__device__ __forceinline__ float bfhi(unsigned w) { return __builtin_bit_cast(float, w & 0xffff0000u); }
__device__ __forceinline__ float wave_sum(float v) {
#pragma unroll
    for (int o = 1; o < 64; o <<= 1) v += __shfl_xor(v, o);
    return v;
}
__device__ __forceinline__ float fast_sigmoid(float x) { return __builtin_amdgcn_rcpf(1.0f + __builtin_amdgcn_exp2f(-1.4426950408889634f * x)); }
__device__ __forceinline__ float gelu_tanh(float x) { const float u = x * (1.0f + 0.044715f * x * x); return x * __builtin_amdgcn_rcpf(1.0f + __builtin_amdgcn_exp2f(-2.3022081985f * u)); }

#define XB_TMO      128
#define XB_XCNT(j)  (256  + 64 * (j))
#define XB_XSUB(j)  (1280 + 64 * (j))
#define XB_XGEN(j)  (2304 + 64 * (j))
#define XB_TOP      3328
#define XB_TOPGEN   3392
#define XCD_BAR_WORDS 3456
#define XB_SPIN_CAP (1u << 18)
__device__ __forceinline__ unsigned xb_ld(unsigned* p)              { return __hip_atomic_load(p, __ATOMIC_RELAXED, __HIP_MEMORY_SCOPE_AGENT); }
__device__ __forceinline__ unsigned xb_add(unsigned* p, unsigned v) { return __hip_atomic_fetch_add(p, v, __ATOMIC_RELAXED, __HIP_MEMORY_SCOPE_AGENT); }
__device__ __forceinline__ unsigned xb_xcc_id() { return (unsigned)__builtin_amdgcn_s_getreg((3 << 11) | 20) & 0xFu; }
#define XB_SPIN(cond, bar) do { unsigned _sp = 0; while (cond) { __builtin_amdgcn_s_sleep(1); \
    if ((++_sp & 255u) == 0u) { if (xb_ld(&(bar)[XB_TMO])) break; if (_sp > XB_SPIN_CAP) { atomicAdd(&(bar)[XB_TMO], 1u); break; } } } } while (0)
struct XcdBarrier { unsigned* bar; unsigned x; volatile LAS unsigned* st; };
__device__ __forceinline__ XcdBarrier xcd_barrier_post(unsigned* bar, volatile LAS unsigned* st, int tid) {
    XcdBarrier b; b.bar = bar; b.x = xb_xcc_id(); b.st = st;
    if (tid == 0) (void)xb_add(&bar[XB_XCNT(b.x)], 1u);
    return b;
}
__device__ __forceinline__ void xcd_barrier_complete(unsigned* bar, unsigned x, unsigned& nloc, unsigned& nx) {
    const unsigned G = gridDim.x * gridDim.y * gridDim.z;
    unsigned sum, cnt, mine, sp = 0u;
    for (;;) {
        sum = 0u; cnt = 0u; mine = 0u;
#pragma unroll
        for (unsigned j = 0; j < 16; ++j) { const unsigned c = xb_ld(&bar[XB_XCNT(j)]); sum += c; cnt += (c > 0u) ? 1u : 0u; mine = (j == x) ? c : mine; }
        if (sum == G) break;
        __builtin_amdgcn_s_sleep(1);
        if ((++sp & 255u) == 0u) { if (xb_ld(&bar[XB_TMO])) break; if (sp > XB_SPIN_CAP) { atomicAdd(&bar[XB_TMO], 1u); break; } }
    }
    nloc = mine > 0u ? mine : 1u; nx = cnt > 0u ? cnt : 1u;
}
__device__ __forceinline__ void xcd_barrier(const XcdBarrier& b, int tid) {
    asm volatile("s_waitcnt vmcnt(0)" ::: "memory");
    __syncthreads();
    if (tid == 0) {
        unsigned* bar = b.bar;
        __builtin_amdgcn_s_waitcnt(0);
        unsigned nloc = b.st[0], nx = b.st[1];
        if (nloc == 0u) { xcd_barrier_complete(bar, b.x, nloc, nx); b.st[0] = nloc; b.st[1] = nx; }
        const unsigned old = xb_add(&bar[XB_XSUB(b.x)], 1u);
        const unsigned gen = old / nloc;
        if (old + 1u == (gen + 1u) * nloc) {
            __builtin_amdgcn_fence(__ATOMIC_RELEASE, "agent");
            asm volatile("s_waitcnt vmcnt(0)" ::: "memory");
            const unsigned og = xb_add(&bar[XB_TOP], 1u);
            const unsigned tg = og / nx;
            if (og + 1u == (tg + 1u) * nx) xb_add(&bar[XB_TOPGEN], 1u);
            else XB_SPIN(xb_ld(&bar[XB_TOPGEN]) == tg, bar);
            __builtin_amdgcn_fence(__ATOMIC_ACQUIRE, "agent");
            xb_add(&bar[XB_XGEN(b.x)], 1u);
            asm volatile("s_waitcnt vmcnt(0)" ::: "memory");
        } else {
            XB_SPIN(xb_ld(&bar[XB_XGEN(b.x)]) == gen, bar);
            __builtin_amdgcn_fence(__ATOMIC_ACQUIRE, "agent");
            asm volatile("s_waitcnt vmcnt(0)" ::: "memory");
        }
    }
    __syncthreads();
}

namespace pg8 {
constexpr int BM = 256, BK = 64, HALF = 128, HTB = HALF * BK * 2, STAGE_BYTES = 8 * HTB, NXCD = 8, WGM = 8;
__device__ __forceinline__ int lds_byte(int r, int c) { const int st = (r >> 4) * 2 + (c >> 5), rr = r & 15, cc = c & 31, ob = rr * 64 + cc * 2; return st * 1024 + (ob ^ (((ob >> 9) & 1) << 5)); }
__device__ __forceinline__ void stage_rc(int b, int& R, int& C) { const int st = b / 1024, sb = b % 1024, swz = sb ^ (((sb >> 9) & 1) << 5); R = (st >> 1) * 16 + swz / 64; C = (st & 1) * 32 + (swz % 64) / 2; }
__device__ __forceinline__ int perm32(int rho) { const int n = rho >> 4, i = rho & 15; return 8 * (i >> 2) + 4 * n + (i & 3); }
typedef int v8i __attribute__((ext_vector_type(8)));
typedef int v4i __attribute__((ext_vector_type(4)));
constexpr int M8_SHIFT = 4;
constexpr int W8_SHIFT = 5;
__device__ __forceinline__ v8i cat8(bf16x8 lo, bf16x8 hi) { const v4i a = __builtin_bit_cast(v4i, lo), b = __builtin_bit_cast(v4i, hi); return __builtin_shufflevector(a, b, 0, 1, 2, 3, 4, 5, 6, 7); }
struct Unit { int pm, pn, ex, kt0, nkt; };

struct StaticOrder {
    int nM, nN, nwg, G, c, nkt; const char* Bt; size_t tstepB;
    __device__ __forceinline__ void init(int M, int N, int rowbytes, int G_, int c_, const void* Bt_) { nM = M / BM; nN = N / BM; nwg = nM * nN; G = G_; c = c_; Bt = (const char*)Bt_; tstepB = (size_t)BM * rowbytes; nkt = rowbytes / 128; }
    __device__ __forceinline__ bool next(int i, Unit& u) const {
        const long L = (long)i * G + c; if (L >= nwg) return false;
        int wgid = (int)L; { const int q = nwg / NXCD, r = nwg % NXCD, xcd = wgid % NXCD, off = wgid / NXCD; wgid = (xcd < r ? xcd * (q + 1) : r * (q + 1) + (xcd - r) * q) + off; }
        const int nig = WGM * nN, gid = wgid / nig, fm = gid * WGM, gsz = (nM - fm) < WGM ? (nM - fm) : WGM;
        u.pm = fm + ((wgid % nig) % gsz); u.pn = (wgid % nig) / gsz; u.ex = 0; u.kt0 = 0; u.nkt = nkt; return true;
    }
    __device__ __forceinline__ const char* b_ptr(const Unit& u) const { return Bt + (size_t)u.pn * tstepB; }
    __device__ __forceinline__ unsigned a_row(const Unit& u, int r) const { return (unsigned)(u.pm * BM + r); }
};

template <bool F8, class Epi, class Sched>
__device__ __forceinline__ void gemm_phase(LAS unsigned char* lds, const char* Ab, const int rowbytes, const Sched& S, const Epi& E, const int tid, const int a8shift = 0) {
    const int wid = __builtin_amdgcn_readfirstlane(tid >> 6), lane = tid & 63, wr = wid >> 2, wc = wid & 3, fr = lane & 15, fq = lane >> 4;
    int Rs[2]; unsigned Cs[2], voffB[2];
#pragma unroll
    for (int i = 0; i < 2; ++i) { int R, C; stage_rc(tid * 16 + i * 8192, R, C); const int Rb = Epi::PERM ? ((R & ~31) + perm32(R & 31)) : R;
        Rs[i] = R; Cs[i] = (unsigned)C * 2u; voffB[i] = (unsigned)(Rb * rowbytes + C * 2); }
    const size_t kstep = (size_t)(BK * 2);
    const size_t hstep = (size_t)HALF * rowbytes;
    const unsigned rowb = (unsigned)rowbytes;
    const unsigned ldsw = (unsigned)wid * 1024u;
    const int aoff = lds_byte(wr * 64 + fr, fq * 8), boff = lds_byte(wc * 32 + fr, fq * 8);
#define PG8_SA(b, h) (((b) * 2 + (h)) * HTB)
#define PG8_SB(b, h) ((4 + (b) * 2 + (h)) * HTB)
#define PG8_STAGE_B(bufoff, gbase) do { _Pragma("unroll") for (int _i = 0; _i < 2; ++_i) \
        __builtin_amdgcn_global_load_lds((const unsigned*)((const char*)(gbase) + voffB[_i]), (LAS unsigned*)(lds + (bufoff) + ldsw + _i * 8192), 16, 0, 0); } while (0)
#define PG8_STAGE_A(bufoff, kbyte, h) do { _Pragma("unroll") for (int _i = 0; _i < 2; ++_i) \
        __builtin_amdgcn_global_load_lds((const unsigned*)(Ab + (kbyte) + vC[h][_i]), (LAS unsigned*)(lds + (bufoff) + ldsw + _i * 8192), 16, 0, 0); } while (0)
#define PG8_LDA(dst, b, h) do { _Pragma("unroll") for (int m = 0; m < 4; ++m) _Pragma("unroll") for (int k = 0; k < 2; ++k) dst[m][k] = *(const LAS bf16x8*)(lds + PG8_SA(b, h) + aoff + m * 2048 + k * 1024); } while (0)
#define PG8_LDB(dst, b, h) do { _Pragma("unroll") for (int n = 0; n < 2; ++n) _Pragma("unroll") for (int k = 0; k < 2; ++k) dst[n][k] = *(const LAS bf16x8*)(lds + PG8_SB(b, h) + boff + n * 2048 + k * 1024); } while (0)
#define PG8_MMA(ai, bj, At, Bt) do { __builtin_amdgcn_s_setprio(1); _Pragma("unroll") for (int m = 0; m < 4; ++m) _Pragma("unroll") for (int n = 0; n < 2; ++n) { \
        if constexpr (F8) acc[ai][bj][m][n] = __builtin_amdgcn_mfma_scale_f32_16x16x128_f8f6f4(cat8(Bt[n][0], Bt[n][1]), cat8(At[m][0], At[m][1]), acc[ai][bj][m][n], 0, 0, 0, 127 - W8_SHIFT, 0, 127 - a8shift); \
        else { _Pragma("unroll") for (int k = 0; k < 2; ++k) acc[ai][bj][m][n] = __builtin_amdgcn_mfma_f32_16x16x32_bf16(Bt[n][k], At[m][k], acc[ai][bj][m][n], 0, 0, 0); } } __builtin_amdgcn_s_setprio(0); } while (0)
#define PG8_WAIT_V(n) asm volatile("s_waitcnt vmcnt(" #n ")" ::: "memory")
#define PG8_WAIT_L(n) asm volatile("s_waitcnt lgkmcnt(" #n ")" ::: "memory")
#define PG8_BAR __builtin_amdgcn_s_barrier()
#define PG8_SCHED __builtin_amdgcn_sched_barrier(0)
    Unit cur, nxt; int ui = 0;
    if (!S.next(0, cur)) return;
    f32x4 acc[2][2][4][2];
#pragma unroll
    for (int a = 0; a < 2; ++a)
#pragma unroll
        for (int b = 0; b < 2; ++b)
#pragma unroll
            for (int m = 0; m < 4; ++m)
#pragma unroll
                for (int n = 0; n < 2; ++n) acc[a][b][m][n] = (f32x4){0.f, 0.f, 0.f, 0.f};
    bf16x8 At[4][2], B0[2][2], B1[2][2];
    unsigned vC[2][2], vN[2][2];
#pragma unroll
    for (int h = 0; h < 2; ++h)
#pragma unroll
        for (int i = 0; i < 2; ++i) vC[h][i] = S.a_row(cur, h * HALF + Rs[i]) * rowb + Cs[i];
    const char* cB = S.b_ptr(cur) + (size_t)cur.kt0 * kstep; size_t kc = (size_t)cur.kt0 * kstep; int nt = cur.nkt;
    PG8_STAGE_B(PG8_SB(0, 0), cB); PG8_STAGE_B(PG8_SB(0, 1), cB + hstep); PG8_STAGE_A(PG8_SA(0, 0), kc, 0); PG8_STAGE_A(PG8_SA(0, 1), kc, 1);
    if (wr == 1) PG8_BAR;
    PG8_WAIT_V(2); PG8_BAR;
    PG8_STAGE_B(PG8_SB(1, 0), cB + kstep); PG8_STAGE_A(PG8_SA(1, 0), kc + kstep, 0); PG8_STAGE_B(PG8_SB(1, 1), cB + hstep + kstep);
    PG8_WAIT_V(6); PG8_BAR;
    for (;;) {
        const bool has_next = S.next(ui + 1, nxt);
        const char* nB = has_next ? S.b_ptr(nxt) + (size_t)nxt.kt0 * kstep : cB; const size_t kn = has_next ? (size_t)nxt.kt0 * kstep : kc;
#pragma unroll
        for (int h = 0; h < 2; ++h)
#pragma unroll
            for (int i = 0; i < 2; ++i) vN[h][i] = has_next ? (S.a_row(nxt, h * HALF + Rs[i]) * rowb + Cs[i]) : vC[h][i];
        for (int t = 0; t < nt; t += 2) {
            const bool last = (t == nt - 2);
            const size_t ka1 = kc + (size_t)(t + 1) * kstep;
            const size_t ka2 = last ? kn : kc + (size_t)(t + 2) * kstep;
            const char* b2 = last ? nB : cB + (size_t)(t + 2) * kstep; const char* b3 = b2 + kstep;
            PG8_LDB(B0, 0, 0); PG8_LDB(B1, 0, 1); PG8_SCHED; PG8_LDA(At, 0, 0); PG8_STAGE_A(PG8_SA(1, 1), ka1, 1);
            if (last) {
#pragma unroll
                for (int h = 0; h < 2; ++h)
#pragma unroll
                    for (int i = 0; i < 2; ++i) vC[h][i] = vN[h][i];
            }
            PG8_WAIT_V(8); PG8_WAIT_L(0); PG8_BAR; PG8_MMA(0, 0, At, B0); PG8_MMA(0, 1, At, B1); PG8_BAR; PG8_SCHED;
            PG8_LDA(At, 0, 1); PG8_STAGE_B(PG8_SB(0, 0), b2); PG8_STAGE_B(PG8_SB(0, 1), b2 + hstep); PG8_STAGE_A(PG8_SA(0, 0), ka2, 0);
            PG8_WAIT_V(8); PG8_WAIT_L(0); PG8_BAR; PG8_MMA(1, 0, At, B0); PG8_MMA(1, 1, At, B1); PG8_BAR; PG8_SCHED;
            PG8_LDB(B0, 1, 0); PG8_LDB(B1, 1, 1); PG8_SCHED; PG8_LDA(At, 1, 0); PG8_STAGE_A(PG8_SA(0, 1), ka2, 1);
            PG8_WAIT_V(8); PG8_WAIT_L(0); PG8_BAR; PG8_MMA(0, 0, At, B0); PG8_MMA(0, 1, At, B1); PG8_BAR; PG8_SCHED;
            PG8_LDA(At, 1, 1); PG8_STAGE_B(PG8_SB(1, 0), b3); PG8_STAGE_B(PG8_SB(1, 1), b3 + hstep); PG8_STAGE_A(PG8_SA(1, 0), ka2 + kstep, 0);
            PG8_WAIT_V(8); PG8_WAIT_L(0); PG8_BAR; PG8_MMA(1, 0, At, B0); PG8_MMA(1, 1, At, B1); PG8_BAR; PG8_SCHED;
        }
        if (wr == 0) PG8_BAR;
        E(acc, cur, wr, wc, fr, fq);
        if (!has_next) break;
#pragma unroll
        for (int a = 0; a < 2; ++a)
#pragma unroll
            for (int b = 0; b < 2; ++b)
#pragma unroll
                for (int m = 0; m < 4; ++m)
#pragma unroll
                    for (int n = 0; n < 2; ++n) acc[a][b][m][n] = (f32x4){0.f, 0.f, 0.f, 0.f};
        cur = nxt; cB = nB; kc = kn; nt = cur.nkt; ++ui;
        if (wr == 1) PG8_BAR;
    }
    PG8_WAIT_V(0);
    PG8_BAR;
#undef PG8_SA
#undef PG8_SB
#undef PG8_STAGE_A
#undef PG8_STAGE_B
#undef PG8_LDA
#undef PG8_LDB
#undef PG8_MMA
#undef PG8_WAIT_V
#undef PG8_WAIT_L
#undef PG8_BAR
#undef PG8_SCHED
}

typedef const f32x4 (&AccRef)[2][2][4][2];

struct EpiInProj {
    static constexpr bool PERM = true;
    bf16* UV; unsigned char* Q8; unsigned char* K8; unsigned char* VT8; bf16* SA; bf16* SB; const float* cosT; const float* sinT; int pn_off;
    __device__ __forceinline__ void operator()(AccRef acc, const Unit& u, int wr, int wc, int fr, int fq) const {
        asm volatile("" : "+v"(fr), "+v"(fq));
        const int pn = u.pn + pn_off, rbase = u.pm * BM + wr * 64 + fr, cl = wc * 32 + 8 * fq;
        if (pn < 8) {
#pragma unroll
            for (int ai = 0; ai < 2; ++ai)
#pragma unroll
                for (int m = 0; m < 4; ++m) { bf16* rp = UV + (size_t)(rbase + ai * HALF + m * 16) * D + pn * BM + cl;
#pragma unroll
                    for (int bj = 0; bj < 2; ++bj) { const f32x4 a = acc[ai][bj][m][0], b = acc[ai][bj][m][1];
                        v4u w; w.x = cvt_pk_bf16(gelu_tanh(a[0]), gelu_tanh(a[1])); w.y = cvt_pk_bf16(gelu_tanh(a[2]), gelu_tanh(a[3]));
                        w.z = cvt_pk_bf16(gelu_tanh(b[0]), gelu_tanh(b[1])); w.w = cvt_pk_bf16(gelu_tanh(b[2]), gelu_tanh(b[3]));
                        *(v4u*)(rp + bj * HALF) = w; } }
        } else if (pn < 24) {
            unsigned char* dst = (pn < 16) ? Q8 : K8; const int hp = ((pn - 8) & 7) * 2, j0 = cl >> 1;
#pragma unroll
            for (int ai = 0; ai < 2; ++ai)
#pragma unroll
                for (int m = 0; m < 4; ++m) { const int row = rbase + ai * HALF + m * 16, b = row >> 12, s = row & 4095;
                    const f32x4 c4 = *(const f32x4*)(cosT + (size_t)row * 64 + j0), s4 = *(const f32x4*)(sinT + (size_t)row * 64 + j0);
#pragma unroll
                    for (int bj = 0; bj < 2; ++bj) { const f32x4 x0 = acc[ai][bj][m][0], x1 = acc[ai][bj][m][1];
                        v2u w;
                        w.x = pk_fp8x4(x0[0] * c4[0] - x0[1] * s4[0], x0[1] * c4[0] + x0[0] * s4[0], x0[2] * c4[1] - x0[3] * s4[1], x0[3] * c4[1] + x0[2] * s4[1]);
                        w.y = pk_fp8x4(x1[0] * c4[2] - x1[1] * s4[2], x1[1] * c4[2] + x1[0] * s4[2], x1[2] * c4[3] - x1[3] * s4[3], x1[3] * c4[3] + x1[2] * s4[3]);
                        *(v2u*)(dst + ((size_t)(b * NHEAD + hp + bj) * SEQ + s) * HD + cl) = w; } }
        } else if (pn < 32) {
            const int hp = (pn - 24) * 2, lane = fr + 16 * fq, jq = lane & 3;
#pragma unroll
            for (int ai = 0; ai < 2; ++ai)
#pragma unroll
                for (int m = 0; m < 4; ++m) { const int row = rbase + ai * HALF + m * 16, b = row >> 12, s0 = (row & 4095) & ~3;
#pragma unroll
                    for (int bj = 0; bj < 2; ++bj) { const f32x4 a = acc[ai][bj][m][0], c = acc[ai][bj][m][1];
                        const unsigned w0 = pk_fp8x4(a[0], a[1], a[2], a[3]), w1 = pk_fp8x4(c[0], c[1], c[2], c[3]);
                        unsigned o0 = 0u, o1 = 0u;
#define VQ(q) { const unsigned t0 = (unsigned)__builtin_amdgcn_mov_dpp((int)w0, (q) * 0x55, 0xf, 0xf, true), t1 = (unsigned)__builtin_amdgcn_mov_dpp((int)w1, (q) * 0x55, 0xf, 0xf, true); \
                            o0 |= ((t0 >> (8 * jq)) & 0xffu) << (8 * (q)); o1 |= ((t1 >> (8 * jq)) & 0xffu) << (8 * (q)); }
                        VQ(0) VQ(1) VQ(2) VQ(3)
#undef VQ
                        unsigned char* vp = VT8 + ((size_t)(b * NHEAD + hp + bj) * HD + cl + jq) * SEQ + s0;
                        *(unsigned*)vp = o0; *(unsigned*)(vp + 4 * SEQ) = o1; } }
        } else {
            bf16* dst = (pn < 40) ? SA : SB; const int colt = ((pn - 32) & 7) * BM;
#pragma unroll
            for (int ai = 0; ai < 2; ++ai)
#pragma unroll
                for (int m = 0; m < 4; ++m) { bf16* rp = dst + (size_t)(rbase + ai * HALF + m * 16) * D + colt + cl;
#pragma unroll
                    for (int bj = 0; bj < 2; ++bj) { const f32x4 a = acc[ai][bj][m][0], b = acc[ai][bj][m][1];
                        v4u w; w.x = cvt_pk_bf16(fast_sigmoid(a[0]), fast_sigmoid(a[1])); w.y = cvt_pk_bf16(fast_sigmoid(a[2]), fast_sigmoid(a[3]));
                        w.z = cvt_pk_bf16(fast_sigmoid(b[0]), fast_sigmoid(b[1])); w.w = cvt_pk_bf16(fast_sigmoid(b[2]), fast_sigmoid(b[3]));
                        *(v4u*)(rp + bj * HALF) = w; } }
        }
    }
};
struct EpiGateSeg {
    static constexpr bool PERM = true;
    const bf16* SAg; const bf16* SBg; bf16* T1; unsigned char* Mg; int seg;
    __device__ __forceinline__ void operator()(AccRef acc, const Unit& u, int wr, int wc, int fr, int fq) const {
        const int rbase = u.pm * BM + wr * 64 + fr, col0 = u.pn * BM + wc * 32 + 8 * fq;
        if (seg == 0) {
#pragma unroll
            for (int ai = 0; ai < 2; ++ai) {
                v4u g[4][2];
#pragma unroll
                for (int m = 0; m < 4; ++m)
#pragma unroll
                    for (int bj = 0; bj < 2; ++bj) g[m][bj] = *(const v4u*)(SAg + (size_t)(rbase + ai * HALF + m * 16) * D + col0 + bj * HALF);
#pragma unroll
                for (int m = 0; m < 4; ++m) { const size_t off = (size_t)(rbase + ai * HALF + m * 16) * D + col0;
#pragma unroll
                    for (int bj = 0; bj < 2; ++bj) { const v4u gg = g[m][bj]; const f32x4 a = acc[ai][bj][m][0], b = acc[ai][bj][m][1];
                        v4u w; w.x = cvt_pk_bf16(bflo(gg.x) * a[0], bfhi(gg.x) * a[1]); w.y = cvt_pk_bf16(bflo(gg.y) * a[2], bfhi(gg.y) * a[3]);
                        w.z = cvt_pk_bf16(bflo(gg.z) * b[0], bfhi(gg.z) * b[1]); w.w = cvt_pk_bf16(bflo(gg.w) * b[2], bfhi(gg.w) * b[3]);
                        *(v4u*)(T1 + off + bj * HALF) = w; } }
            }
        } else {
#pragma unroll
            for (int ai = 0; ai < 2; ++ai)
#pragma unroll
                for (int mp = 0; mp < 2; ++mp) {
                    v4u tt[2][2], g[2][2];
#pragma unroll
                    for (int mm = 0; mm < 2; ++mm)
#pragma unroll
                        for (int bj = 0; bj < 2; ++bj) { const size_t off = (size_t)(rbase + ai * HALF + (2 * mp + mm) * 16) * D + col0 + bj * HALF; tt[mm][bj] = *(const v4u*)(T1 + off); g[mm][bj] = *(const v4u*)(SBg + off); }
#pragma unroll
                    for (int mm = 0; mm < 2; ++mm) { const int m = 2 * mp + mm; const size_t off = (size_t)(rbase + ai * HALF + m * 16) * D + col0;
#pragma unroll
                        for (int bj = 0; bj < 2; ++bj) { const v4u t = tt[mm][bj], gg = g[mm][bj]; const f32x4 a = acc[ai][bj][m][0], b = acc[ai][bj][m][1];
                            constexpr float MS = (float)(1 << M8_SHIFT);
                            v2u w; w.x = pk_fp8x4((bflo(t.x) + bflo(gg.x) * a[0]) * MS, (bfhi(t.x) + bfhi(gg.x) * a[1]) * MS, (bflo(t.y) + bflo(gg.y) * a[2]) * MS, (bfhi(t.y) + bfhi(gg.y) * a[3]) * MS);
                            w.y = pk_fp8x4((bflo(t.z) + bflo(gg.z) * b[0]) * MS, (bfhi(t.z) + bfhi(gg.z) * b[1]) * MS, (bflo(t.w) + bflo(gg.w) * b[2]) * MS, (bfhi(t.w) + bfhi(gg.w) * b[3]) * MS);
                            *(v2u*)(Mg + off + bj * HALF) = w; } }
                }
        }
    }
};
struct EpiDelta {
    static constexpr bool PERM = true;
    const float* gm; bf16* Dl;
    __device__ __forceinline__ void operator()(AccRef acc, const Unit& u, int wr, int wc, int fr, int fq) const {
        const int rbase = u.pm * BM + wr * 64 + fr, col0 = u.pn * BM + wc * 32 + 8 * fq, b = (u.pm * BM) >> 12;
        f32x4 gv[2][2];
#pragma unroll
        for (int bj = 0; bj < 2; ++bj)
#pragma unroll
            for (int n = 0; n < 2; ++n) gv[bj][n] = *(const f32x4*)(gm + (size_t)b * 12288 + col0 + bj * HALF + 4 * n);
#pragma unroll
        for (int ai = 0; ai < 2; ++ai)
#pragma unroll
            for (int m = 0; m < 4; ++m) { bf16* rp = Dl + (size_t)(rbase + ai * HALF + m * 16) * D + col0;
#pragma unroll
                for (int bj = 0; bj < 2; ++bj) { const f32x4 a = acc[ai][bj][m][0] * gv[bj][0], c = acc[ai][bj][m][1] * gv[bj][1];
                    v4u w; w.x = cvt_pk_bf16(a[0], a[1]); w.y = cvt_pk_bf16(a[2], a[3]); w.z = cvt_pk_bf16(c[0], c[1]); w.w = cvt_pk_bf16(c[2], c[3]);
                    *(v4u*)(rp + bj * HALF) = w; } }
    }
};
struct MoeSched {
    const LAS int* bstart; const LAS int* cntl; const int* list; int npn, total, G, c, nkt; const char* Bt; size_t estride, tstepB; bool gather;
    __device__ __forceinline__ bool next(int i, Unit& u) const {
        const int L = i * G + c; if (L >= total) return false;
        const int rb = L / npn; int e = 0;
        for (int j = 1; j < NEXP; ++j) e += (bstart[j] <= rb) ? 1 : 0;
        u.pm = rb; u.pn = L - rb * npn; u.ex = e; u.kt0 = 0; u.nkt = nkt; return true;
    }
    __device__ __forceinline__ const char* b_ptr(const Unit& u) const { return Bt + (size_t)u.ex * estride + (size_t)u.pn * tstepB; }
    __device__ __forceinline__ unsigned a_row(const Unit& u, int r) const {
        if (!gather) return (unsigned)(u.pm * BM + r);
        const int pos = (u.pm - bstart[u.ex]) * BM + r;
        return (pos < cntl[u.ex]) ? (unsigned)list[u.ex * LCAP + pos] : 0u;
    }
};
struct EpiSwiGLU {
    static constexpr bool PERM = true;
    unsigned char* HID;
    __device__ __forceinline__ void operator()(AccRef acc, const Unit& u, int wr, int wc, int fr, int fq) const {
        const int rbase = u.pm * BM + wr * 64 + fr, hc0 = u.pn * 128 + wc * 16 + 4 * fq;
#pragma unroll
        for (int ai = 0; ai < 2; ++ai)
#pragma unroll
            for (int m = 0; m < 4; ++m) { unsigned char* rp = HID + (size_t)(rbase + ai * HALF + m * 16) * DFF + hc0;
#pragma unroll
                for (int bj = 0; bj < 2; ++bj) { const f32x4 g = acc[ai][bj][m][0], up = acc[ai][bj][m][1];
                    *(unsigned*)(rp + bj * 64) = pk_fp8x4(g[0] * fast_sigmoid(g[0]) * up[0], g[1] * fast_sigmoid(g[1]) * up[1], g[2] * fast_sigmoid(g[2]) * up[2], g[3] * fast_sigmoid(g[3]) * up[3]); } }
    }
};
struct EpiStoreBf16 {
    static constexpr bool PERM = true;
    bf16* Y;
    __device__ __forceinline__ void operator()(AccRef acc, const Unit& u, int wr, int wc, int fr, int fq) const {
        const int rbase = u.pm * BM + wr * 64 + fr, col0 = u.pn * BM + wc * 32 + 8 * fq;
#pragma unroll
        for (int ai = 0; ai < 2; ++ai)
#pragma unroll
            for (int m = 0; m < 4; ++m) { bf16* rp = Y + (size_t)(rbase + ai * HALF + m * 16) * D + col0;
#pragma unroll
                for (int bj = 0; bj < 2; ++bj) { const f32x4 a = acc[ai][bj][m][0], b = acc[ai][bj][m][1];
                    v4u w; w.x = cvt_pk_bf16(a[0], a[1]); w.y = cvt_pk_bf16(a[2], a[3]); w.z = cvt_pk_bf16(b[0], b[1]); w.w = cvt_pk_bf16(b[2], b[3]);
                    *(v4u*)(rp + bj * HALF) = w; } }
    }
};
}

namespace att {
constexpr int NW = 8, QBLK = 32, KVBLK = 64, QB = 256, OP = 2048;
constexpr int KPITCH = 144, VPITCH = 144;
constexpr int SHM_K = 2 * KVBLK * KPITCH, SHM_V = HD * VPITCH;
constexpr int LDS_BYTES = 2 * SHM_V + 2 * SHM_K + NW * 64 * 4;
constexpr float SCALE = 0.08838834764831845f, THR = 4.f;
constexpr int O8_SHIFT = 4;
constexpr int KM_SHIFT = 4;
#define SBAR() __builtin_amdgcn_sched_barrier(0)
typedef pg8::v8i v8i; typedef pg8::v4i v4i;
__device__ __forceinline__ v8i cat32(v4i a, v4i b) { return __builtin_shufflevector(a, b, 0, 1, 2, 3, 4, 5, 6, 7); }
__device__ __forceinline__ v4i ld16(const unsigned char* p) { return *reinterpret_cast<const v4i*>(p); }
__device__ __forceinline__ f32x16 mma8(v8i a, v8i b, f32x16 c) { return __builtin_amdgcn_mfma_scale_f32_32x32x64_f8f6f4(a, b, c, 0, 0, 0, 127, 0, 127); }
__device__ __forceinline__ int crow(int r, int hi) { return (r & 3) + 8 * (r >> 2) + 4 * hi; }
__device__ __forceinline__ void mask_tile(f32x16& p0, f32x16& p1, int dq) {
    const float NEG = -__builtin_inff();
#pragma unroll
    for (int r = 0; r < 16; ++r) {
        const int c = (r & 3) + 8 * (r >> 2);
        if (dq - c < 0) p0[r] = NEG;
        if (dq - c - 32 < 0) p1[r] = NEG;
    }
}
__device__ __forceinline__ void partialSM(f32x16& p0, f32x16& p1, float& m_reg, float& mn, float& alpha, bool keep) {
    float pmax = p0[0];
#pragma unroll
    for (int r = 1; r < 16; ++r) pmax = fmaxf(pmax, p0[r]);
#pragma unroll
    for (int r = 0; r < 16; ++r) pmax = fmaxf(pmax, p1[r]);
    { auto rr = __builtin_amdgcn_permlane32_swap(__float_as_uint(pmax), __float_as_uint(pmax), false, false);
      pmax = fmaxf(__uint_as_float(rr[0]), __uint_as_float(rr[1])); }
    const float NEG = -__builtin_inff();
    pmax = keep ? pmax : NEG;
    constexpr float C2 = 1.4426950408889634f * SCALE;
    if (__builtin_expect(__all((pmax - m_reg) * SCALE <= THR), 1)) { mn = m_reg; alpha = 1.f; }
    else { mn = fmaxf(m_reg, pmax); alpha = __builtin_amdgcn_exp2f((m_reg - mn) * C2); m_reg = mn; }
    const float c2l = keep ? C2 : 0.f;
    const float mnL = keep ? -mn * C2 : NEG;
#pragma unroll
    for (int r = 0; r < 16; ++r) p0[r] = fmaf(p0[r], c2l, mnL);
#pragma unroll
    for (int r = 0; r < 16; ++r) p1[r] = fmaf(p1[r], c2l, mnL);
#pragma unroll
    for (int r = 0; r < 16; ++r) p0[r] = __builtin_amdgcn_exp2f(p0[r]);
}
__device__ __forceinline__ void finishSM(f32x16& p0, f32x16& p1, float alpha, float& l_reg, v8i& pf) {
#pragma unroll
    for (int r = 0; r < 16; ++r) p1[r] = __builtin_amdgcn_exp2f(p1[r]);
    float ps = 0;
#pragma unroll
    for (int r = 0; r < 16; ++r) ps += p0[r];
#pragma unroll
    for (int r = 0; r < 16; ++r) ps += p1[r];
    { auto rr = __builtin_amdgcn_permlane32_swap(__float_as_uint(ps), __float_as_uint(ps), false, false);
      ps = __uint_as_float(rr[0]) + __uint_as_float(rr[1]); }
    l_reg = l_reg * alpha + ps;
#pragma unroll
    for (int q = 0; q < 4; ++q) { pf[q] = (int)pk_fp8x4(p0[4 * q], p0[4 * q + 1], p0[4 * q + 2], p0[4 * q + 3]); pf[4 + q] = (int)pk_fp8x4(p1[4 * q], p1[4 * q + 1], p1[4 * q + 2], p1[4 * q + 3]); }
}
template <int SUB>
__device__ __forceinline__ void qkt(int KB, f32x16& p0, f32x16& p1, const unsigned char* K_lds, int r32, int hi, const v8i* qf) {
    p0 = f32x16{}; p1 = f32x16{};
    const unsigned char* kb = K_lds + KB * SHM_K + (SUB * KVBLK + r32) * KPITCH + hi * 32;
#pragma unroll
    for (int ks = 0; ks < 2; ++ks) {
        const v8i a0 = cat32(ld16(kb + ks * 64), ld16(kb + ks * 64 + 16)), a1 = cat32(ld16(kb + 32 * KPITCH + ks * 64), ld16(kb + 32 * KPITCH + ks * 64 + 16));
        p0 = mma8(a0, qf[ks], p0); p1 = mma8(a1, qf[ks], p1); }
}
template <int SUB>
__device__ __forceinline__ void pv_tile(int VB, f32x16* o, const unsigned char* V_lds, int r32, int hi, v8i pf) {
    const unsigned char* vb = V_lds + VB * SHM_V + r32 * VPITCH + SUB * KVBLK + hi * 32;
#pragma unroll
    for (int d0 = 0; d0 < 4; ++d0) { const v8i a = cat32(ld16(vb + d0 * 32 * VPITCH), ld16(vb + d0 * 32 * VPITCH + 16)); o[d0] = mma8(a, pf, o[d0]); }
}
__device__ __forceinline__ unsigned moba_sel(const v8i* qf, const unsigned char* KM, int qb, int r32, int hi) {
    f32x16 g = f32x16{}; const unsigned char* kp = KM + (r32 & 15) * HD + hi * 32;
#pragma unroll
    for (int ks = 0; ks < 2; ++ks) g = mma8(cat32(ld16(kp + ks * 64), ld16(kp + ks * 64 + 16)), qf[ks], g);
    float v[16];
#pragma unroll
    for (int r = 0; r < 8; ++r) { const float mine = g[r], oth = __shfl_xor(mine, 32); const int base = (r & 3) + 8 * (r >> 2);
        v[base] = hi ? oth : mine; v[base + 4] = hi ? mine : oth; }
#pragma unroll
    for (int n = 0; n < 16; ++n) v[n] = (n < qb) ? v[n] : -1e30f;
    unsigned sel = 0u;
#pragma unroll
    for (int pass = 0; pass < 3; ++pass) {
        float best = v[0]; int bi = 0;
#pragma unroll
        for (int n = 1; n < 16; ++n) { const bool gt = v[n] > best; best = gt ? v[n] : best; bi = gt ? n : bi; }
        if (best > -1e29f) sel |= 1u << bi;
#pragma unroll
        for (int n = 0; n < 16; ++n) v[n] = (n == bi) ? -__builtin_inff() : v[n];
    }
    return sel;
}
struct BlockRef { const unsigned char* Q; const unsigned char* K; const unsigned char* V; unsigned char* O; const unsigned char* KM; int qb; };
struct Seam { v8i qf[2]; v4i st_k[2], st_v[2]; };
__device__ __forceinline__ BlockRef make_ref(unsigned char* ws, int vcu, int k) {
    const int x8 = vcu & 7, bh = (k < 2) ? (vcu >> 3) : 32 + (vcu >> 3), qb = (k & 1) ? 15 - x8 : x8, b = bh >> 4, h = bh & 15;
    BlockRef r; r.Q = ws + WS_Q8 + ((size_t)bh * SEQ + (size_t)qb * 256) * HD; r.K = ws + WS_K8 + (size_t)bh * SEQ * HD; r.V = ws + WS_VT8 + (size_t)bh * HD * SEQ;
    r.O = ws + WS_O8 + ((size_t)(b * SEQ + qb * 256)) * OP + h * HD; r.KM = ws + WS_KM + (size_t)bh * 16 * HD; r.qb = qb; return r;
}
#define VMW() asm volatile("s_waitcnt vmcnt(0)" ::: "memory")
#define VMWN(n) asm volatile("s_waitcnt vmcnt(%0)" :: "i"(n) : "memory")
#define SLOAD_H(Kp, Vp, k0) do { const unsigned char* kp_ = (Kp) + (size_t)(k0) * HD + klo; const unsigned char* vp_ = (Vp) + (size_t)(k0) + vlo; \
        S.st_k[0] = ld16(kp_); S.st_k[1] = ld16(kp_ + KVBLK * HD); S.st_v[0] = ld16(vp_); S.st_v[1] = ld16(vp_ + KVBLK); } while (0)
#define SWRITE_HK(bf) do { *(v4i*)(K_lds + (bf) * SHM_K + kws) = S.st_k[0]; *(v4i*)(K_lds + (bf) * SHM_K + kws + KVBLK * KPITCH) = S.st_k[1]; } while (0)
#define SWRITE_HV(bf) do { _Pragma("unroll") for (int i_ = 0; i_ < 2; ++i_) { unsigned char* vd_ = V_lds + (bf) * SHM_V + vws + i_ * KVBLK; \
        *(int*)(vd_) = S.st_v[i_][0]; *(int*)(vd_ + 32) = S.st_v[i_][1]; *(int*)(vd_ + 4) = S.st_v[i_][2]; *(int*)(vd_ + 36) = S.st_v[i_][3]; } } while (0)
#define SWRITE_H(bf) do { SWRITE_HV(bf); SWRITE_HK(bf); } while (0)
#define QLOAD(Qp) do { const unsigned char* qp_ = (Qp) + qoff; S.qf[0] = cat32(ld16(qp_), ld16(qp_ + 16)); S.qf[1] = cat32(ld16(qp_ + 64), ld16(qp_ + 80)); } while (0)
#define ATT_GEOM() const int wid = __builtin_amdgcn_readfirstlane(tid >> 6), lane = tid & 63, r32 = lane & 31, hi = lane >> 5; \
    const unsigned klo = (unsigned)((tid >> 3) * HD + (tid & 7) * 16), kws = (unsigned)((tid >> 3) * KPITCH + (tid & 7) * 16); \
    const unsigned vlo = (unsigned)((tid >> 2) * SEQ + (tid & 3) * 16), vws = (unsigned)((tid >> 2) * VPITCH + (tid & 3) * 8); \
    const unsigned qoff = (unsigned)((wid * QBLK + r32) * HD + hi * 32); \
    unsigned char* V_lds = (unsigned char*)lds; unsigned char* K_lds = (unsigned char*)lds + 2 * SHM_V
__device__ __forceinline__ void moba_prime(const BlockRef& cur, char* lds, Seam& S, const int tid) {
    ATT_GEOM(); (void)V_lds; (void)vws;
    QLOAD(cur.Q);
    SLOAD_H(cur.K, cur.V, 0); VMW(); SWRITE_HK(0);
    __syncthreads();
}
__device__ __forceinline__ void moba_block(const BlockRef& cur, const BlockRef& nxt, char* lds, Seam& S, const int tid) {
    ATT_GEOM();
    const int qb = cur.qb, NS = 2 * (qb + 1);
    const int qlo = qb * QB + wid * QBLK;
    unsigned* sel_l = (unsigned*)(lds + 2 * SHM_V + 2 * SHM_K) + wid * 64;
    { const unsigned sel0 = (qb > 0) ? moba_sel(S.qf, cur.KM, qb, r32, hi) : 0u; if (hi == 0) sel_l[r32] = sel0; }
    float m_reg = -1e30f, l_reg = 0; f32x16 o[4] = {};
    const unsigned char* Kh = cur.K; const unsigned char* Vh = cur.V;
#define RESC(a) do { if (__any((a) < 1.f)) { for (int d_ = 0; d_ < 4; ++d_) for (int r = 0; r < 16; ++r) o[d_][r] *= (a); } } while (0)
#define KBASE(t) ((t) * KVBLK)
#define KEEP(t) ((((t) >> 2) >= qb) || (((sel_l[r32] >> ((t) >> 2)) & 1u) != 0u))
#define MASKT(P0_, P1_, t) do { const int kb_ = KBASE(t); if (kb_ + KVBLK - 1 > qlo) mask_tile(P0_, P1_, qlo - kb_ + r32 - 4 * hi); } while (0)
    f32x16 pA0, pA1, pB0, pB1; float mnA, mnB, alA, alB; v8i pf;
#define STEP_A(T_, B_, LOADNEXT) do { SBAR(); qkt<0>(B_, pA0, pA1, K_lds, r32, hi, S.qf); finishSM(pB0, pB1, alB, l_reg, pf); SBAR(); \
        if (LOADNEXT) { SLOAD_H(Kh, Vh, KBASE(2 * (T_) + 2)); SBAR(); } \
        pv_tile<1>(1 - (B_), o, V_lds, r32, hi, pf); MASKT(pA0, pA1, 2 * (T_)); partialSM(pA0, pA1, m_reg, mnA, alA, KEEP(2 * (T_))); RESC(alA); } while (0)
#define STEP_B(T_, B_, WRITENEXT) do { SBAR(); qkt<1>(B_, pB0, pB1, K_lds, r32, hi, S.qf); finishSM(pA0, pA1, alA, l_reg, pf); SBAR(); \
        pv_tile<0>(B_, o, V_lds, r32, hi, pf); MASKT(pB0, pB1, 2 * (T_) + 1); partialSM(pB0, pB1, m_reg, mnB, alB, KEEP(2 * (T_) + 1)); \
        if (WRITENEXT) { __syncthreads(); VMW(); SWRITE_H(1 - (B_)); RESC(alB); __syncthreads(); } else { RESC(alB); } } while (0)
    SWRITE_HV(0); SBAR();
    SLOAD_H(Kh, Vh, KBASE(2));
    SBAR(); qkt<0>(0, pA0, pA1, K_lds, r32, hi, S.qf);
    MASKT(pA0, pA1, 0); partialSM(pA0, pA1, m_reg, mnA, alA, KEEP(0));
    __syncthreads();
    STEP_B(0, 0, true);
    for (int T_ = 1; T_ + 1 < NS; ++T_) { const int bsel = T_ & 1; STEP_A(T_, bsel, true); STEP_B(T_, bsel, true); }
    STEP_A(NS - 1, 1, false);
    SBAR(); qkt<1>(1, pB0, pB1, K_lds, r32, hi, S.qf); SBAR();
    SLOAD_H(nxt.K, nxt.V, 0); SBAR();
    QLOAD(nxt.Q);
    SBAR();
    finishSM(pA0, pA1, alA, l_reg, pf); SBAR();
    pv_tile<0>(1, o, V_lds, r32, hi, pf);
    MASKT(pB0, pB1, 2 * NS - 1); partialSM(pB0, pB1, m_reg, mnB, alB, true); RESC(alB);
    finishSM(pB0, pB1, alB, l_reg, pf); SBAR(); pv_tile<1>(1, o, V_lds, r32, hi, pf);
    SBAR(); VMWN(4); SWRITE_HK(0); SBAR();
    { const float rl = __builtin_amdgcn_rcpf(l_reg) * (float)(1 << O8_SHIFT);
      int r32e = r32, hie = hi; asm volatile("" : "+v"(r32e), "+v"(hie));
      unsigned char* Ow = cur.O + (size_t)(wid * QBLK + r32e) * OP + 4 * hie;
#pragma unroll
      for (int d0 = 0; d0 < 4; ++d0)
#pragma unroll
          for (int g4 = 0; g4 < 4; ++g4) *(unsigned*)(Ow + d0 * 32 + 8 * g4) = pk_fp8x4(o[d0][4 * g4] * rl, o[d0][4 * g4 + 1] * rl, o[d0][4 * g4 + 2] * rl, o[d0][4 * g4 + 3] * rl); }
    __syncthreads();
#undef RESC
#undef KBASE
#undef KEEP
#undef MASKT
#undef STEP_A
#undef STEP_B
}
#undef VMW
#undef VMWN
#undef SLOAD_H
#undef SWRITE_HK
#undef SWRITE_HV
#undef SWRITE_H
#undef QLOAD
#undef ATT_GEOM
}

struct Args { const float* in[23]; float* out; unsigned char* ws; };
typedef const __attribute__((address_space(4))) Args* ArgsP;
__device__ __forceinline__ int ltid(int wave0) { int l; asm volatile("v_mbcnt_lo_u32_b32 %0, -1, 0\n\tv_mbcnt_hi_u32_b32 %0, -1, %0" : "=v"(l)); return (wave0 << 6) | l; }
__device__ __forceinline__ ArgsP kargs() { ArgsP p = (ArgsP)__builtin_amdgcn_kernarg_segment_ptr(); asm volatile("" : "+s"(p)); return p; }
#define WSP(T_, off) ((T_*)(ws + (off)))

struct ConvUnit { const float* W; void* WT; int ldw, ldt, k0, n0, kind, add; };
__device__ __forceinline__ int conv_row(const ConvUnit& c, int n) {
    if (c.kind == 2) { if (n >= 6144) return n - 2048; const int p = n & 127; return (n & ~127) + 2 * (p & 63) + (p >> 6) - 2048; }
    if (c.kind == 3) return (n >> 2) * 8 + (n & 3) + c.add;
    return n;
}
constexpr int CBUF = 65536, OP8 = 144, OP16 = 272;
__device__ __forceinline__ void conv_dma(const ConvUnit& c, int wave, int lane, LAS unsigned char* buf) {
    const float* Wl = c.W + (size_t)(c.k0 + 16 * wave + (lane >> 5)) * c.ldw + c.n0 + 4 * (lane & 31);
#pragma unroll
    for (int i = 0; i < 8; ++i) __builtin_amdgcn_global_load_lds((const unsigned*)(Wl + (size_t)(2 * i) * c.ldw), (LAS unsigned*)(buf + (16 * wave + 2 * i) * 512), 16, 0, 0);
}
__device__ __forceinline__ void conv_read(int wave, int lane, const LAS unsigned char* buf, float (&f)[32]) {
    const LAS float* p = (const LAS float*)(buf + (16 * wave) * 512 + 4 * lane);
#pragma unroll
    for (int i = 0; i < 16; ++i) { f[i] = p[i * 128]; f[16 + i] = p[i * 128 + 64]; }
}
__device__ __forceinline__ void conv_park8(int wave, int lane, LAS unsigned char* img, const float (&f)[32]) {
    constexpr float SC = (float)(1 << pg8::W8_SHIFT);
#pragma unroll
    for (int h = 0; h < 2; ++h) { v4u o; o.x = pk_fp8x4(f[16 * h] * SC, f[16 * h + 1] * SC, f[16 * h + 2] * SC, f[16 * h + 3] * SC); o.y = pk_fp8x4(f[16 * h + 4] * SC, f[16 * h + 5] * SC, f[16 * h + 6] * SC, f[16 * h + 7] * SC);
        o.z = pk_fp8x4(f[16 * h + 8] * SC, f[16 * h + 9] * SC, f[16 * h + 10] * SC, f[16 * h + 11] * SC); o.w = pk_fp8x4(f[16 * h + 12] * SC, f[16 * h + 13] * SC, f[16 * h + 14] * SC, f[16 * h + 15] * SC);
        *(LAS v4u*)(img + (lane + 64 * h) * OP8 + 16 * wave) = o; }
}
__device__ __forceinline__ void conv_out8(const ConvUnit& c, int tid, const LAS unsigned char* img) {
#pragma unroll
    for (int j = 0; j < 2; ++j) { const int row = (tid >> 3) + 64 * j, ch = tid & 7; const v4u v = *(const LAS v4u*)(img + row * OP8 + 16 * ch);
        *(v4u*)((unsigned char*)c.WT + (size_t)conv_row(c, c.n0 + row) * c.ldt + c.k0 + 16 * ch) = v; }
}
__device__ __forceinline__ void conv_park16(int wave, int lane, LAS unsigned char* img, const float (&f)[32], const int h) {
    v4u o0, o1; o0.x = pk2(f[16 * h], f[16 * h + 1]); o0.y = pk2(f[16 * h + 2], f[16 * h + 3]); o0.z = pk2(f[16 * h + 4], f[16 * h + 5]); o0.w = pk2(f[16 * h + 6], f[16 * h + 7]);
    o1.x = pk2(f[16 * h + 8], f[16 * h + 9]); o1.y = pk2(f[16 * h + 10], f[16 * h + 11]); o1.z = pk2(f[16 * h + 12], f[16 * h + 13]); o1.w = pk2(f[16 * h + 14], f[16 * h + 15]);
    LAS unsigned char* q = img + lane * OP16 + 32 * wave; *(LAS v4u*)q = o0; *(LAS v4u*)(q + 16) = o1;
}
__device__ __forceinline__ void conv_out16(const ConvUnit& c, int tid, const LAS unsigned char* img, const int h) {
#pragma unroll
    for (int j = 0; j < 2; ++j) { const int row = (tid >> 4) + 32 * j, ch = tid & 15; const v4u v = *(const LAS v4u*)(img + row * OP16 + 16 * ch);
        *(v4u*)((bf16*)c.WT + (size_t)conv_row(c, c.n0 + 64 * h + row) * c.ldt + c.k0 + 8 * ch) = v; }
}
constexpr int NCONV = 8320;
__device__ __forceinline__ ConvUnit conv_decode(int u, ArgsP A, unsigned char* ws) {
    ConvUnit c; c.add = 0;
    if (u < 1536) { const int kp = u / 96, g = u - kp * 96; c.W = A->in[6]; c.ldw = INC; c.k0 = kp * 128; c.n0 = g * 128; c.ldt = D;
        if (g < 16) { c.WT = ws + WS_WINZ; c.kind = 0; } else { c.WT = ws + WS_WIN8; c.kind = 2; } return c; }
    u -= 1536;
    if (u < 128) { c.W = A->in[11]; c.ldw = D; c.k0 = (u >> 4) * 128; c.n0 = (u & 15) * 128; c.WT = ws + WS_WSO; c.ldt = SGW; c.kind = 0; return c; }
    u -= 128;
    if (u < 256) { c.W = A->in[12]; c.ldw = D; c.k0 = (u >> 4) * 128; c.n0 = (u & 15) * 128; c.WT = ws + WS_WMO8; c.ldt = D; c.kind = 1; return c; }
    u -= 256;
    if (u < 256) { c.W = A->in[13]; c.ldw = D; c.k0 = (u >> 4) * 128; c.n0 = (u & 15) * 128; c.WT = ws + WS_WOUT; c.ldt = D; c.kind = 1; return c; }
    u -= 256;
    const int m = u >> 11, r = u & 2047, e = r >> 6, q = r & 63;
    if (m < 2) { c.W = A->in[19 + m] + (size_t)e * D * DFF; c.ldw = DFF; c.k0 = (q >> 2) * 128; c.n0 = (q & 3) * 128; c.WT = ws + WS_WGU8 + (size_t)e * 1024 * D; c.ldt = D; c.kind = 3; c.add = 4 * m; return c; }
    c.W = A->in[21] + (size_t)e * DFF * D; c.ldw = D; c.k0 = (q >> 4) * 128; c.n0 = (q & 15) * 128; c.WT = ws + WS_WD8 + (size_t)e * D * DFF; c.ldt = DFF; c.kind = 1; return c;
}
constexpr int NCONV_EARLY = 1536;
__device__ __forceinline__ void conv_run(LAS unsigned char* lds, const int tid, const int wave, const int lane, int u, const int uend) {
    float f[32];
    LAS unsigned char* b0 = lds; LAS unsigned char* b1 = lds + CBUF; LAS unsigned char* img = lds + TAB_OFF;
#define CONV_CLAMP(x) ((x) < uend ? (x) : uend - 1)
#define CONV_BAR() do { asm volatile("s_waitcnt lgkmcnt(0)" ::: "memory"); __builtin_amdgcn_s_barrier(); asm volatile("" ::: "memory"); } while (0)
#define CONV_STEP(N, buf) do { \
        asm volatile("s_waitcnt vmcnt(" #N ")" ::: "memory"); __builtin_amdgcn_s_barrier(); asm volatile("" ::: "memory"); \
        conv_read(wave, lane, buf, f); CONV_BAR(); \
        { ArgsP Ai = kargs(); const ConvUnit cn = conv_decode(CONV_CLAMP(u + 512), Ai, Ai->ws); conv_dma(cn, wave, lane, buf); } \
        { ArgsP Ai = kargs(); const ConvUnit c = conv_decode(u, Ai, Ai->ws); \
          if (c.kind != 0) { conv_park8(wave, lane, img, f); CONV_BAR(); conv_out8(c, tid, img); } \
          else { conv_park16(wave, lane, img, f, 0); CONV_BAR(); conv_out16(c, tid, img, 0); CONV_BAR(); conv_park16(wave, lane, img, f, 1); CONV_BAR(); conv_out16(c, tid, img, 1); } } \
        u += 256; } while (0)
    { ArgsP Ai = kargs(); const ConvUnit c = conv_decode(u, Ai, Ai->ws); conv_dma(c, wave, lane, b0); }
    { ArgsP Ai = kargs(); const ConvUnit c = conv_decode(CONV_CLAMP(u + 256), Ai, Ai->ws); conv_dma(c, wave, lane, b1); }
    CONV_STEP(8, b0);
    if (u < uend) { CONV_STEP(10, b1);
        for (;;) {
            if (u >= uend) break; CONV_STEP(12, b0);
            if (u >= uend) break; CONV_STEP(12, b1);
        } }
    asm volatile("s_waitcnt vmcnt(0)" ::: "memory");
    __builtin_amdgcn_s_barrier();
#undef CONV_STEP
#undef CONV_BAR
#undef CONV_CLAMP
}

__global__ void __launch_bounds__(NWAVES * 64, 2) fwd_kernel(Args args) {
    extern __shared__ __attribute__((aligned(16))) unsigned char lds_raw[];
    LAS unsigned char* lds = (LAS unsigned char*)lds_raw;
    const int wave0 = __builtin_amdgcn_readfirstlane((int)threadIdx.x >> 6);
    constexpr int G = 256;
#define BX ((int)blockIdx.x)
#define VCU (((int)blockIdx.x & 7) * 32 + ((int)blockIdx.x >> 3))
    volatile LAS unsigned* MISC = (volatile LAS unsigned*)(lds + MISC_OFF);
    for (int u = ltid(wave0); u < (LDS_BYTES - LDSCTL_OFF) / 4; u += NWAVES * 64) ((LAS unsigned*)(lds + LDSCTL_OFF))[u] = 0u;
    __syncthreads();
    (void)xcd_barrier_post((unsigned*)(args.ws + WS_CTL) + CW_BAR, MISC + 8, ltid(wave0));
#define GRID_BAR() do { XcdBarrier b_; b_.bar = (unsigned*)(kargs()->ws + WS_CTL) + CW_BAR; b_.x = xb_xcc_id(); b_.st = (volatile LAS unsigned*)(lds + MISC_OFF) + 8; xcd_barrier(b_, ltid(wave0)); } while (0)

    DUPLOOP(0) {
    {
        ArgsP A = kargs(); unsigned char* ws = A->ws; const int tid = ltid(wave0), lane = tid & 63, wave = __builtin_amdgcn_readfirstlane(tid >> 6); (void)lane; (void)wave; gu32* ctl = (gu32*)(ws + WS_CTL);
        const float* cin = A->in[1];
        LAS float* cact = (LAS float*)(lds + 98304);
        for (int i = tid; i < BATCH * D; i += NWAVES * 64) { const float v = cin[i]; cact[i] = v / (1.0f + __expf(-v)); }
        __syncthreads();
        { const int it = (wave < 6) ? VCU * 6 + wave : 1536 + VCU * 2 + (wave - 6); ArgsP Ai = kargs(); unsigned char* wsi = Ai->ws;
            if (it < 1536) {
                const int qd = it / 384, col = (it - qd * 384) * 32 + 4 * (lane & 7), rq = lane >> 3;
                f32x4 a0 = {0.f, 0.f, 0.f, 0.f}, a1 = a0, a2 = a0, a3 = a0;
                for (int k0 = qd * 512; k0 < qd * 512 + 512; k0 += 256) {
                    f32x4 w[32];
#pragma unroll
                    for (int i = 0; i < 32; ++i) w[i] = *(const f32x4*)(Ai->in[3] + (size_t)(k0 + rq + 8 * i) * 12288 + col);
#pragma unroll
                    for (int i = 0; i < 32; ++i) { const int k = k0 + rq + 8 * i;
                        a0 += cact[k] * w[i]; a1 += cact[D + k] * w[i]; a2 += cact[2 * D + k] * w[i]; a3 += cact[3 * D + k] * w[i]; }
                }
#pragma unroll
                for (int e = 0; e < 4; ++e)
#pragma unroll
                    for (int o = 8; o < 64; o <<= 1) { a0[e] += __shfl_xor(a0[e], o); a1[e] += __shfl_xor(a1[e], o); a2[e] += __shfl_xor(a2[e], o); a3[e] += __shfl_xor(a3[e], o); }
                if (rq == 0) { const f32x4 bb = (qd == 0) ? *(const f32x4*)(Ai->in[4] + col) : (f32x4){0.f, 0.f, 0.f, 0.f}; float* ap = ((float*)(wsi + WS_ADAP)) + (size_t)qd * 49152 + col;
                    *(f32x4*)(ap) = a0 + bb; *(f32x4*)(ap + 12288) = a1 + bb; *(f32x4*)(ap + 2 * 12288) = a2 + bb; *(f32x4*)(ap + 3 * 12288) = a3 + bb; }
            } else if (it < 1792) {
                const int tok = (it - 1536) * 64 + lane; const double pos = (double)((const int*)Ai->in[2])[tok];
                float* cosT = (float*)(wsi + WS_COS); float* sinT = (float*)(wsi + WS_SIN);
                double inv = 1.0;
                for (int j = 0; j < 64; ++j) {
                    const double rev = pos * inv * 0.15915494309189535;
                    const float fr = (float)(rev - __builtin_floor(rev));
                    cosT[(size_t)tok * 64 + j] = __builtin_amdgcn_cosf(fr); sinT[(size_t)tok * 64 + j] = __builtin_amdgcn_sinf(fr);
                    inv *= 0.8659643233600653;
                }
            } else if (it < 1824) {
                const int g = (it - 1792) >> 2, part = (it - 1792) & 3; bf16* WSb = (bf16*)(wsi + WS_WS);
                for (int i = part * 4096 + lane; i < part * 4096 + 4096; i += 64) { const int r = i >> 7, c = i & 127; WSb[g * 16384 + i] = (c <= r) ? (bf16)f2bf(Ai->in[9][g * 16384 + i]) : (bf16)0; }
            } else if (it < 2016) {
                const int q = it - 1824, u = q & 7, n0 = (q >> 3) * 2; bf16* RT = (bf16*)(wsi + WS_RT);
#pragma unroll
                for (int nn = 0; nn < 2; ++nn) { const int n = n0 + nn;
#pragma unroll
                    for (int i = 0; i < 4; ++i) { const int k = u * 256 + lane + 64 * i; const float w = (n < 4) ? Ai->in[15][k * 4 + n] : (n < 36) ? Ai->in[17][k * 32 + (n - 4)] : 0.f;
                        const unsigned hi = f2bf(w); const int ks = k >> 5, kk = k & 31; RT[((ks * 2) * 48 + n) * 32 + kk] = (bf16)hi; RT[((ks * 2 + 1) * 48 + n) * 32 + kk] = (bf16)f2bf(w - __builtin_bit_cast(float, hi << 16)); } }
            }
        }
        __syncthreads();
        conv_run(lds, tid, wave, lane, VCU, NCONV_EARLY);
    }
    GRID_BAR();
    }

    DUPLOOP(1) {
    {
        ArgsP A = kargs(); unsigned char* ws = A->ws; const int tid = ltid(wave0), lane = tid & 63, wave = __builtin_amdgcn_readfirstlane(tid >> 6); (void)lane; (void)wave;
        const float* x = A->in[0]; const float* g_mix = A->in[5]; const float* adap = WSP(float, WS_ADAP); float* adaf = WSP(float, WS_ADA); bf16* Nb = WSP(bf16, WS_N); unsigned char* N8 = ws + WS_N1F8;
        LAS float* tg = (LAS float*)(lds); LAS float* tb = (LAS float*)(lds + 8192);
        const int row0 = VCU * 64, b = row0 >> 12;
        for (int i = tid; i < D; i += NWAVES * 64) { const float* ap = adap + b * 12288 + i;
            tg[i] = g_mix[i] * (1.0f + ((ap[2048] + ap[49152 + 2048]) + (ap[2 * 49152 + 2048] + ap[3 * 49152 + 2048]))); tb[i] = (ap[0] + ap[49152]) + (ap[2 * 49152] + ap[3 * 49152]); }
        if (tid < 192) { const int i = VCU * 192 + tid; adaf[i] = (adap[i] + adap[49152 + i]) + (adap[2 * 49152 + i] + adap[3 * 49152 + i]); }
        __syncthreads();
        for (int rq = 0; rq < 2; ++rq) {
            f32x4 v[4][8];
#pragma unroll
            for (int q = 0; q < 4; ++q) { const f32x4* xr = (const f32x4*)(x + (size_t)(row0 + wave * 8 + rq * 4 + q) * D) + lane;
#pragma unroll
                for (int j = 0; j < 8; ++j) v[q][j] = xr[64 * j]; }
#pragma unroll
            for (int q = 0; q < 4; ++q) { const int row = row0 + wave * 8 + rq * 4 + q; float ss = 0.f;
#pragma unroll
                for (int j = 0; j < 8; ++j) ss += (v[q][j].x * v[q][j].x + v[q][j].y * v[q][j].y) + (v[q][j].z * v[q][j].z + v[q][j].w * v[q][j].w);
                const float rstd = rsqrtf(wave_sum(ss) * (1.f / D) + EPS);
                v2u* o8 = (v2u*)(Nb + (size_t)row * D) + lane;
#pragma unroll
                for (int j = 0; j < 8; ++j) { const f32x4 gg = *(const LAS f32x4*)(tg + 4 * lane + 256 * j), bb = *(const LAS f32x4*)(tb + 4 * lane + 256 * j);
                    const f32x4 y = v[q][j] * rstd * gg + bb; v2u w; w.x = cvt_pk_bf16(y.x, y.y); w.y = cvt_pk_bf16(y.z, y.w); o8[64 * j] = w;
                    *((unsigned*)(N8 + (size_t)row * D) + lane + 64 * j) = pk_fp8x4(y.x, y.y, y.z, y.w); } }
        }
    }
    GRID_BAR();
    }

    DUPLOOP(2) {
    {
        ArgsP A = kargs(); unsigned char* ws = A->ws; const int tid = ltid(wave0), lane = tid & 63, wave = __builtin_amdgcn_readfirstlane(tid >> 6); (void)lane; (void)wave;
        bf16* Nb = WSP(bf16, WS_N); bf16* UV = WSP(bf16, WS_UV); unsigned char* Qh = ws + WS_Q8; unsigned char* Kh = ws + WS_K8; unsigned char* Vh = ws + WS_VT8;
        bf16* SAg = WSP(bf16, WS_SA); bf16* SBg = WSP(bf16, WS_SB); const float* cosT = WSP(float, WS_COS); const float* sinT = WSP(float, WS_SIN);
        { pg8::StaticOrder S; S.init(T, 2048, D * 2, G, BX, ws + WS_WINZ);
          pg8::EpiInProj E{UV, Qh, Kh, Vh, SAg, SBg, cosT, sinT, 0};
          pg8::gemm_phase<false>(lds, (const char*)Nb, D * 2, S, E, tid); }
        { pg8::StaticOrder S; S.init(T, 10240, D, G, BX, ws + WS_WIN8);
          pg8::EpiInProj E{UV, Qh, Kh, Vh, SAg, SBg, cosT, sinT, 8};
          pg8::gemm_phase<true>(lds, (const char*)(ws + WS_N1F8), D, S, E, tid); }
    }
    GRID_BAR();
    }

    DUPLOOP(3) {
    {
        ArgsP A = kargs(); unsigned char* ws = A->ws; const int tid = ltid(wave0), lane = tid & 63, wave = __builtin_amdgcn_readfirstlane(tid >> 6); (void)lane; (void)wave;
        const float* sgu_ln_g = A->in[7]; const float* sgu_ln_b = A->in[8]; const float* sgu_b_s = A->in[10];
        const bf16* UV = WSP(bf16, WS_UV); const bf16* WSb = WSP(bf16, WS_WS); bf16* SGUO = WSP(bf16, WS_SGUO); const unsigned char* K8 = ws + WS_K8; unsigned char* KM = ws + WS_KM;
        constexpr int VP = 136;
        LAS bf16* vT = (LAS bf16*)lds; LAS f32x2* st = (LAS f32x2*)(lds + 2 * 128 * VP * 2); LAS float* kx = (LAS float*)(lds + 73728);
        { const int item = VCU * NWAVES + wave, blk = item >> 1, half = item & 1, c8 = (lane & 15) * 8, r0 = lane >> 4;
          const unsigned char* kp = K8 + ((size_t)blk * 256 + half * 128 + r0) * HD + c8;
          float sacc[8] = {0.f, 0.f, 0.f, 0.f, 0.f, 0.f, 0.f, 0.f};
          { v2u w[32];
#pragma unroll
              for (int u = 0; u < 32; ++u) w[u] = *(const v2u*)(kp + (size_t)(4 * u) * HD);
#pragma unroll
              for (int u = 0; u < 32; ++u) { const f32x2 a0 = __builtin_amdgcn_cvt_pk_f32_fp8((int)w[u].x, false), a1 = __builtin_amdgcn_cvt_pk_f32_fp8((int)w[u].x, true), a2 = __builtin_amdgcn_cvt_pk_f32_fp8((int)w[u].y, false), a3 = __builtin_amdgcn_cvt_pk_f32_fp8((int)w[u].y, true);
                  sacc[0] += a0.x; sacc[1] += a0.y; sacc[2] += a1.x; sacc[3] += a1.y; sacc[4] += a2.x; sacc[5] += a2.y; sacc[6] += a3.x; sacc[7] += a3.y; } }
#pragma unroll
          for (int e = 0; e < 8; ++e) { sacc[e] += __shfl_xor(sacc[e], 16); sacc[e] += __shfl_xor(sacc[e], 32); }
          LAS float* kxp = kx + (wave >> 1) * 128 + c8;
          if (half == 1 && lane < 16) {
#pragma unroll
              for (int e = 0; e < 8; ++e) kxp[e] = sacc[e]; }
          __syncthreads();
          if (half == 0 && lane < 16) {
#pragma unroll
              for (int e = 0; e < 8; ++e) sacc[e] = (sacc[e] + kxp[e]) * ((float)(1 << att::KM_SHIFT) / 256.f);
              v2u o; o.x = pk_fp8x4(sacc[0], sacc[1], sacc[2], sacc[3]); o.y = pk_fp8x4(sacc[4], sacc[5], sacc[6], sacc[7]);
              *(v2u*)(KM + (size_t)blk * HD + c8) = o; } }
        {
            const int ch = VCU >> 1, hf = VCU & 1, R0 = ch * 128;
            v4u aa[4][8];
#pragma unroll
            for (int it4 = 0; it4 < 4; ++it4) { const v4u* vp = (const v4u*)(UV + (size_t)(R0 + wave * 16 + it4 * 4 + (lane >> 4)) * D + SGW) + (lane & 15);
#pragma unroll
                for (int q = 0; q < 8; ++q) aa[it4][q] = vp[16 * q]; }
#pragma unroll
            for (int it4 = 0; it4 < 4; ++it4) { const int j = wave * 16 + it4 * 4 + (lane >> 4);
                const v4u (&a)[8] = aa[it4];
                float s = 0.f;
#pragma unroll
                for (int q = 0; q < 8; ++q) s += ((bflo(a[q].x) + bfhi(a[q].x)) + (bflo(a[q].y) + bfhi(a[q].y))) + ((bflo(a[q].z) + bfhi(a[q].z)) + (bflo(a[q].w) + bfhi(a[q].w)));
#pragma unroll
                for (int o = 1; o < 16; o <<= 1) s += __shfl_xor(s, o);
                const float mean = s * (1.f / SGW); float qv = 0.f;
#pragma unroll
                for (int q = 0; q < 8; ++q) { float d;
                    d = bflo(a[q].x) - mean; qv += d * d; d = bfhi(a[q].x) - mean; qv += d * d; d = bflo(a[q].y) - mean; qv += d * d; d = bfhi(a[q].y) - mean; qv += d * d;
                    d = bflo(a[q].z) - mean; qv += d * d; d = bfhi(a[q].z) - mean; qv += d * d; d = bflo(a[q].w) - mean; qv += d * d; d = bfhi(a[q].w) - mean; qv += d * d; }
#pragma unroll
                for (int o = 1; o < 16; o <<= 1) qv += __shfl_xor(qv, o);
                if ((lane & 15) == 0) st[j] = (f32x2){mean, rsqrtf(qv * (1.f / SGW) + EPS)};
            }
            __syncthreads();
            for (int ps = 0; ps < 2; ++ps) {
                const int gp = hf * 2 + ps;
                { const int j = lane + 64 * (wave & 1), cb = 64 * (wave >> 1); const f32x2 ms = st[j];
                  v4u a[8];
#pragma unroll
                  for (int cq = 0; cq < 8; ++cq) a[cq] = *(const v4u*)(UV + (size_t)(R0 + j) * D + SGW + gp * 256 + cb + 8 * cq);
#pragma unroll
                  for (int cq = 0; cq < 8; ++cq) { const int c0 = cb + 8 * cq, chn = gp * 256 + c0;
                      const f32x4 g0 = *(const f32x4*)(sgu_ln_g + chn), g1 = *(const f32x4*)(sgu_ln_g + chn + 4), b0 = *(const f32x4*)(sgu_ln_b + chn), b1 = *(const f32x4*)(sgu_ln_b + chn + 4);
                      const float e[8] = {bflo(a[cq].x), bfhi(a[cq].x), bflo(a[cq].y), bfhi(a[cq].y), bflo(a[cq].z), bfhi(a[cq].z), bflo(a[cq].w), bfhi(a[cq].w)};
                      const float gg[8] = {g0[0], g0[1], g0[2], g0[3], g1[0], g1[1], g1[2], g1[3]}, bb[8] = {b0[0], b0[1], b0[2], b0[3], b1[0], b1[1], b1[2], b1[3]};
#pragma unroll
                      for (int i = 0; i < 8; ++i) vT[(c0 + i) * VP + j] = (bf16)f2bf((e[i] - ms.x) * ms.y * gg[i] + bb[i]); } }
                __syncthreads();
                { const int g = wave >> 2, ib = wave & 3, gg = gp * 2 + g, r32 = lane & 31, hi = lane >> 5; const int nks = 2 * (ib + 1);
                  const bf16* Wg = WSb + (size_t)gg * 16384 + (size_t)(ib * 32 + r32) * 128 + hi * 8;
                  f32x16 acc[4] = {};
                  const int tokr = R0 + ib * 32 + r32;
                  bf16x8 bwv[8]; v2u uu[4][4];
#pragma unroll
                  for (int ks = 0; ks < 8; ++ks) bwv[ks] = *(const bf16x8*)(Wg + (ks < nks ? ks : 0) * 16);
#pragma unroll
                  for (int db = 0; db < 4; ++db)
#pragma unroll
                      for (int q4 = 0; q4 < 4; ++q4) uu[db][q4] = *(const v2u*)(UV + (size_t)tokr * D + gg * 128 + db * 32 + 8 * q4 + 4 * hi);
                  __builtin_amdgcn_sched_barrier(0);
#pragma unroll
                  for (int ks = 0; ks < 8; ++ks) { if (ks >= nks) break;
                      const bf16x8 bw = bwv[ks];
#pragma unroll
                      for (int db = 0; db < 4; ++db) { const bf16x8 av = *(const LAS bf16x8*)(vT + (size_t)(g * 128 + db * 32 + r32) * VP + ks * 16 + hi * 8);
                          acc[db] = __builtin_amdgcn_mfma_f32_32x32x16_bf16(av, bw, acc[db], 0, 0, 0); }
                  }
                  const float bs = sgu_b_s[gg * 128 + ib * 32 + r32];
#pragma unroll
                  for (int db = 0; db < 4; ++db)
#pragma unroll
                      for (int q4 = 0; q4 < 4; ++q4) { const int d = db * 32 + 8 * q4 + 4 * hi;
                          const v2u u2 = uu[db][q4];
                          v2u w; w.x = cvt_pk_bf16(bflo(u2.x) * (acc[db][4 * q4 + 0] + bs), bfhi(u2.x) * (acc[db][4 * q4 + 1] + bs));
                          w.y = cvt_pk_bf16(bflo(u2.y) * (acc[db][4 * q4 + 2] + bs), bfhi(u2.y) * (acc[db][4 * q4 + 3] + bs));
                          *(v2u*)(SGUO + (size_t)tokr * SGW + gg * 128 + d) = w; } }
                __syncthreads();
            }
        }
    }
    GRID_BAR();
    }

    if ((BX & 1) == 0) { const int tid = ltid(wave0); conv_run(lds, tid, __builtin_amdgcn_readfirstlane(tid >> 6), tid & 63, NCONV_EARLY + VCU, NCONV); }
    {
        char* al = (char*)lds_raw;
        ArgsP A = kargs(); unsigned char* ws = A->ws; const int tid = ltid(wave0), lane = tid & 63, wave = __builtin_amdgcn_readfirstlane(tid >> 6); (void)lane; (void)wave;
        att::Seam S;
        att::moba_prime(att::make_ref(ws, VCU, 0), al, S, tid);
        constexpr int NBLK = 4 * ((((PROBE_DUP) >> 4) & 1) + 1);
        for (int k = 0; k < NBLK; ++k) att::moba_block(att::make_ref(ws, VCU, k & 3), att::make_ref(ws, VCU, (k + 1) & 3), al, S, tid);
    }
    if ((BX & 1) != 0) { asm volatile("s_waitcnt vmcnt(0)" ::: "memory"); __syncthreads(); const int tid = ltid(wave0); conv_run(lds, tid, __builtin_amdgcn_readfirstlane(tid >> 6), tid & 63, NCONV_EARLY + VCU, NCONV); }
    GRID_BAR();

    DUPLOOP(5) {
    {
        ArgsP A = kargs(); unsigned char* ws = A->ws; const int tid = ltid(wave0), lane = tid & 63, wave = __builtin_amdgcn_readfirstlane(tid >> 6); (void)lane; (void)wave;
        const bf16* SAg = WSP(bf16, WS_SA); const bf16* SBg = WSP(bf16, WS_SB); bf16* T1 = WSP(bf16, WS_Q); unsigned char* MERGED = ws + WS_MERGED;
        { pg8::StaticOrder S; S.init(T, D, SGW * 2, G, BX, ws + WS_WSO);
          pg8::EpiGateSeg E{SAg, SBg, T1, MERGED, 0};
          pg8::gemm_phase<false>(lds, (const char*)(ws + WS_SGUO), SGW * 2, S, E, tid); }
        { pg8::StaticOrder S; S.init(T, D, D, G, BX, ws + WS_WMO8);
          pg8::EpiGateSeg E{SAg, SBg, T1, MERGED, 1};
          pg8::gemm_phase<true>(lds, (const char*)(ws + WS_O8), D, S, E, tid, att::O8_SHIFT); }
    }
    GRID_BAR();
    }

    DUPLOOP(6) {
    {
        ArgsP A = kargs(); unsigned char* ws = A->ws; const int tid = ltid(wave0), lane = tid & 63, wave = __builtin_amdgcn_readfirstlane(tid >> 6); (void)lane; (void)wave;
        const float* ada = WSP(float, WS_ADA); bf16* DELTA = WSP(bf16, WS_DELTA);
        pg8::StaticOrder S; S.init(T, D, D, G, BX, ws + WS_WOUT);
        pg8::EpiDelta E{ada + 4096, DELTA};
        pg8::gemm_phase<true>(lds, (const char*)(ws + WS_MERGED), D, S, E, tid, pg8::M8_SHIFT);
    }
    GRID_BAR();
    }

    DUPLOOP(10) {
    {
        ArgsP A = kargs(); unsigned char* ws = A->ws; const int tid = ltid(wave0), lane = tid & 63, wave = __builtin_amdgcn_readfirstlane(tid >> 6); (void)lane; (void)wave; gu32* ctl = (gu32*)(ws + WS_CTL);
        const float* g_ffn = A->in[14]; const float* b_rg = A->in[16]; const float* b_re = A->in[18]; const float* __restrict__ x = A->in[0]; const bf16* __restrict__ DELTA = WSP(bf16, WS_DELTA);
        const float* ada = WSP(float, WS_ADA); const bf16* __restrict__ RT = WSP(bf16, WS_RT); unsigned char* __restrict__ N28 = ws + WS_N2F8;
        int* tok_e = WSP(int, WS_TOKE); int* tok_p = WSP(int, WS_TOKP); float* tok_w = WSP(float, WS_TOKW); int* elist = WSP(int, WS_LIST);
        if (rep_ == 1) { ctl += 32768; tok_e = WSP(int, WS_K); tok_p = tok_e + 2 * T; tok_w = (float*)(tok_p + 2 * T); elist = (int*)(ws + WS_K + 8 * MiB); }
        LAS unsigned char* At = lds;
        LAS float* lgx = (LAS float*)(lds + TAB_OFF);
        const int row0 = VCU * 64, b = row0 >> 12;
        LAS float* tgs = (LAS float*)(lds + TAB_OFF + 12288); LAS float* tsh = tgs + D;
        for (int i = tid; i < D; i += NWAVES * 64) { tgs[i] = g_ffn[i] * (ada[b * 12288 + 8192 + i] + 1.0f); tsh[i] = ada[b * 12288 + 6144 + i]; }
        __syncthreads();
        for (int ps = 0; ps < 2; ++ps) {
            { const LAS f32x4* gp = (const LAS f32x4*)tgs + lane; const LAS f32x4* shp = (const LAS f32x4*)tsh + lane;
#pragma unroll
              for (int rp = 0; rp < 2; ++rp) {
                  f32x4 v[2][8]; v2u dl[2][8];
#pragma unroll
                  for (int q = 0; q < 2; ++q) { const int row = row0 + ps * 32 + wave * 4 + rp * 2 + q;
#pragma unroll
                      for (int j = 0; j < 8; ++j) { v[q][j] = *((const f32x4*)(x + (size_t)row * D) + lane + 64 * j); dl[q][j] = *((const v2u*)(DELTA + (size_t)row * D) + lane + 64 * j); } }
#pragma unroll
                  for (int q = 0; q < 2; ++q) { const int rl = wave * 4 + rp * 2 + q, row = row0 + ps * 32 + rl; float ss = 0.f;
#pragma unroll
                      for (int j = 0; j < 8; ++j) { v[q][j] += (f32x4){bflo(dl[q][j].x), bfhi(dl[q][j].x), bflo(dl[q][j].y), bfhi(dl[q][j].y)};
                          ss += (v[q][j].x * v[q][j].x + v[q][j].y * v[q][j].y) + (v[q][j].z * v[q][j].z + v[q][j].w * v[q][j].w); }
                      const float rstd = rsqrtf(wave_sum(ss) * (1.f / D) + EPS);
#pragma unroll
                      for (int j = 0; j < 8; ++j) { const f32x4 y = v[q][j] * rstd * gp[64 * j] + shp[64 * j];
                          *((unsigned*)(N28 + (size_t)row * D) + lane + 64 * j) = pk_fp8x4(y.x, y.y, y.z, y.w);
                          v2u w; w.x = cvt_pk_bf16(y.x, y.y); w.y = cvt_pk_bf16(y.z, y.w);
                          *(LAS v2u*)(At + rl * 4096 + ((((lane >> 1) + 32 * j) ^ (rl & 15)) << 4) + ((lane & 1) << 3)) = w; } } } }
            __syncthreads();
            { const int i = lane & 15, kq = lane >> 4;
                f32x4 acc[2][3];
#pragma unroll
                for (int mt = 0; mt < 2; ++mt)
#pragma unroll
                    for (int nt = 0; nt < 3; ++nt) acc[mt][nt] = (f32x4){0.f, 0.f, 0.f, 0.f};
                unsigned voff = (unsigned)((wave * 8) * (2 * 48 * 32) + i * 32 + 8 * kq) * 2u;
#pragma unroll 1
                for (int ks = 0; ks < 8; ++ks, voff += 6144u) { const int kg = wave * 8 + ks;
                    bf16x8 wh[3], wl[3];
                    const char* ph = (const char*)RT + voff; const char* pl = ph + 3072;
#pragma unroll
                    for (int nt = 0; nt < 3; ++nt) { wh[nt] = *(const bf16x8*)(ph + nt * 1024); wl[nt] = *(const bf16x8*)(pl + nt * 1024); }
#pragma unroll
                    for (int mt = 0; mt < 2; ++mt) { const bf16x8 af = *(const LAS bf16x8*)(At + (16 * mt + i) * 4096 + (((4 * kg + kq) ^ i) << 4));
#pragma unroll
                        for (int nt = 0; nt < 3; ++nt) { acc[mt][nt] = __builtin_amdgcn_mfma_f32_16x16x32_bf16(af, wh[nt], acc[mt][nt], 0, 0, 0); acc[mt][nt] = __builtin_amdgcn_mfma_f32_16x16x32_bf16(af, wl[nt], acc[mt][nt], 0, 0, 0); } } }
                __syncthreads();
                LAS float* part = (LAS float*)At + wave * 1536;
#pragma unroll
                for (int mt = 0; mt < 2; ++mt)
#pragma unroll
                    for (int nt = 0; nt < 3; ++nt)
#pragma unroll
                        for (int e = 0; e < 4; ++e) part[(16 * mt + 4 * kq + e) * 48 + nt * 16 + i] = acc[mt][nt][e];
                __syncthreads();
#pragma unroll
                for (int q = 0; q < 3; ++q) { const int idx = tid + 512 * q; float sum = 0.f;
#pragma unroll
                    for (int w8 = 0; w8 < 8; ++w8) sum += ((const LAS float*)At)[w8 * 1536 + idx];
                    lgx[ps * 1536 + idx] = sum; }
                __syncthreads(); }
        }
        if (wave == 7) {
            const LAS float* l = lgx + lane * 48; const int tokn = row0 + lane;
            float gl[4]; int gs = 0; float gmax;
#pragma unroll
            for (int q = 0; q < 4; ++q) gl[q] = l[q] + b_rg[q];
            gmax = gl[0];
#pragma unroll
            for (int q = 1; q < 4; ++q) if (gl[q] > gmax) { gmax = gl[q]; gs = q; }
            float den = 0.f;
#pragma unroll
            for (int q = 0; q < 4; ++q) den += __expf(gl[q] - gmax);
            const float pg = 1.0f / den;
            float v0 = -3.0e38f, v1 = -3.0e38f; int i0 = 0, i1 = 0;
#pragma unroll
            for (int q = 0; q < 8; ++q) { const float ev = l[4 + gs * 8 + q] + b_re[gs * 8 + q];
                if (ev > v0) { v1 = v0; i1 = i0; v0 = ev; i0 = q; } else if (ev > v1) { v1 = ev; i1 = q; } }
            const float t = __expf(v1 - v0), w0 = pg / (1.0f + t), w1 = pg * t / (1.0f + t);
            const int e0 = gs * 8 + i0, e1 = gs * 8 + i1;
            const int p0 = (int)__hip_atomic_fetch_add(ctl + CW_CNT + 64 * e0, 1u, RLX_AGENT);
            const int p1 = (int)__hip_atomic_fetch_add(ctl + CW_CNT + 64 * e1, 1u, RLX_AGENT);
            elist[e0 * LCAP + p0] = tokn; elist[e1 * LCAP + p1] = tokn;
            tok_e[2 * tokn] = e0; tok_e[2 * tokn + 1] = e1; tok_p[2 * tokn] = p0; tok_p[2 * tokn + 1] = p1; tok_w[2 * tokn] = w0; tok_w[2 * tokn + 1] = w1;
        }
    }
    GRID_BAR();
    }

    LAS int* bstart = (LAS int*)(lds + TAB_OFF); LAS int* cntl = (LAS int*)(lds + TAB_OFF + 256);
    { const int t = ltid(wave0);
      if (t < 64) { gu32* ctl = (gu32*)(kargs()->ws + WS_CTL);
          const int c = (t < NEXP) ? (int)__hip_atomic_load(ctl + CW_CNT + 64 * (t & 31), RLX_AGENT) : 0, nb = (c + 255) >> 8;
          int incl = nb;
#pragma unroll
          for (int o = 1; o < 32; o <<= 1) { const int v = __shfl_up(incl, o); if (t >= o) incl += v; }
          if (t < NEXP) { cntl[t] = c; bstart[t] = incl - nb; if (t == NEXP - 1) bstart[NEXP] = incl; } } }
    __syncthreads();
    const int RB = bstart[NEXP];
    DUPLOOP(7) {
        ArgsP A = kargs(); unsigned char* ws = A->ws; const int tid = ltid(wave0), lane = tid & 63, wave = __builtin_amdgcn_readfirstlane(tid >> 6); (void)lane; (void)wave;
        const int* elist = WSP(int, WS_LIST);
        pg8::MoeSched S{bstart, cntl, elist, 4, RB * 4, G, BX, D / 128, (const char*)(ws + WS_WGU8), (size_t)1024 * D, (size_t)256 * D, true};
        pg8::EpiSwiGLU E{ws + WS_HID8};
        pg8::gemm_phase<true>(lds, (const char*)(ws + WS_N2F8), D, S, E, tid);
        GRID_BAR();
    }
    DUPLOOP(8) {
        ArgsP A = kargs(); unsigned char* ws = A->ws; const int tid = ltid(wave0), lane = tid & 63, wave = __builtin_amdgcn_readfirstlane(tid >> 6); (void)lane; (void)wave;
        const int* elist = WSP(int, WS_LIST); bf16* YROW = WSP(bf16, WS_YROW);
        pg8::MoeSched S{bstart, cntl, elist, 8, RB * 8, G, BX, DFF / 128, (const char*)(ws + WS_WD8), (size_t)D * DFF, (size_t)256 * DFF, false};
        pg8::EpiStoreBf16 E{YROW};
        pg8::gemm_phase<true>(lds, (const char*)(ws + WS_HID8), DFF, S, E, tid);
        GRID_BAR();
    }

    DUPLOOP(9)
    {
        ArgsP A = kargs(); unsigned char* ws = A->ws; const int tid = ltid(wave0), lane = tid & 63, wave = __builtin_amdgcn_readfirstlane(tid >> 6); (void)lane; (void)wave;
        float* out = A->out; const float* x = A->in[0]; const bf16* DELTA = WSP(bf16, WS_DELTA); const float* g_fin = A->in[22]; const float* ada = WSP(float, WS_ADA); const bf16* YROW = WSP(bf16, WS_YROW);
        const int* tok_e = WSP(int, WS_TOKE); const int* tok_p = WSP(int, WS_TOKP); const float* tok_w = WSP(float, WS_TOKW);
        const bool poison = __hip_atomic_load((gu32*)(ws + WS_CTL) + CW_BAR + XB_TMO, RLX_AGENT) != 0u;
        LAS float* tgf = (LAS float*)lds; LAS float* tgn = tgf + D;
        { const int b0 = (VCU * NWAVES * 8) >> 12; for (int i = tid; i < D; i += NWAVES * 64) { tgf[i] = ada[(size_t)b0 * 12288 + 10240 + i]; tgn[i] = g_fin[i]; } }
        __syncthreads();
        for (int rr = 0; rr < 8; ++rr) {
            const int row = (VCU * NWAVES + wave) * 8 + rr;
            const int e0 = tok_e[2 * row], e1 = tok_e[2 * row + 1];
            const size_t s0 = (size_t)(bstart[e0] * 256 + tok_p[2 * row]), s1 = (size_t)(bstart[e1] * 256 + tok_p[2 * row + 1]);
            const float w0 = tok_w[2 * row], w1 = tok_w[2 * row + 1];
            f32x4* hr = (f32x4*)(out + (size_t)row * D) + lane; const f32x4* xr = (const f32x4*)(x + (size_t)row * D) + lane; const v2u* dr = (const v2u*)(DELTA + (size_t)row * D) + lane;
            const v2u* y0 = (const v2u*)(YROW + s0 * D) + lane; const v2u* y1 = (const v2u*)(YROW + s1 * D) + lane;
            const LAS f32x4* gf = (const LAS f32x4*)tgf + lane;
            f32x4 v[8]; float ss = 0.f;
#pragma unroll
            for (int j = 0; j < 8; ++j) { const v2u dl = dr[64 * j]; const f32x4 hv = xr[64 * j] + (f32x4){bflo(dl.x), bfhi(dl.x), bflo(dl.y), bfhi(dl.y)}, gg = gf[64 * j]; const v2u a = y0[64 * j], c = y1[64 * j];
                f32x4 y; y.x = w0 * bflo(a.x) + w1 * bflo(c.x); y.y = w0 * bfhi(a.x) + w1 * bfhi(c.x); y.z = w0 * bflo(a.y) + w1 * bflo(c.y); y.w = w0 * bfhi(a.y) + w1 * bfhi(c.y);
                v[j] = hv + gg * y; ss += (v[j].x * v[j].x + v[j].y * v[j].y) + (v[j].z * v[j].z + v[j].w * v[j].w); }
            const float rstd = rsqrtf(wave_sum(ss) * (1.f / D) + EPS);
#pragma unroll
            for (int j = 0; j < 8; ++j) { const f32x4 gg = *((const LAS f32x4*)tgn + lane + 64 * j); hr[64 * j] = poison ? (f32x4){__builtin_nanf(""), __builtin_nanf(""), __builtin_nanf(""), __builtin_nanf("")} : v[j] * rstd * gg; }
        }
    }
}

extern "C" void kernel_launch(void* const* d_in, const int* in_sizes, int n_in, void* d_out, int out_size, void* d_ws, size_t ws_size, hipStream_t stream) {
    static int grid = 0;
    if (grid == 0) {
        if (n_in != 23 || in_sizes[0] != T * D || out_size != T * D || ws_size < WS_END) { fprintf(stderr, "kernel_launch: unexpected shapes (n_in %d, out %d, ws %zu)\n", n_in, out_size, ws_size); grid = -1; return; }
        int dev = 0, cus = 0, per_cu = 0;
        if (hipGetDevice(&dev) != hipSuccess || hipDeviceGetAttribute(&cus, hipDeviceAttributeMultiprocessorCount, dev) != hipSuccess) { grid = -1; return; }
        if (hipFuncSetAttribute((const void*)fwd_kernel, hipFuncAttributeMaxDynamicSharedMemorySize, LDS_BYTES) != hipSuccess) { fprintf(stderr, "kernel_launch: hipFuncSetAttribute failed\n"); grid = -1; return; }
        if (hipOccupancyMaxActiveBlocksPerMultiprocessor(&per_cu, (const void*)fwd_kernel, NWAVES * 64, LDS_BYTES) != hipSuccess || per_cu < 1) fprintf(stderr, "kernel_launch: occupancy query reports %d\n", per_cu);
        (void)hipGetLastError();
        grid = cus;
        if (grid != 256) { fprintf(stderr, "kernel_launch: this kernel is built for 256 CUs, got %d\n", grid); grid = -1; return; }
    }
    if (grid < 0) return;
    (void)hipMemsetAsync((char*)d_ws + WS_CTL, 0, CTL_ZERO_BYTES, stream);
    Args a{};
    for (int i = 0; i < 23; ++i) a.in[i] = (const float*)d_in[i];
    a.out = (float*)d_out; a.ws = (unsigned char*)d_ws;
    hipLaunchKernelGGL(fwd_kernel, dim3(grid), dim3(NWAVES * 64), LDS_BYTES, stream, a);
}
```

```cpp
#include <hip/hip_runtime.h>
#include <cstdio>
#include <cstdint>

#define GAS __attribute__((address_space(1)))
#define LAS __attribute__((address_space(3)))
typedef unsigned short bf16;
typedef unsigned v4u __attribute__((ext_vector_type(4)));
typedef unsigned v2u __attribute__((ext_vector_type(2)));
typedef float f32x2 __attribute__((ext_vector_type(2)));
typedef float f32x4 __attribute__((ext_vector_type(4)));
typedef float f32x16 __attribute__((ext_vector_type(16)));
typedef short bf16x8 __attribute__((ext_vector_type(8)));
typedef short s16x4 __attribute__((ext_vector_type(4)));
typedef GAS unsigned gu32;
#define RLX_AGENT __ATOMIC_RELAXED, __HIP_MEMORY_SCOPE_AGENT
#define LDS_WAIT() asm volatile("s_waitcnt lgkmcnt(0)" ::: "memory")
#define VM_WAIT() asm volatile("s_waitcnt vmcnt(0)" ::: "memory")

constexpr int BATCH = 4, SEQ = 4096, T = BATCH * SEQ, D = 2048;
constexpr int SGW = 1024, NHEAD = 16, HD = 128, INC = 12288;
constexpr int NEXP = 32, DFF = 512, LCAP = 16384;
constexpr float EPS = 1e-6f;
constexpr int NWAVES = 8;
#ifndef PROBE_DUP
#define PROBE_DUP 0
#endif
#define DUPLOOP(k) for (int rep_ = 0; rep_ < (((PROBE_DUP) >> (k)) & 1) + 1; ++rep_)

constexpr size_t MiB = 1u << 20;
constexpr size_t WS_CTL = 0, CTL_ZERO_BYTES = 1 * MiB;
constexpr size_t WS_ADAP = 1 * MiB;
constexpr size_t WS_ADA = 1 * MiB + 786432;
constexpr size_t WS_COS = 2 * MiB, WS_SIN = 6 * MiB;
constexpr size_t WS_KM = 10 * MiB;
constexpr size_t WS_WS = 10 * MiB + 512 * 1024;
constexpr size_t WS_RT = 11 * MiB;
constexpr size_t WS_TOKE = 12 * MiB, WS_TOKP = WS_TOKE + 128 * 1024, WS_TOKW = WS_TOKP + 128 * 1024;
constexpr size_t WS_LIST = 13 * MiB;
constexpr size_t WS_WINZ = 16 * MiB;
constexpr size_t WS_WIN8 = 24 * MiB;
constexpr size_t WS_WSO = 48 * MiB;
constexpr size_t WS_WMO8 = 52 * MiB;
constexpr size_t WS_WOUT = 60 * MiB;
constexpr size_t WS_WGU8 = 68 * MiB;
constexpr size_t WS_WD8 = 132 * MiB;
constexpr size_t WS_N = 164 * MiB;
constexpr size_t WS_N1F8 = 228 * MiB;
constexpr size_t WS_UV = 260 * MiB;
constexpr size_t WS_Q = 324 * MiB, WS_K = 388 * MiB, WS_V = 452 * MiB;
constexpr size_t WS_SA = 516 * MiB, WS_SB = 580 * MiB;
constexpr size_t WS_END = 644 * MiB;
constexpr size_t WS_Q8 = WS_Q, WS_K8 = WS_K, WS_VT8 = WS_V;
constexpr size_t WS_SGUO = WS_N, WS_O8 = WS_N + 32 * MiB, WS_N2F8 = WS_UV, WS_MERGED = WS_UV, WS_HID8 = WS_N, WS_YROW = WS_Q, WS_DELTA = WS_SA;
constexpr int CW_BAR = 4096, CW_QUEUE = 8192, CW_CNT = 8192 + 64;

constexpr int RING_BYTES = 131072, LDSCTL_OFF = RING_BYTES, MISC_OFF = LDSCTL_OFF + 320, TAB_OFF = LDSCTL_OFF + 1024;
constexpr int LDS_BYTES = 163840;

__device__ __forceinline__ unsigned f2bf(float f) { unsigned u = __builtin_bit_cast(unsigned, f); return (u + 0x7fffu + ((u >> 16) & 1u)) >> 16; }
__device__ __forceinline__ unsigned pk2(float lo, float hi) { return f2bf(lo) | (f2bf(hi) << 16); }
typedef __bf16 bf16x2_t __attribute__((ext_vector_type(2)));
__device__ __forceinline__ unsigned cvt_pk_bf16(float lo, float hi) { f32x2 v = {lo, hi}; bf16x2_t b = __builtin_convertvector(v, bf16x2_t); return __builtin_bit_cast(unsigned, b); }
__device__ __forceinline__ unsigned pk_fp8x4(float a, float b, float c, float d) { unsigned w = 0u; w = __builtin_amdgcn_cvt_pk_fp8_f32(a, b, w, false); w = __builtin_amdgcn_cvt_pk_fp8_f32(c, d, w, true); return w; }
__device__ __forceinline__ float bflo(unsigned w) { return __builtin_bit_cast(float, w << 16); }
__device__ __forceinline__ float bfhi(unsigned w) { return __builtin_bit_cast(float, w & 0xffff0000u); }
__device__ __forceinline__ float wave_sum(float v) {
#pragma unroll
    for (int o = 1; o < 64; o <<= 1) v += __shfl_xor(v, o);
    return v;
}
__device__ __forceinline__ float fast_sigmoid(float x) { return __builtin_amdgcn_rcpf(1.0f + __builtin_amdgcn_exp2f(-1.4426950408889634f * x)); }
__device__ __forceinline__ float gelu_tanh(float x) { const float u = x * (1.0f + 0.044715f * x * x); return x * __builtin_amdgcn_rcpf(1.0f + __builtin_amdgcn_exp2f(-2.3022081985f * u)); }

#define XB_TMO      128
#define XB_XCNT(j)  (256  + 64 * (j))
#define XB_XSUB(j)  (1280 + 64 * (j))
#define XB_XGEN(j)  (2304 + 64 * (j))
#define XB_TOP      3328
#define XB_TOPGEN   3392
#define XCD_BAR_WORDS 3456
#define XB_SPIN_CAP (1u << 18)
__device__ __forceinline__ unsigned xb_ld(unsigned* p)              { return __hip_atomic_load(p, __ATOMIC_RELAXED, __HIP_MEMORY_SCOPE_AGENT); }
__device__ __forceinline__ unsigned xb_add(unsigned* p, unsigned v) { return __hip_atomic_fetch_add(p, v, __ATOMIC_RELAXED, __HIP_MEMORY_SCOPE_AGENT); }
__device__ __forceinline__ unsigned xb_xcc_id() { return (unsigned)__builtin_amdgcn_s_getreg((3 << 11) | 20) & 0xFu; }
#define XB_SPIN(cond, bar) do { unsigned _sp = 0; while (cond) { __builtin_amdgcn_s_sleep(1); \
    if ((++_sp & 255u) == 0u) { if (xb_ld(&(bar)[XB_TMO])) break; if (_sp > XB_SPIN_CAP) { atomicAdd(&(bar)[XB_TMO], 1u); break; } } } } while (0)
struct XcdBarrier { unsigned* bar; unsigned x; volatile LAS unsigned* st; };
__device__ __forceinline__ XcdBarrier xcd_barrier_post(unsigned* bar, volatile LAS unsigned* st, int tid) {
    XcdBarrier b; b.bar = bar; b.x = xb_xcc_id(); b.st = st;
    if (tid == 0) (void)xb_add(&bar[XB_XCNT(b.x)], 1u);
    return b;
}
__device__ __forceinline__ void xcd_barrier_complete(unsigned* bar, unsigned x, unsigned& nloc, unsigned& nx) {
    const unsigned G = gridDim.x * gridDim.y * gridDim.z;
    unsigned sum, cnt, mine, sp = 0u;
    for (;;) {
        sum = 0u; cnt = 0u; mine = 0u;
#pragma unroll
        for (unsigned j = 0; j < 16; ++j) { const unsigned c = xb_ld(&bar[XB_XCNT(j)]); sum += c; cnt += (c > 0u) ? 1u : 0u; mine = (j == x) ? c : mine; }
        if (sum == G) break;
        __builtin_amdgcn_s_sleep(1);
        if ((++sp & 255u) == 0u) { if (xb_ld(&bar[XB_TMO])) break; if (sp > XB_SPIN_CAP) { atomicAdd(&bar[XB_TMO], 1u); break; } }
    }
    nloc = mine > 0u ? mine : 1u; nx = cnt > 0u ? cnt : 1u;
}
__device__ __forceinline__ void xcd_barrier(const XcdBarrier& b, int tid) {
    asm volatile("s_waitcnt vmcnt(0)" ::: "memory");
    __syncthreads();
    if (tid == 0) {
        unsigned* bar = b.bar;
        __builtin_amdgcn_s_waitcnt(0);
        unsigned nloc = b.st[0], nx = b.st[1];
        if (nloc == 0u) { xcd_barrier_complete(bar, b.x, nloc, nx); b.st[0] = nloc; b.st[1] = nx; }
        const unsigned old = xb_add(&bar[XB_XSUB(b.x)], 1u);
        const unsigned gen = old / nloc;
        if (old + 1u == (gen + 1u) * nloc) {
            __builtin_amdgcn_fence(__ATOMIC_RELEASE, "agent");
            asm volatile("s_waitcnt vmcnt(0)" ::: "memory");
            const unsigned og = xb_add(&bar[XB_TOP], 1u);
            const unsigned tg = og / nx;
            if (og + 1u == (tg + 1u) * nx) xb_add(&bar[XB_TOPGEN], 1u);
            else XB_SPIN(xb_ld(&bar[XB_TOPGEN]) == tg, bar);
            __builtin_amdgcn_fence(__ATOMIC_ACQUIRE, "agent");
            xb_add(&bar[XB_XGEN(b.x)], 1u);
            asm volatile("s_waitcnt vmcnt(0)" ::: "memory");
        } else {
            XB_SPIN(xb_ld(&bar[XB_XGEN(b.x)]) == gen, bar);
            __builtin_amdgcn_fence(__ATOMIC_ACQUIRE, "agent");
            asm volatile("s_waitcnt vmcnt(0)" ::: "memory");
        }
    }
    __syncthreads();
}

namespace pg8 {
constexpr int BM = 256, BK = 64, HALF = 128, HTB = HALF * BK * 2, STAGE_BYTES = 8 * HTB, NXCD = 8, WGM = 8;
__device__ __forceinline__ int lds_byte(int r, int c) { const int st = (r >> 4) * 2 + (c >> 5), rr = r & 15, cc = c & 31, ob = rr * 64 + cc * 2; return st * 1024 + (ob ^ (((ob >> 9) & 1) << 5)); }
__device__ __forceinline__ void stage_rc(int b, int& R, int& C) { const int st = b / 1024, sb = b % 1024, swz = sb ^ (((sb >> 9) & 1) << 5); R = (st >> 1) * 16 + swz / 64; C = (st & 1) * 32 + (swz % 64) / 2; }
__device__ __forceinline__ int perm32(int rho) { const int n = rho >> 4, i = rho & 15; return 8 * (i >> 2) + 4 * n + (i & 3); }
typedef int v8i __attribute__((ext_vector_type(8)));
typedef int v4i __attribute__((ext_vector_type(4)));
constexpr int M8_SHIFT = 4;
constexpr int W8_SHIFT = 5;
__device__ __forceinline__ v8i cat8(bf16x8 lo, bf16x8 hi) { const v4i a = __builtin_bit_cast(v4i, lo), b = __builtin_bit_cast(v4i, hi); return __builtin_shufflevector(a, b, 0, 1, 2, 3, 4, 5, 6, 7); }
struct Unit { int pm, pn, ex, kt0, nkt; };

struct StaticOrder {
    int nM, nN, nwg, G, c, nkt; const char* Bt; size_t tstepB;
    __device__ __forceinline__ void init(int M, int N, int rowbytes, int G_, int c_, const void* Bt_) { nM = M / BM; nN = N / BM; nwg = nM * nN; G = G_; c = c_; Bt = (const char*)Bt_; tstepB = (size_t)BM * rowbytes; nkt = rowbytes / 128; }
    __device__ __forceinline__ bool next(int i, Unit& u) const {
        const long L = (long)i * G + c; if (L >= nwg) return false;
        int wgid = (int)L; { const int q = nwg / NXCD, r = nwg % NXCD, xcd = wgid % NXCD, off = wgid / NXCD; wgid = (xcd < r ? xcd * (q + 1) : r * (q + 1) + (xcd - r) * q) + off; }
        const int nig = WGM * nN, gid = wgid / nig, fm = gid * WGM, gsz = (nM - fm) < WGM ? (nM - fm) : WGM;
        u.pm = fm + ((wgid % nig) % gsz); u.pn = (wgid % nig) / gsz; u.ex = 0; u.kt0 = 0; u.nkt = nkt; return true;
    }
    __device__ __forceinline__ const char* b_ptr(const Unit& u) const { return Bt + (size_t)u.pn * tstepB; }
    __device__ __forceinline__ unsigned a_row(const Unit& u, int r) const { return (unsigned)(u.pm * BM + r); }
};

template <bool F8, class Epi, class Sched>
__device__ __forceinline__ void gemm_phase(LAS unsigned char* lds, const char* Ab, const int rowbytes, const Sched& S, const Epi& E, const int tid, const int a8shift = 0) {
    const int wid = __builtin_amdgcn_readfirstlane(tid >> 6), lane = tid & 63, wr = wid >> 2, wc = wid & 3, fr = lane & 15, fq = lane >> 4;
    int Rs[2]; unsigned Cs[2], voffB[2];
#pragma unroll
    for (int i = 0; i < 2; ++i) { int R, C; stage_rc(tid * 16 + i * 8192, R, C); const int Rb = Epi::PERM ? ((R & ~31) + perm32(R & 31)) : R;
        Rs[i] = R; Cs[i] = (unsigned)C * 2u; voffB[i] = (unsigned)(Rb * rowbytes + C * 2); }
    const size_t kstep = (size_t)(BK * 2);
    const size_t hstep = (size_t)HALF * rowbytes;
    const unsigned rowb = (unsigned)rowbytes;
    const unsigned ldsw = (unsigned)wid * 1024u;
    const int aoff = lds_byte(wr * 64 + fr, fq * 8), boff = lds_byte(wc * 32 + fr, fq * 8);
#define PG8_SA(b, h) (((b) * 2 + (h)) * HTB)
#define PG8_SB(b, h) ((4 + (b) * 2 + (h)) * HTB)
#define PG8_STAGE_B(bufoff, gbase) do { _Pragma("unroll") for (int _i = 0; _i < 2; ++_i) \
        __builtin_amdgcn_global_load_lds((const unsigned*)((const char*)(gbase) + voffB[_i]), (LAS unsigned*)(lds + (bufoff) + ldsw + _i * 8192), 16, 0, 0); } while (0)
#define PG8_STAGE_A(bufoff, kbyte, h) do { _Pragma("unroll") for (int _i = 0; _i < 2; ++_i) \
        __builtin_amdgcn_global_load_lds((const unsigned*)(Ab + (kbyte) + vC[h][_i]), (LAS unsigned*)(lds + (bufoff) + ldsw + _i * 8192), 16, 0, 0); } while (0)
#define PG8_LDA(dst, b, h) do { _Pragma("unroll") for (int m = 0; m < 4; ++m) _Pragma("unroll") for (int k = 0; k < 2; ++k) dst[m][k] = *(const LAS bf16x8*)(lds + PG8_SA(b, h) + aoff + m * 2048 + k * 1024); } while (0)
#define PG8_LDB(dst, b, h) do { _Pragma("unroll") for (int n = 0; n < 2; ++n) _Pragma("unroll") for (int k = 0; k < 2; ++k) dst[n][k] = *(const LAS bf16x8*)(lds + PG8_SB(b, h) + boff + n * 2048 + k * 1024); } while (0)
#define PG8_MMA(ai, bj, At, Bt) do { __builtin_amdgcn_s_setprio(1); _Pragma("unroll") for (int m = 0; m < 4; ++m) _Pragma("unroll") for (int n = 0; n < 2; ++n) { \
        if constexpr (F8) acc[ai][bj][m][n] = __builtin_amdgcn_mfma_scale_f32_16x16x128_f8f6f4(cat8(Bt[n][0], Bt[n][1]), cat8(At[m][0], At[m][1]), acc[ai][bj][m][n], 0, 0, 0, 127 - W8_SHIFT, 0, 127 - a8shift); \
        else { _Pragma("unroll") for (int k = 0; k < 2; ++k) acc[ai][bj][m][n] = __builtin_amdgcn_mfma_f32_16x16x32_bf16(Bt[n][k], At[m][k], acc[ai][bj][m][n], 0, 0, 0); } } __builtin_amdgcn_s_setprio(0); } while (0)
#define PG8_WAIT_V(n) asm volatile("s_waitcnt vmcnt(" #n ")" ::: "memory")
#define PG8_WAIT_L(n) asm volatile("s_waitcnt lgkmcnt(" #n ")" ::: "memory")
#define PG8_BAR __builtin_amdgcn_s_barrier()
#define PG8_SCHED __builtin_amdgcn_sched_barrier(0)
    Unit cur, nxt; int ui = 0;
    if (!S.next(0, cur)) return;
    f32x4 acc[2][2][4][2];
#pragma unroll
    for (int a = 0; a < 2; ++a)
#pragma unroll
        for (int b = 0; b < 2; ++b)
#pragma unroll
            for (int m = 0; m < 4; ++m)
#pragma unroll
                for (int n = 0; n < 2; ++n) acc[a][b][m][n] = (f32x4){0.f, 0.f, 0.f, 0.f};
    bf16x8 At[4][2], B0[2][2], B1[2][2];
    unsigned vC[2][2], vN[2][2];
#pragma unroll
    for (int h = 0; h < 2; ++h)
#pragma unroll
        for (int i = 0; i < 2; ++i) vC[h][i] = S.a_row(cur, h * HALF + Rs[i]) * rowb + Cs[i];
    const char* cB = S.b_ptr(cur) + (size_t)cur.kt0 * kstep; size_t kc = (size_t)cur.kt0 * kstep; int nt = cur.nkt;
    PG8_STAGE_B(PG8_SB(0, 0), cB); PG8_STAGE_B(PG8_SB(0, 1), cB + hstep); PG8_STAGE_A(PG8_SA(0, 0), kc, 0); PG8_STAGE_A(PG8_SA(0, 1), kc, 1);
    if (wr == 1) PG8_BAR;
    PG8_WAIT_V(2); PG8_BAR;
    PG8_STAGE_B(PG8_SB(1, 0), cB + kstep); PG8_STAGE_A(PG8_SA(1, 0), kc + kstep, 0); PG8_STAGE_B(PG8_SB(1, 1), cB + hstep + kstep);
    PG8_WAIT_V(6); PG8_BAR;
    for (;;) {
        const bool has_next = S.next(ui + 1, nxt);
        const char* nB = has_next ? S.b_ptr(nxt) + (size_t)nxt.kt0 * kstep : cB; const size_t kn = has_next ? (size_t)nxt.kt0 * kstep : kc;
#pragma unroll
        for (int h = 0; h < 2; ++h)
#pragma unroll
            for (int i = 0; i < 2; ++i) vN[h][i] = has_next ? (S.a_row(nxt, h * HALF + Rs[i]) * rowb + Cs[i]) : vC[h][i];
        for (int t = 0; t < nt; t += 2) {
            const bool last = (t == nt - 2);
            const size_t ka1 = kc + (size_t)(t + 1) * kstep;
            const size_t ka2 = last ? kn : kc + (size_t)(t + 2) * kstep;
            const char* b2 = last ? nB : cB + (size_t)(t + 2) * kstep; const char* b3 = b2 + kstep;
            PG8_LDB(B0, 0, 0); PG8_LDB(B1, 0, 1); PG8_SCHED; PG8_LDA(At, 0, 0); PG8_STAGE_A(PG8_SA(1, 1), ka1, 1);
            if (last) {
#pragma unroll
                for (int h = 0; h < 2; ++h)
#pragma unroll
                    for (int i = 0; i < 2; ++i) vC[h][i] = vN[h][i];
            }
            PG8_WAIT_V(8); PG8_WAIT_L(0); PG8_BAR; PG8_MMA(0, 0, At, B0); PG8_MMA(0, 1, At, B1); PG8_BAR; PG8_SCHED;
            PG8_LDA(At, 0, 1); PG8_STAGE_B(PG8_SB(0, 0), b2); PG8_STAGE_B(PG8_SB(0, 1), b2 + hstep); PG8_STAGE_A(PG8_SA(0, 0), ka2, 0);
            PG8_WAIT_V(8); PG8_WAIT_L(0); PG8_BAR; PG8_MMA(1, 0, At, B0); PG8_MMA(1, 1, At, B1); PG8_BAR; PG8_SCHED;
            PG8_LDB(B0, 1, 0); PG8_LDB(B1, 1, 1); PG8_SCHED; PG8_LDA(At, 1, 0); PG8_STAGE_A(PG8_SA(0, 1), ka2, 1);
            PG8_WAIT_V(8); PG8_WAIT_L(0); PG8_BAR; PG8_MMA(0, 0, At, B0); PG8_MMA(0, 1, At, B1); PG8_BAR; PG8_SCHED;
            PG8_LDA(At, 1, 1); PG8_STAGE_B(PG8_SB(1, 0), b3); PG8_STAGE_B(PG8_SB(1, 1), b3 + hstep); PG8_STAGE_A(PG8_SA(1, 0), ka2 + kstep, 0);
            PG8_WAIT_V(8); PG8_WAIT_L(0); PG8_BAR; PG8_MMA(1, 0, At, B0); PG8_MMA(1, 1, At, B1); PG8_BAR; PG8_SCHED;
        }
        if (wr == 0) PG8_BAR;
        E(acc, cur, wr, wc, fr, fq);
        if (!has_next) break;
#pragma unroll
        for (int a = 0; a < 2; ++a)
#pragma unroll
            for (int b = 0; b < 2; ++b)
#pragma unroll
                for (int m = 0; m < 4; ++m)
#pragma unroll
                    for (int n = 0; n < 2; ++n) acc[a][b][m][n] = (f32x4){0.f, 0.f, 0.f, 0.f};
        cur = nxt; cB = nB; kc = kn; nt = cur.nkt; ++ui;
        if (wr == 1) PG8_BAR;
    }
    PG8_WAIT_V(0);
    PG8_BAR;
#undef PG8_SA
#undef PG8_SB
#undef PG8_STAGE_A
#undef PG8_STAGE_B
#undef PG8_LDA
#undef PG8_LDB
#undef PG8_MMA
#undef PG8_WAIT_V
#undef PG8_WAIT_L
#undef PG8_BAR
#undef PG8_SCHED
}

typedef const f32x4 (&AccRef)[2][2][4][2];

struct EpiInProj {
    static constexpr bool PERM = true;
    bf16* UV; unsigned char* Q8; unsigned char* K8; unsigned char* VT8; bf16* SA; bf16* SB; const float* cosT; const float* sinT; int pn_off;
    __device__ __forceinline__ void operator()(AccRef acc, const Unit& u, int wr, int wc, int fr, int fq) const {
        asm volatile("" : "+v"(fr), "+v"(fq));
        const int pn = u.pn + pn_off, rbase = u.pm * BM + wr * 64 + fr, cl = wc * 32 + 8 * fq;
        if (pn < 8) {
#pragma unroll
            for (int ai = 0; ai < 2; ++ai)
#pragma unroll
                for (int m = 0; m < 4; ++m) { bf16* rp = UV + (size_t)(rbase + ai * HALF + m * 16) * D + pn * BM + cl;
#pragma unroll
                    for (int bj = 0; bj < 2; ++bj) { const f32x4 a = acc[ai][bj][m][0], b = acc[ai][bj][m][1];
                        v4u w; w.x = cvt_pk_bf16(gelu_tanh(a[0]), gelu_tanh(a[1])); w.y = cvt_pk_bf16(gelu_tanh(a[2]), gelu_tanh(a[3]));
                        w.z = cvt_pk_bf16(gelu_tanh(b[0]), gelu_tanh(b[1])); w.w = cvt_pk_bf16(gelu_tanh(b[2]), gelu_tanh(b[3]));
                        *(v4u*)(rp + bj * HALF) = w; } }
        } else if (pn < 24) {
            unsigned char* dst = (pn < 16) ? Q8 : K8; const int hp = ((pn - 8) & 7) * 2, j0 = cl >> 1;
#pragma unroll
            for (int ai = 0; ai < 2; ++ai) {
                f32x4 cc[4], sn[4];
#pragma unroll
                for (int m = 0; m < 4; ++m) { const int row = rbase + ai * HALF + m * 16; cc[m] = *(const f32x4*)(cosT + (size_t)row * 64 + j0); sn[m] = *(const f32x4*)(sinT + (size_t)row * 64 + j0); }
#pragma unroll
                for (int m = 0; m < 4; ++m) { const int row = rbase + ai * HALF + m * 16, b = row >> 12, s = row & 4095;
                    const f32x4 c4 = cc[m], s4 = sn[m];
#pragma unroll
                    for (int bj = 0; bj < 2; ++bj) { const f32x4 x0 = acc[ai][bj][m][0], x1 = acc[ai][bj][m][1];
                        v2u w;
                        w.x = pk_fp8x4(x0[0] * c4[0] - x0[1] * s4[0], x0[1] * c4[0] + x0[0] * s4[0], x0[2] * c4[1] - x0[3] * s4[1], x0[3] * c4[1] + x0[2] * s4[1]);
                        w.y = pk_fp8x4(x1[0] * c4[2] - x1[1] * s4[2], x1[1] * c4[2] + x1[0] * s4[2], x1[2] * c4[3] - x1[3] * s4[3], x1[3] * c4[3] + x1[2] * s4[3]);
                        *(v2u*)(dst + ((size_t)(b * NHEAD + hp + bj) * SEQ + s) * HD + cl) = w; } }
            }
        } else if (pn < 32) {
            const int hp = (pn - 24) * 2, lane = fr + 16 * fq, jq = lane & 3;
#pragma unroll
            for (int ai = 0; ai < 2; ++ai)
#pragma unroll
                for (int m = 0; m < 4; ++m) { const int row = rbase + ai * HALF + m * 16, b = row >> 12, s0 = (row & 4095) & ~3;
#pragma unroll
                    for (int bj = 0; bj < 2; ++bj) { const f32x4 a = acc[ai][bj][m][0], c = acc[ai][bj][m][1];
                        const unsigned w0 = pk_fp8x4(a[0], a[1], a[2], a[3]), w1 = pk_fp8x4(c[0], c[1], c[2], c[3]);
                        unsigned o0 = 0u, o1 = 0u;
#define VQ(q) { const unsigned t0 = (unsigned)__builtin_amdgcn_mov_dpp((int)w0, (q) * 0x55, 0xf, 0xf, true), t1 = (unsigned)__builtin_amdgcn_mov_dpp((int)w1, (q) * 0x55, 0xf, 0xf, true); \
                            o0 |= ((t0 >> (8 * jq)) & 0xffu) << (8 * (q)); o1 |= ((t1 >> (8 * jq)) & 0xffu) << (8 * (q)); }
                        VQ(0) VQ(1) VQ(2) VQ(3)
#undef VQ
                        unsigned char* vp = VT8 + ((size_t)(b * NHEAD + hp + bj) * HD + cl + jq) * SEQ + s0;
                        *(unsigned*)vp = o0; *(unsigned*)(vp + 4 * SEQ) = o1; } }
        } else {
            bf16* dst = (pn < 40) ? SA : SB; const int colt = ((pn - 32) & 7) * BM;
#pragma unroll
            for (int ai = 0; ai < 2; ++ai)
#pragma unroll
                for (int m = 0; m < 4; ++m) { bf16* rp = dst + (size_t)(rbase + ai * HALF + m * 16) * D + colt + cl;
#pragma unroll
                    for (int bj = 0; bj < 2; ++bj) { const f32x4 a = acc[ai][bj][m][0], b = acc[ai][bj][m][1];
                        v4u w; w.x = cvt_pk_bf16(fast_sigmoid(a[0]), fast_sigmoid(a[1])); w.y = cvt_pk_bf16(fast_sigmoid(a[2]), fast_sigmoid(a[3]));
                        w.z = cvt_pk_bf16(fast_sigmoid(b[0]), fast_sigmoid(b[1])); w.w = cvt_pk_bf16(fast_sigmoid(b[2]), fast_sigmoid(b[3]));
                        *(v4u*)(rp + bj * HALF) = w; } }
        }
    }
};
struct EpiGateSeg {
    static constexpr bool PERM = true;
    const bf16* SAg; const bf16* SBg; bf16* T1; unsigned char* Mg; int seg;
    __device__ __forceinline__ void operator()(AccRef acc, const Unit& u, int wr, int wc, int fr, int fq) const {
        const int rbase = u.pm * BM + wr * 64 + fr, col0 = u.pn * BM + wc * 32 + 8 * fq;
        if (seg == 0) {
#pragma unroll
            for (int ai = 0; ai < 2; ++ai) {
                v4u g[4][2];
#pragma unroll
                for (int m = 0; m < 4; ++m)
#pragma unroll
                    for (int bj = 0; bj < 2; ++bj) g[m][bj] = *(const v4u*)(SAg + (size_t)(rbase + ai * HALF + m * 16) * D + col0 + bj * HALF);
#pragma unroll
                for (int m = 0; m < 4; ++m) { const size_t off = (size_t)(rbase + ai * HALF + m * 16) * D + col0;
#pragma unroll
                    for (int bj = 0; bj < 2; ++bj) { const v4u gg = g[m][bj]; const f32x4 a = acc[ai][bj][m][0], b = acc[ai][bj][m][1];
                        v4u w; w.x = cvt_pk_bf16(bflo(gg.x) * a[0], bfhi(gg.x) * a[1]); w.y = cvt_pk_bf16(bflo(gg.y) * a[2], bfhi(gg.y) * a[3]);
                        w.z = cvt_pk_bf16(bflo(gg.z) * b[0], bfhi(gg.z) * b[1]); w.w = cvt_pk_bf16(bflo(gg.w) * b[2], bfhi(gg.w) * b[3]);
                        *(v4u*)(T1 + off + bj * HALF) = w; } }
            }
        } else {
#pragma unroll
            for (int ai = 0; ai < 2; ++ai)
#pragma unroll
                for (int mp = 0; mp < 2; ++mp) {
                    v4u tt[2][2], g[2][2];
#pragma unroll
                    for (int mm = 0; mm < 2; ++mm)
#pragma unroll
                        for (int bj = 0; bj < 2; ++bj) { const size_t off = (size_t)(rbase + ai * HALF + (2 * mp + mm) * 16) * D + col0 + bj * HALF; tt[mm][bj] = *(const v4u*)(T1 + off); g[mm][bj] = *(const v4u*)(SBg + off); }
#pragma unroll
                    for (int mm = 0; mm < 2; ++mm) { const int m = 2 * mp + mm; const size_t off = (size_t)(rbase + ai * HALF + m * 16) * D + col0;
#pragma unroll
                        for (int bj = 0; bj < 2; ++bj) { const v4u t = tt[mm][bj], gg = g[mm][bj]; const f32x4 a = acc[ai][bj][m][0], b = acc[ai][bj][m][1];
                            constexpr float MS = (float)(1 << M8_SHIFT);
                            v2u w; w.x = pk_fp8x4((bflo(t.x) + bflo(gg.x) * a[0]) * MS, (bfhi(t.x) + bfhi(gg.x) * a[1]) * MS, (bflo(t.y) + bflo(gg.y) * a[2]) * MS, (bfhi(t.y) + bfhi(gg.y) * a[3]) * MS);
                            w.y = pk_fp8x4((bflo(t.z) + bflo(gg.z) * b[0]) * MS, (bfhi(t.z) + bfhi(gg.z) * b[1]) * MS, (bflo(t.w) + bflo(gg.w) * b[2]) * MS, (bfhi(t.w) + bfhi(gg.w) * b[3]) * MS);
                            *(v2u*)(Mg + off + bj * HALF) = w; } }
                }
        }
    }
};
struct EpiDelta {
    static constexpr bool PERM = true;
    const float* gm; bf16* Dl;
    __device__ __forceinline__ void operator()(AccRef acc, const Unit& u, int wr, int wc, int fr, int fq) const {
        const int rbase = u.pm * BM + wr * 64 + fr, col0 = u.pn * BM + wc * 32 + 8 * fq, b = (u.pm * BM) >> 12;
        f32x4 gv[2][2];
#pragma unroll
        for (int bj = 0; bj < 2; ++bj)
#pragma unroll
            for (int n = 0; n < 2; ++n) gv[bj][n] = *(const f32x4*)(gm + (size_t)b * 12288 + col0 + bj * HALF + 4 * n);
#pragma unroll
        for (int ai = 0; ai < 2; ++ai)
#pragma unroll
            for (int m = 0; m < 4; ++m) { bf16* rp = Dl + (size_t)(rbase + ai * HALF + m * 16) * D + col0;
#pragma unroll
                for (int bj = 0; bj < 2; ++bj) { const f32x4 a = acc[ai][bj][m][0] * gv[bj][0], c = acc[ai][bj][m][1] * gv[bj][1];
                    v4u w; w.x = cvt_pk_bf16(a[0], a[1]); w.y = cvt_pk_bf16(a[2], a[3]); w.z = cvt_pk_bf16(c[0], c[1]); w.w = cvt_pk_bf16(c[2], c[3]);
                    *(v4u*)(rp + bj * HALF) = w; } }
    }
};
struct MoeSched {
    const LAS int* bstart; const LAS int* cntl; const int* list; int npn, total, G, c, nkt; const char* Bt; size_t estride, tstepB; bool gather;
    __device__ __forceinline__ bool next(int i, Unit& u) const {
        const int L = i * G + c; if (L >= total) return false;
        const int rb = L / npn; int e = 0;
        for (int j = 1; j < NEXP; ++j) e += (bstart[j] <= rb) ? 1 : 0;
        u.pm = rb; u.pn = L - rb * npn; u.ex = e; u.kt0 = 0; u.nkt = nkt; return true;
    }
    __device__ __forceinline__ const char* b_ptr(const Unit& u) const { return Bt + (size_t)u.ex * estride + (size_t)u.pn * tstepB; }
    __device__ __forceinline__ unsigned a_row(const Unit& u, int r) const {
        if (!gather) return (unsigned)(u.pm * BM + r);
        const int pos = (u.pm - bstart[u.ex]) * BM + r;
        return (pos < cntl[u.ex]) ? (unsigned)list[u.ex * LCAP + pos] : 0u;
    }
};
struct EpiSwiGLU {
    static constexpr bool PERM = true;
    unsigned char* HID;
    __device__ __forceinline__ void operator()(AccRef acc, const Unit& u, int wr, int wc, int fr, int fq) const {
        const int rbase = u.pm * BM + wr * 64 + fr, hc0 = u.pn * 128 + wc * 16 + 4 * fq;
#pragma unroll
        for (int ai = 0; ai < 2; ++ai)
#pragma unroll
            for (int m = 0; m < 4; ++m) { unsigned char* rp = HID + (size_t)(rbase + ai * HALF + m * 16) * DFF + hc0;
#pragma unroll
                for (int bj = 0; bj < 2; ++bj) { const f32x4 g = acc[ai][bj][m][0], up = acc[ai][bj][m][1];
                    *(unsigned*)(rp + bj * 64) = pk_fp8x4(g[0] * fast_sigmoid(g[0]) * up[0], g[1] * fast_sigmoid(g[1]) * up[1], g[2] * fast_sigmoid(g[2]) * up[2], g[3] * fast_sigmoid(g[3]) * up[3]); } }
    }
};
constexpr int Y8_SHIFT = 4;
struct EpiStoreF8 {
    static constexpr bool PERM = true;
    unsigned char* Y;
    __device__ __forceinline__ void operator()(AccRef acc, const Unit& u, int wr, int wc, int fr, int fq) const {
        const int rbase = u.pm * BM + wr * 64 + fr, col0 = u.pn * BM + wc * 32 + 8 * fq;
        constexpr float YS = (float)(1 << Y8_SHIFT);
#pragma unroll
        for (int ai = 0; ai < 2; ++ai)
#pragma unroll
            for (int m = 0; m < 4; ++m) { unsigned char* rp = Y + (size_t)(rbase + ai * HALF + m * 16) * D + col0;
#pragma unroll
                for (int bj = 0; bj < 2; ++bj) { const f32x4 a = acc[ai][bj][m][0], b = acc[ai][bj][m][1];
                    v2u w; w.x = pk_fp8x4(a[0] * YS, a[1] * YS, a[2] * YS, a[3] * YS); w.y = pk_fp8x4(b[0] * YS, b[1] * YS, b[2] * YS, b[3] * YS);
                    *(v2u*)(rp + bj * HALF) = w; } }
    }
};
}

namespace att {
constexpr int NW = 8, QBLK = 32, KVBLK = 64, QB = 256, OP = 2048;
constexpr int KPITCH = 144, VPITCH = 144;
constexpr int SHM_K = 2 * KVBLK * KPITCH, SHM_V = HD * VPITCH;
constexpr int LDS_BYTES = 2 * SHM_V + 2 * SHM_K + NW * 64 * 4;
constexpr float SCALE = 0.08838834764831845f, THR = 4.f;
constexpr int O8_SHIFT = 4;
constexpr int KM_SHIFT = 4;
#define SBAR() __builtin_amdgcn_sched_barrier(0)
typedef pg8::v8i v8i; typedef pg8::v4i v4i;
__device__ __forceinline__ v8i cat32(v4i a, v4i b) { return __builtin_shufflevector(a, b, 0, 1, 2, 3, 4, 5, 6, 7); }
__device__ __forceinline__ v4i ld16(const unsigned char* p) { return *reinterpret_cast<const v4i*>(p); }
__device__ __forceinline__ f32x16 mma8(v8i a, v8i b, f32x16 c) { return __builtin_amdgcn_mfma_scale_f32_32x32x64_f8f6f4(a, b, c, 0, 0, 0, 127, 0, 127); }
__device__ __forceinline__ int crow(int r, int hi) { return (r & 3) + 8 * (r >> 2) + 4 * hi; }
__device__ __forceinline__ void mask_tile(f32x16& p0, f32x16& p1, int dq) {
    const float NEG = -__builtin_inff();
#pragma unroll
    for (int r = 0; r < 16; ++r) {
        const int c = (r & 3) + 8 * (r >> 2);
        if (dq - c < 0) p0[r] = NEG;
        if (dq - c - 32 < 0) p1[r] = NEG;
    }
}
__device__ __forceinline__ void partialSM(f32x16& p0, f32x16& p1, float& m_reg, float& mn, float& alpha, bool keep) {
    float pmax = p0[0];
#pragma unroll
    for (int r = 1; r < 16; ++r) pmax = fmaxf(pmax, p0[r]);
#pragma unroll
    for (int r = 0; r < 16; ++r) pmax = fmaxf(pmax, p1[r]);
    { auto rr = __builtin_amdgcn_permlane32_swap(__float_as_uint(pmax), __float_as_uint(pmax), false, false);
      pmax = fmaxf(__uint_as_float(rr[0]), __uint_as_float(rr[1])); }
    const float NEG = -__builtin_inff();
    pmax = keep ? pmax : NEG;
    constexpr float C2 = 1.4426950408889634f * SCALE;
    if (__builtin_expect(__all((pmax - m_reg) * SCALE <= THR), 1)) { mn = m_reg; alpha = 1.f; }
    else { mn = fmaxf(m_reg, pmax); alpha = __builtin_amdgcn_exp2f((m_reg - mn) * C2); m_reg = mn; }
    const float c2l = keep ? C2 : 0.f;
    const float mnL = keep ? -mn * C2 : NEG;
#pragma unroll
    for (int r = 0; r < 16; ++r) p0[r] = fmaf(p0[r], c2l, mnL);
#pragma unroll
    for (int r = 0; r < 16; ++r) p1[r] = fmaf(p1[r], c2l, mnL);
#pragma unroll
    for (int r = 0; r < 16; ++r) p0[r] = __builtin_amdgcn_exp2f(p0[r]);
}
__device__ __forceinline__ void finishSM(f32x16& p0, f32x16& p1, float alpha, float& l_reg, v8i& pf) {
#pragma unroll
    for (int r = 0; r < 16; ++r) p1[r] = __builtin_amdgcn_exp2f(p1[r]);
    float ps = 0;
#pragma unroll
    for (int r = 0; r < 16; ++r) ps += p0[r];
#pragma unroll
    for (int r = 0; r < 16; ++r) ps += p1[r];
    { auto rr = __builtin_amdgcn_permlane32_swap(__float_as_uint(ps), __float_as_uint(ps), false, false);
      ps = __uint_as_float(rr[0]) + __uint_as_float(rr[1]); }
    l_reg = l_reg * alpha + ps;
#pragma unroll
    for (int q = 0; q < 4; ++q) { pf[q] = (int)pk_fp8x4(p0[4 * q], p0[4 * q + 1], p0[4 * q + 2], p0[4 * q + 3]); pf[4 + q] = (int)pk_fp8x4(p1[4 * q], p1[4 * q + 1], p1[4 * q + 2], p1[4 * q + 3]); }
}
template <int SUB>
__device__ __forceinline__ void qkt(int KB, f32x16& p0, f32x16& p1, const unsigned char* K_lds, int r32, int hi, const v8i* qf) {
    p0 = f32x16{}; p1 = f32x16{};
    const unsigned char* kb = K_lds + KB * SHM_K + (SUB * KVBLK + r32) * KPITCH + hi * 32;
#pragma unroll
    for (int ks = 0; ks < 2; ++ks) {
        const v8i a0 = cat32(ld16(kb + ks * 64), ld16(kb + ks * 64 + 16)), a1 = cat32(ld16(kb + 32 * KPITCH + ks * 64), ld16(kb + 32 * KPITCH + ks * 64 + 16));
        p0 = mma8(a0, qf[ks], p0); p1 = mma8(a1, qf[ks], p1); }
}
template <int SUB>
__device__ __forceinline__ void pv_tile(int VB, f32x16* o, const unsigned char* V_lds, int r32, int hi, v8i pf) {
    const unsigned char* vb = V_lds + VB * SHM_V + r32 * VPITCH + SUB * KVBLK + hi * 32;
#pragma unroll
    for (int d0 = 0; d0 < 4; ++d0) { const v8i a = cat32(ld16(vb + d0 * 32 * VPITCH), ld16(vb + d0 * 32 * VPITCH + 16)); o[d0] = mma8(a, pf, o[d0]); }
}
__device__ __forceinline__ unsigned moba_sel(const v8i* qf, const unsigned char* KM, int qb, int r32, int hi) {
    f32x16 g = f32x16{}; const unsigned char* kp = KM + (r32 & 15) * HD + hi * 32;
#pragma unroll
    for (int ks = 0; ks < 2; ++ks) g = mma8(cat32(ld16(kp + ks * 64), ld16(kp + ks * 64 + 16)), qf[ks], g);
    float v[16];
#pragma unroll
    for (int r = 0; r < 8; ++r) { const float mine = g[r], oth = __shfl_xor(mine, 32); const int base = (r & 3) + 8 * (r >> 2);
        v[base] = hi ? oth : mine; v[base + 4] = hi ? mine : oth; }
#pragma unroll
    for (int n = 0; n < 16; ++n) v[n] = (n < qb) ? v[n] : -1e30f;
    unsigned sel = 0u;
#pragma unroll
    for (int pass = 0; pass < 3; ++pass) {
        float best = v[0]; int bi = 0;
#pragma unroll
        for (int n = 1; n < 16; ++n) { const bool gt = v[n] > best; best = gt ? v[n] : best; bi = gt ? n : bi; }
        if (best > -1e29f) sel |= 1u << bi;
#pragma unroll
        for (int n = 0; n < 16; ++n) v[n] = (n == bi) ? -__builtin_inff() : v[n];
    }
    return sel;
}
struct BlockRef { const unsigned char* Q; const unsigned char* K; const unsigned char* V; unsigned char* O; const unsigned char* KM; int qb; };
struct Seam { v8i qf[2]; v4i st_k[2], st_v[2]; };
__device__ __forceinline__ BlockRef make_ref(unsigned char* ws, int vcu, int k) {
    const int x8 = vcu & 7, bh = (k < 2) ? (vcu >> 3) : 32 + (vcu >> 3), qb = (k & 1) ? 15 - x8 : x8, b = bh >> 4, h = bh & 15;
    BlockRef r; r.Q = ws + WS_Q8 + ((size_t)bh * SEQ + (size_t)qb * 256) * HD; r.K = ws + WS_K8 + (size_t)bh * SEQ * HD; r.V = ws + WS_VT8 + (size_t)bh * HD * SEQ;
    r.O = ws + WS_O8 + ((size_t)(b * SEQ + qb * 256)) * OP + h * HD; r.KM = ws + WS_KM + (size_t)bh * 16 * HD; r.qb = qb; return r;
}
#define VMW() asm volatile("s_waitcnt vmcnt(0)" ::: "memory")
#define VMWN(n) asm volatile("s_waitcnt vmcnt(%0)" :: "i"(n) : "memory")
#define SLOAD_H(Kp, Vp, k0) do { const unsigned char* kp_ = (Kp) + (size_t)(k0) * HD + klo; const unsigned char* vp_ = (Vp) + (size_t)(k0) + vlo; \
        S.st_k[0] = ld16(kp_); S.st_k[1] = ld16(kp_ + KVBLK * HD); S.st_v[0] = ld16(vp_); S.st_v[1] = ld16(vp_ + KVBLK); } while (0)
#define SWRITE_HK(bf) do { *(v4i*)(K_lds + (bf) * SHM_K + kws) = S.st_k[0]; *(v4i*)(K_lds + (bf) * SHM_K + kws + KVBLK * KPITCH) = S.st_k[1]; } while (0)
#define SWRITE_HV(bf) do { _Pragma("unroll") for (int i_ = 0; i_ < 2; ++i_) { unsigned char* vd_ = V_lds + (bf) * SHM_V + vws + i_ * KVBLK; \
        *(int*)(vd_) = S.st_v[i_][0]; *(int*)(vd_ + 32) = S.st_v[i_][1]; *(int*)(vd_ + 4) = S.st_v[i_][2]; *(int*)(vd_ + 36) = S.st_v[i_][3]; } } while (0)
#define SWRITE_H(bf) do { SWRITE_HV(bf); SWRITE_HK(bf); } while (0)
#define QLOAD(Qp) do { const unsigned char* qp_ = (Qp) + qoff; S.qf[0] = cat32(ld16(qp_), ld16(qp_ + 16)); S.qf[1] = cat32(ld16(qp_ + 64), ld16(qp_ + 80)); } while (0)
#define ATT_GEOM() const int wid = __builtin_amdgcn_readfirstlane(tid >> 6), lane = tid & 63, r32 = lane & 31, hi = lane >> 5; \
    const unsigned klo = (unsigned)((tid >> 3) * HD + (tid & 7) * 16), kws = (unsigned)((tid >> 3) * KPITCH + (tid & 7) * 16); \
    const unsigned vlo = (unsigned)((tid >> 2) * SEQ + (tid & 3) * 16), vws = (unsigned)((tid >> 2) * VPITCH + (tid & 3) * 8); \
    const unsigned qoff = (unsigned)((wid * QBLK + r32) * HD + hi * 32); \
    unsigned char* V_lds = (unsigned char*)lds; unsigned char* K_lds = (unsigned char*)lds + 2 * SHM_V
__device__ __forceinline__ void moba_prime(const BlockRef& cur, char* lds, Seam& S, const int tid) {
    ATT_GEOM(); (void)V_lds; (void)vws;
    QLOAD(cur.Q);
    SLOAD_H(cur.K, cur.V, 0); VMW(); SWRITE_HK(0);
    __syncthreads();
}
__device__ __forceinline__ void moba_block(const BlockRef& cur, const BlockRef& nxt, char* lds, Seam& S, const int tid) {
    ATT_GEOM();
    const int qb = cur.qb, NS = 2 * (qb + 1);
    const int qlo = qb * QB + wid * QBLK;
    unsigned* sel_l = (unsigned*)(lds + 2 * SHM_V + 2 * SHM_K) + wid * 64;
    { const unsigned sel0 = (qb > 0) ? moba_sel(S.qf, cur.KM, qb, r32, hi) : 0u; if (hi == 0) sel_l[r32] = sel0; }
    float m_reg = -1e30f, l_reg = 0; f32x16 o[4] = {};
    const unsigned char* Kh = cur.K; const unsigned char* Vh = cur.V;
#define RESC(a) do { if (__any((a) < 1.f)) { for (int d_ = 0; d_ < 4; ++d_) for (int r = 0; r < 16; ++r) o[d_][r] *= (a); } } while (0)
#define KBASE(t) ((t) * KVBLK)
#define KEEP(t) ((((t) >> 2) >= qb) || (((sel_l[r32] >> ((t) >> 2)) & 1u) != 0u))
#define MASKT(P0_, P1_, t) do { const int kb_ = KBASE(t); if (kb_ + KVBLK - 1 > qlo) mask_tile(P0_, P1_, qlo - kb_ + r32 - 4 * hi); } while (0)
    f32x16 pA0, pA1, pB0, pB1; float mnA, mnB, alA, alB; v8i pf;
#define STEP_A(T_, B_, LOADNEXT) do { SBAR(); qkt<0>(B_, pA0, pA1, K_lds, r32, hi, S.qf); finishSM(pB0, pB1, alB, l_reg, pf); SBAR(); \
        if (LOADNEXT) { SLOAD_H(Kh, Vh, KBASE(2 * (T_) + 2)); SBAR(); } \
        pv_tile<1>(1 - (B_), o, V_lds, r32, hi, pf); MASKT(pA0, pA1, 2 * (T_)); partialSM(pA0, pA1, m_reg, mnA, alA, KEEP(2 * (T_))); RESC(alA); } while (0)
#define STEP_B(T_, B_, WRITENEXT) do { SBAR(); qkt<1>(B_, pB0, pB1, K_lds, r32, hi, S.qf); finishSM(pA0, pA1, alA, l_reg, pf); SBAR(); \
        pv_tile<0>(B_, o, V_lds, r32, hi, pf); MASKT(pB0, pB1, 2 * (T_) + 1); partialSM(pB0, pB1, m_reg, mnB, alB, KEEP(2 * (T_) + 1)); \
        if (WRITENEXT) { __syncthreads(); VMW(); SWRITE_H(1 - (B_)); RESC(alB); __syncthreads(); } else { RESC(alB); } } while (0)
    SWRITE_HV(0); SBAR();
    SLOAD_H(Kh, Vh, KBASE(2));
    SBAR(); qkt<0>(0, pA0, pA1, K_lds, r32, hi, S.qf);
    MASKT(pA0, pA1, 0); partialSM(pA0, pA1, m_reg, mnA, alA, KEEP(0));
    __syncthreads();
    STEP_B(0, 0, true);
    for (int T_ = 1; T_ + 1 < NS; ++T_) { const int bsel = T_ & 1; STEP_A(T_, bsel, true); STEP_B(T_, bsel, true); }
    STEP_A(NS - 1, 1, false);
    SBAR(); qkt<1>(1, pB0, pB1, K_lds, r32, hi, S.qf); SBAR();
    SLOAD_H(nxt.K, nxt.V, 0); SBAR();
    QLOAD(nxt.Q);
    SBAR();
    finishSM(pA0, pA1, alA, l_reg, pf); SBAR();
    pv_tile<0>(1, o, V_lds, r32, hi, pf);
    MASKT(pB0, pB1, 2 * NS - 1); partialSM(pB0, pB1, m_reg, mnB, alB, true); RESC(alB);
    finishSM(pB0, pB1, alB, l_reg, pf); SBAR(); pv_tile<1>(1, o, V_lds, r32, hi, pf);
    SBAR(); VMWN(4); SWRITE_HK(0); SBAR();
    { const float rl = __builtin_amdgcn_rcpf(l_reg) * (float)(1 << O8_SHIFT);
      int r32e = r32, hie = hi; asm volatile("" : "+v"(r32e), "+v"(hie));
      unsigned char* Ow = cur.O + (size_t)(wid * QBLK + r32e) * OP + 4 * hie;
#pragma unroll
      for (int d0 = 0; d0 < 4; ++d0)
#pragma unroll
          for (int g4 = 0; g4 < 4; ++g4) *(unsigned*)(Ow + d0 * 32 + 8 * g4) = pk_fp8x4(o[d0][4 * g4] * rl, o[d0][4 * g4 + 1] * rl, o[d0][4 * g4 + 2] * rl, o[d0][4 * g4 + 3] * rl); }
    __syncthreads();
#undef RESC
#undef KBASE
#undef KEEP
#undef MASKT
#undef STEP_A
#undef STEP_B
}
#undef VMW
#undef VMWN
#undef SLOAD_H
#undef SWRITE_HK
#undef SWRITE_HV
#undef SWRITE_H
#undef QLOAD
#undef ATT_GEOM
}

struct Args { const float* in[23]; float* out; unsigned char* ws; };
typedef const __attribute__((address_space(4))) Args* ArgsP;
__device__ __forceinline__ int ltid(int wave0) { int l; asm volatile("v_mbcnt_lo_u32_b32 %0, -1, 0\n\tv_mbcnt_hi_u32_b32 %0, -1, %0" : "=v"(l)); return (wave0 << 6) | l; }
__device__ __forceinline__ ArgsP kargs() { ArgsP p = (ArgsP)__builtin_amdgcn_kernarg_segment_ptr(); asm volatile("" : "+s"(p)); return p; }
#define WSP(T_, off) ((T_*)(ws + (off)))

struct ConvUnit { const float* W; void* WT; int ldw, ldt, k0, n0, kind, add; };
__device__ __forceinline__ int conv_row(const ConvUnit& c, int n) {
    if (c.kind == 2) { if (n >= 6144) return n - 2048; const int p = n & 127; return (n & ~127) + 2 * (p & 63) + (p >> 6) - 2048; }
    if (c.kind == 3) return (n >> 2) * 8 + (n & 3) + c.add;
    return n;
}
constexpr int CBUF = 65536, OP8 = 144, OP16 = 272;
__device__ __forceinline__ void conv_dma(const ConvUnit& c, int wave, int lane, LAS unsigned char* buf) {
    const float* Wl = c.W + (size_t)(c.k0 + 16 * wave + (lane >> 5)) * c.ldw + c.n0 + 4 * (lane & 31);
#pragma unroll
    for (int i = 0; i < 8; ++i) __builtin_amdgcn_global_load_lds((const unsigned*)(Wl + (size_t)(2 * i) * c.ldw), (LAS unsigned*)(buf + (16 * wave + 2 * i) * 512), 16, 0, 0);
}
__device__ __forceinline__ void conv_read(int wave, int lane, const LAS unsigned char* buf, float (&f)[32]) {
    const LAS float* p = (const LAS float*)(buf + (16 * wave) * 512 + 4 * lane);
#pragma unroll
    for (int i = 0; i < 16; ++i) { f[i] = p[i * 128]; f[16 + i] = p[i * 128 + 64]; }
}
__device__ __forceinline__ void conv_park8(int wave, int lane, LAS unsigned char* img, const float (&f)[32]) {
    constexpr float SC = (float)(1 << pg8::W8_SHIFT);
#pragma unroll
    for (int h = 0; h < 2; ++h) { v4u o; o.x = pk_fp8x4(f[16 * h] * SC, f[16 * h + 1] * SC, f[16 * h + 2] * SC, f[16 * h + 3] * SC); o.y = pk_fp8x4(f[16 * h + 4] * SC, f[16 * h + 5] * SC, f[16 * h + 6] * SC, f[16 * h + 7] * SC);
        o.z = pk_fp8x4(f[16 * h + 8] * SC, f[16 * h + 9] * SC, f[16 * h + 10] * SC, f[16 * h + 11] * SC); o.w = pk_fp8x4(f[16 * h + 12] * SC, f[16 * h + 13] * SC, f[16 * h + 14] * SC, f[16 * h + 15] * SC);
        *(LAS v4u*)(img + (lane + 64 * h) * OP8 + 16 * wave) = o; }
}
__device__ __forceinline__ void conv_out8(const ConvUnit& c, int tid, const LAS unsigned char* img) {
#pragma unroll
    for (int j = 0; j < 2; ++j) { const int row = (tid >> 3) + 64 * j, ch = tid & 7; const v4u v = *(const LAS v4u*)(img + row * OP8 + 16 * ch);
        *(v4u*)((unsigned char*)c.WT + (size_t)conv_row(c, c.n0 + row) * c.ldt + c.k0 + 16 * ch) = v; }
}
__device__ __forceinline__ void conv_park16(int wave, int lane, LAS unsigned char* img, const float (&f)[32], const int h) {
    v4u o0, o1; o0.x = pk2(f[16 * h], f[16 * h + 1]); o0.y = pk2(f[16 * h + 2], f[16 * h + 3]); o0.z = pk2(f[16 * h + 4], f[16 * h + 5]); o0.w = pk2(f[16 * h + 6], f[16 * h + 7]);
    o1.x = pk2(f[16 * h + 8], f[16 * h + 9]); o1.y = pk2(f[16 * h + 10], f[16 * h + 11]); o1.z = pk2(f[16 * h + 12], f[16 * h + 13]); o1.w = pk2(f[16 * h + 14], f[16 * h + 15]);
    LAS unsigned char* q = img + lane * OP16 + 32 * wave; *(LAS v4u*)q = o0; *(LAS v4u*)(q + 16) = o1;
}
__device__ __forceinline__ void conv_out16(const ConvUnit& c, int tid, const LAS unsigned char* img, const int h) {
#pragma unroll
    for (int j = 0; j < 2; ++j) { const int row = (tid >> 4) + 32 * j, ch = tid & 15; const v4u v = *(const LAS v4u*)(img + row * OP16 + 16 * ch);
        *(v4u*)((bf16*)c.WT + (size_t)conv_row(c, c.n0 + 64 * h + row) * c.ldt + c.k0 + 8 * ch) = v; }
}
constexpr int NCONV = 8320;
__device__ __forceinline__ ConvUnit conv_decode(int u, ArgsP A, unsigned char* ws) {
    ConvUnit c; c.add = 0;
    if (u < 1536) { const int kp = u / 96, g = u - kp * 96; c.W = A->in[6]; c.ldw = INC; c.k0 = kp * 128; c.n0 = g * 128; c.ldt = D;
        if (g < 16) { c.WT = ws + WS_WINZ; c.kind = 0; } else { c.WT = ws + WS_WIN8; c.kind = 2; } return c; }
    u -= 1536;
    if (u < 128) { c.W = A->in[11]; c.ldw = D; c.k0 = (u >> 4) * 128; c.n0 = (u & 15) * 128; c.WT = ws + WS_WSO; c.ldt = SGW; c.kind = 0; return c; }
    u -= 128;
    if (u < 256) { c.W = A->in[12]; c.ldw = D; c.k0 = (u >> 4) * 128; c.n0 = (u & 15) * 128; c.WT = ws + WS_WMO8; c.ldt = D; c.kind = 1; return c; }
    u -= 256;
    if (u < 256) { c.W = A->in[13]; c.ldw = D; c.k0 = (u >> 4) * 128; c.n0 = (u & 15) * 128; c.WT = ws + WS_WOUT; c.ldt = D; c.kind = 1; return c; }
    u -= 256;
    const int m = u >> 11, r = u & 2047, e = r >> 6, q = r & 63;
    if (m < 2) { c.W = A->in[19 + m] + (size_t)e * D * DFF; c.ldw = DFF; c.k0 = (q >> 2) * 128; c.n0 = (q & 3) * 128; c.WT = ws + WS_WGU8 + (size_t)e * 1024 * D; c.ldt = D; c.kind = 3; c.add = 4 * m; return c; }
    c.W = A->in[21] + (size_t)e * DFF * D; c.ldw = D; c.k0 = (q >> 4) * 128; c.n0 = (q & 15) * 128; c.WT = ws + WS_WD8 + (size_t)e * D * DFF; c.ldt = DFF; c.kind = 1; return c;
}
constexpr int NCONV_EARLY = 1536;
__device__ __forceinline__ void conv_run(LAS unsigned char* lds, const int tid, const int wave, const int lane, int u, const int uend) {
    float f[32];
    LAS unsigned char* b0 = lds; LAS unsigned char* b1 = lds + CBUF; LAS unsigned char* img = lds + TAB_OFF;
#define CONV_CLAMP(x) ((x) < uend ? (x) : uend - 1)
#define CONV_BAR() do { asm volatile("s_waitcnt lgkmcnt(0)" ::: "memory"); __builtin_amdgcn_s_barrier(); asm volatile("" ::: "memory"); } while (0)
#define CONV_STEP(N, buf) do { \
        asm volatile("s_waitcnt vmcnt(" #N ")" ::: "memory"); __builtin_amdgcn_s_barrier(); asm volatile("" ::: "memory"); \
        conv_read(wave, lane, buf, f); CONV_BAR(); \
        { ArgsP Ai = kargs(); const ConvUnit cn = conv_decode(CONV_CLAMP(u + 512), Ai, Ai->ws); conv_dma(cn, wave, lane, buf); } \
        { ArgsP Ai = kargs(); const ConvUnit c = conv_decode(u, Ai, Ai->ws); \
          if (c.kind != 0) { conv_park8(wave, lane, img, f); CONV_BAR(); conv_out8(c, tid, img); } \
          else { conv_park16(wave, lane, img, f, 0); CONV_BAR(); conv_out16(c, tid, img, 0); CONV_BAR(); conv_park16(wave, lane, img, f, 1); CONV_BAR(); conv_out16(c, tid, img, 1); } } \
        u += 256; } while (0)
    { ArgsP Ai = kargs(); const ConvUnit c = conv_decode(u, Ai, Ai->ws); conv_dma(c, wave, lane, b0); }
    { ArgsP Ai = kargs(); const ConvUnit c = conv_decode(CONV_CLAMP(u + 256), Ai, Ai->ws); conv_dma(c, wave, lane, b1); }
    CONV_STEP(8, b0);
    if (u < uend) { CONV_STEP(10, b1);
        for (;;) {
            if (u >= uend) break; CONV_STEP(12, b0);
            if (u >= uend) break; CONV_STEP(12, b1);
        } }
    asm volatile("s_waitcnt vmcnt(0)" ::: "memory");
    __builtin_amdgcn_s_barrier();
#undef CONV_STEP
#undef CONV_BAR
#undef CONV_CLAMP
}

__global__ void __launch_bounds__(NWAVES * 64, 2) fwd_kernel(Args args) {
    extern __shared__ __attribute__((aligned(16))) unsigned char lds_raw[];
    LAS unsigned char* lds = (LAS unsigned char*)lds_raw;
    const int wave0 = __builtin_amdgcn_readfirstlane((int)threadIdx.x >> 6);
    constexpr int G = 256;
#define BX ((int)blockIdx.x)
#define VCU (((int)blockIdx.x & 7) * 32 + ((int)blockIdx.x >> 3))
    volatile LAS unsigned* MISC = (volatile LAS unsigned*)(lds + MISC_OFF);
    for (int u = ltid(wave0); u < (LDS_BYTES - LDSCTL_OFF) / 4; u += NWAVES * 64) ((LAS unsigned*)(lds + LDSCTL_OFF))[u] = 0u;
    __syncthreads();
    (void)xcd_barrier_post((unsigned*)(args.ws + WS_CTL) + CW_BAR, MISC + 8, ltid(wave0));
#define GRID_BAR() do { XcdBarrier b_; b_.bar = (unsigned*)(kargs()->ws + WS_CTL) + CW_BAR; b_.x = xb_xcc_id(); b_.st = (volatile LAS unsigned*)(lds + MISC_OFF) + 8; xcd_barrier(b_, ltid(wave0)); } while (0)

    DUPLOOP(0) {
    {
        ArgsP A = kargs(); unsigned char* ws = A->ws; const int tid = ltid(wave0), lane = tid & 63, wave = __builtin_amdgcn_readfirstlane(tid >> 6); (void)lane; (void)wave; gu32* ctl = (gu32*)(ws + WS_CTL);
        const float* cin = A->in[1];
        LAS float* cact = (LAS float*)(lds + 98304);
        for (int i = tid; i < BATCH * D; i += NWAVES * 64) { const float v = cin[i]; cact[i] = v / (1.0f + __expf(-v)); }
        __syncthreads();
        { const int it = (wave < 6) ? VCU * 6 + wave : 1536 + VCU * 2 + (wave - 6); ArgsP Ai = kargs(); unsigned char* wsi = Ai->ws;
            if (it < 1536) {
                const int qd = it / 384, col = (it - qd * 384) * 32 + 4 * (lane & 7), rq = lane >> 3;
                f32x4 a0 = {0.f, 0.f, 0.f, 0.f}, a1 = a0, a2 = a0, a3 = a0;
                for (int k0 = qd * 512; k0 < qd * 512 + 512; k0 += 256) {
                    f32x4 w[32];
#pragma unroll
                    for (int i = 0; i < 32; ++i) w[i] = *(const f32x4*)(Ai->in[3] + (size_t)(k0 + rq + 8 * i) * 12288 + col);
#pragma unroll
                    for (int i = 0; i < 32; ++i) { const int k = k0 + rq + 8 * i;
                        a0 += cact[k] * w[i]; a1 += cact[D + k] * w[i]; a2 += cact[2 * D + k] * w[i]; a3 += cact[3 * D + k] * w[i]; }
                }
#pragma unroll
                for (int e = 0; e < 4; ++e)
#pragma unroll
                    for (int o = 8; o < 64; o <<= 1) { a0[e] += __shfl_xor(a0[e], o); a1[e] += __shfl_xor(a1[e], o); a2[e] += __shfl_xor(a2[e], o); a3[e] += __shfl_xor(a3[e], o); }
                if (rq == 0) { const f32x4 bb = (qd == 0) ? *(const f32x4*)(Ai->in[4] + col) : (f32x4){0.f, 0.f, 0.f, 0.f}; float* ap = ((float*)(wsi + WS_ADAP)) + (size_t)qd * 49152 + col;
                    *(f32x4*)(ap) = a0 + bb; *(f32x4*)(ap + 12288) = a1 + bb; *(f32x4*)(ap + 2 * 12288) = a2 + bb; *(f32x4*)(ap + 3 * 12288) = a3 + bb; }
            } else if (it < 1792) {
                const int tok = (it - 1536) * 64 + lane; const double pos = (double)((const int*)Ai->in[2])[tok];
                float* cosT = (float*)(wsi + WS_COS); float* sinT = (float*)(wsi + WS_SIN);
                double inv = 1.0;
                for (int j = 0; j < 64; ++j) {
                    const double rev = pos * inv * 0.15915494309189535;
                    const float fr = (float)(rev - __builtin_floor(rev));
                    cosT[(size_t)tok * 64 + j] = __builtin_amdgcn_cosf(fr); sinT[(size_t)tok * 64 + j] = __builtin_amdgcn_sinf(fr);
                    inv *= 0.8659643233600653;
                }
            } else if (it < 1824) {
                const int g = (it - 1792) >> 2, part = (it - 1792) & 3; bf16* WSb = (bf16*)(wsi + WS_WS);
                for (int i = part * 4096 + lane; i < part * 4096 + 4096; i += 64) { const int r = i >> 7, c = i & 127; WSb[g * 16384 + i] = (c <= r) ? (bf16)f2bf(Ai->in[9][g * 16384 + i]) : (bf16)0; }
            } else if (it < 2016) {
                const int q = it - 1824, u = q & 7, n0 = (q >> 3) * 2; bf16* RT = (bf16*)(wsi + WS_RT);
#pragma unroll
                for (int nn = 0; nn < 2; ++nn) { const int n = n0 + nn;
#pragma unroll
                    for (int i = 0; i < 4; ++i) { const int k = u * 256 + lane + 64 * i; const float w = (n < 4) ? Ai->in[15][k * 4 + n] : (n < 36) ? Ai->in[17][k * 32 + (n - 4)] : 0.f;
                        const unsigned hi = f2bf(w); const int ks = k >> 5, kk = k & 31; RT[((ks * 2) * 48 + n) * 32 + kk] = (bf16)hi; RT[((ks * 2 + 1) * 48 + n) * 32 + kk] = (bf16)f2bf(w - __builtin_bit_cast(float, hi << 16)); } }
            }
        }
        __syncthreads();
        conv_run(lds, tid, wave, lane, VCU, NCONV_EARLY);
    }
    GRID_BAR();
    }

    DUPLOOP(1) {
    {
        ArgsP A = kargs(); unsigned char* ws = A->ws; const int tid = ltid(wave0), lane = tid & 63, wave = __builtin_amdgcn_readfirstlane(tid >> 6); (void)lane; (void)wave;
        const float* x = A->in[0]; const float* g_mix = A->in[5]; const float* adap = WSP(float, WS_ADAP); float* adaf = WSP(float, WS_ADA); bf16* Nb = WSP(bf16, WS_N); unsigned char* N8 = ws + WS_N1F8;
        LAS float* tg = (LAS float*)(lds); LAS float* tb = (LAS float*)(lds + 8192);
        const int row0 = VCU * 64, b = row0 >> 12;
        for (int i = tid; i < D; i += NWAVES * 64) { const float* ap = adap + b * 12288 + i;
            tg[i] = g_mix[i] * (1.0f + ((ap[2048] + ap[49152 + 2048]) + (ap[2 * 49152 + 2048] + ap[3 * 49152 + 2048]))); tb[i] = (ap[0] + ap[49152]) + (ap[2 * 49152] + ap[3 * 49152]); }
        if (tid < 192) { const int i = VCU * 192 + tid; adaf[i] = (adap[i] + adap[49152 + i]) + (adap[2 * 49152 + i] + adap[3 * 49152 + i]); }
        __syncthreads();
        for (int rq = 0; rq < 2; ++rq) {
            f32x4 v[4][8];
#pragma unroll
            for (int q = 0; q < 4; ++q) { const f32x4* xr = (const f32x4*)(x + (size_t)(row0 + wave * 8 + rq * 4 + q) * D) + lane;
#pragma unroll
                for (int j = 0; j < 8; ++j) v[q][j] = xr[64 * j]; }
#pragma unroll
            for (int q = 0; q < 4; ++q) { const int row = row0 + wave * 8 + rq * 4 + q; float ss = 0.f;
#pragma unroll
                for (int j = 0; j < 8; ++j) ss += (v[q][j].x * v[q][j].x + v[q][j].y * v[q][j].y) + (v[q][j].z * v[q][j].z + v[q][j].w * v[q][j].w);
                const float rstd = rsqrtf(wave_sum(ss) * (1.f / D) + EPS);
                v2u* o8 = (v2u*)(Nb + (size_t)row * D) + lane;
#pragma unroll
                for (int j = 0; j < 8; ++j) { const f32x4 gg = *(const LAS f32x4*)(tg + 4 * lane + 256 * j), bb = *(const LAS f32x4*)(tb + 4 * lane + 256 * j);
                    const f32x4 y = v[q][j] * rstd * gg + bb; v2u w; w.x = cvt_pk_bf16(y.x, y.y); w.y = cvt_pk_bf16(y.z, y.w); o8[64 * j] = w;
                    *((unsigned*)(N8 + (size_t)row * D) + lane + 64 * j) = pk_fp8x4(y.x, y.y, y.z, y.w); } }
        }
    }
    GRID_BAR();
    }

    DUPLOOP(2) {
    {
        ArgsP A = kargs(); unsigned char* ws = A->ws; const int tid = ltid(wave0), lane = tid & 63, wave = __builtin_amdgcn_readfirstlane(tid >> 6); (void)lane; (void)wave;
        bf16* Nb = WSP(bf16, WS_N); bf16* UV = WSP(bf16, WS_UV); unsigned char* Qh = ws + WS_Q8; unsigned char* Kh = ws + WS_K8; unsigned char* Vh = ws + WS_VT8;
        bf16* SAg = WSP(bf16, WS_SA); bf16* SBg = WSP(bf16, WS_SB); const float* cosT = WSP(float, WS_COS); const float* sinT = WSP(float, WS_SIN);
        { pg8::StaticOrder S; S.init(T, 2048, D * 2, G, BX, ws + WS_WINZ);
          pg8::EpiInProj E{UV, Qh, Kh, Vh, SAg, SBg, cosT, sinT, 0};
          pg8::gemm_phase<false>(lds, (const char*)Nb, D * 2, S, E, tid); }
        { pg8::StaticOrder S; S.init(T, 10240, D, G, BX, ws + WS_WIN8);
          pg8::EpiInProj E{UV, Qh, Kh, Vh, SAg, SBg, cosT, sinT, 8};
          pg8::gemm_phase<true>(lds, (const char*)(ws + WS_N1F8), D, S, E, tid); }
    }
    GRID_BAR();
    }

    DUPLOOP(3) {
    {
        ArgsP A = kargs(); unsigned char* ws = A->ws; const int tid = ltid(wave0), lane = tid & 63, wave = __builtin_amdgcn_readfirstlane(tid >> 6); (void)lane; (void)wave;
        const float* sgu_ln_g = A->in[7]; const float* sgu_ln_b = A->in[8]; const float* sgu_b_s = A->in[10];
        const bf16* UV = WSP(bf16, WS_UV); const bf16* WSb = WSP(bf16, WS_WS); bf16* SGUO = WSP(bf16, WS_SGUO); const unsigned char* K8 = ws + WS_K8; unsigned char* KM = ws + WS_KM;
        constexpr int VP = 136;
        LAS bf16* vT = (LAS bf16*)lds; LAS f32x2* st = (LAS f32x2*)(lds + 2 * 128 * VP * 2); LAS float* kx = (LAS float*)(lds + 73728);
        { const int item = VCU * NWAVES + wave, blk = item >> 1, half = item & 1, c8 = (lane & 15) * 8, r0 = lane >> 4;
          const unsigned char* kp = K8 + ((size_t)blk * 256 + half * 128 + r0) * HD + c8;
          float sacc[8] = {0.f, 0.f, 0.f, 0.f, 0.f, 0.f, 0.f, 0.f};
          { v2u w[32];
#pragma unroll
              for (int u = 0; u < 32; ++u) w[u] = *(const v2u*)(kp + (size_t)(4 * u) * HD);
#pragma unroll
              for (int u = 0; u < 32; ++u) { const f32x2 a0 = __builtin_amdgcn_cvt_pk_f32_fp8((int)w[u].x, false), a1 = __builtin_amdgcn_cvt_pk_f32_fp8((int)w[u].x, true), a2 = __builtin_amdgcn_cvt_pk_f32_fp8((int)w[u].y, false), a3 = __builtin_amdgcn_cvt_pk_f32_fp8((int)w[u].y, true);
                  sacc[0] += a0.x; sacc[1] += a0.y; sacc[2] += a1.x; sacc[3] += a1.y; sacc[4] += a2.x; sacc[5] += a2.y; sacc[6] += a3.x; sacc[7] += a3.y; } }
#pragma unroll
          for (int e = 0; e < 8; ++e) { sacc[e] += __shfl_xor(sacc[e], 16); sacc[e] += __shfl_xor(sacc[e], 32); }
          LAS float* kxp = kx + (wave >> 1) * 128 + c8;
          if (half == 1 && lane < 16) {
#pragma unroll
              for (int e = 0; e < 8; ++e) kxp[e] = sacc[e]; }
          __syncthreads();
          if (half == 0 && lane < 16) {
#pragma unroll
              for (int e = 0; e < 8; ++e) sacc[e] = (sacc[e] + kxp[e]) * ((float)(1 << att::KM_SHIFT) / 256.f);
              v2u o; o.x = pk_fp8x4(sacc[0], sacc[1], sacc[2], sacc[3]); o.y = pk_fp8x4(sacc[4], sacc[5], sacc[6], sacc[7]);
              *(v2u*)(KM + (size_t)blk * HD + c8) = o; } }
        {
            const int ch = VCU >> 1, hf = VCU & 1, R0 = ch * 128;
            LAS float* lng = (LAS float*)(lds + 81920); LAS float* lnb = lng + 512;
            lng[tid] = sgu_ln_g[hf * 512 + tid]; lnb[tid] = sgu_ln_b[hf * 512 + tid];
            v4u aa[4][8];
#pragma unroll
            for (int it4 = 0; it4 < 4; ++it4) { const v4u* vp = (const v4u*)(UV + (size_t)(R0 + wave * 16 + it4 * 4 + (lane >> 4)) * D + SGW) + (lane & 15);
#pragma unroll
                for (int q = 0; q < 8; ++q) aa[it4][q] = vp[16 * q]; }
#pragma unroll
            for (int it4 = 0; it4 < 4; ++it4) { const int j = wave * 16 + it4 * 4 + (lane >> 4);
                const v4u (&a)[8] = aa[it4];
                float s = 0.f;
#pragma unroll
                for (int q = 0; q < 8; ++q) s += ((bflo(a[q].x) + bfhi(a[q].x)) + (bflo(a[q].y) + bfhi(a[q].y))) + ((bflo(a[q].z) + bfhi(a[q].z)) + (bflo(a[q].w) + bfhi(a[q].w)));
#pragma unroll
                for (int o = 1; o < 16; o <<= 1) s += __shfl_xor(s, o);
                const float mean = s * (1.f / SGW); float qv = 0.f;
#pragma unroll
                for (int q = 0; q < 8; ++q) { float d;
                    d = bflo(a[q].x) - mean; qv += d * d; d = bfhi(a[q].x) - mean; qv += d * d; d = bflo(a[q].y) - mean; qv += d * d; d = bfhi(a[q].y) - mean; qv += d * d;
                    d = bflo(a[q].z) - mean; qv += d * d; d = bfhi(a[q].z) - mean; qv += d * d; d = bflo(a[q].w) - mean; qv += d * d; d = bfhi(a[q].w) - mean; qv += d * d; }
#pragma unroll
                for (int o = 1; o < 16; o <<= 1) qv += __shfl_xor(qv, o);
                if ((lane & 15) == 0) st[j] = (f32x2){mean, rsqrtf(qv * (1.f / SGW) + EPS)};
            }
            __syncthreads();
            for (int ps = 0; ps < 2; ++ps) {
                const int gp = hf * 2 + ps;
                { const int j = lane + 64 * (wave & 1), cb = 64 * (wave >> 1); const f32x2 ms = st[j];
                  v4u a[8];
#pragma unroll
                  for (int cq = 0; cq < 8; ++cq) a[cq] = *(const v4u*)(UV + (size_t)(R0 + j) * D + SGW + gp * 256 + cb + 8 * cq);
#pragma unroll
                  for (int cq = 0; cq < 8; ++cq) { const int c0 = cb + 8 * cq, chn = gp * 256 + c0;
                      const int cl_ = chn - hf * 512; const f32x4 g0 = *(const LAS f32x4*)(lng + cl_), g1 = *(const LAS f32x4*)(lng + cl_ + 4), b0 = *(const LAS f32x4*)(lnb + cl_), b1 = *(const LAS f32x4*)(lnb + cl_ + 4);
                      const float e[8] = {bflo(a[cq].x), bfhi(a[cq].x), bflo(a[cq].y), bfhi(a[cq].y), bflo(a[cq].z), bfhi(a[cq].z), bflo(a[cq].w), bfhi(a[cq].w)};
                      const float gg[8] = {g0[0], g0[1], g0[2], g0[3], g1[0], g1[1], g1[2], g1[3]}, bb[8] = {b0[0], b0[1], b0[2], b0[3], b1[0], b1[1], b1[2], b1[3]};
#pragma unroll
                      for (int i = 0; i < 8; ++i) vT[(c0 + i) * VP + j] = (bf16)f2bf((e[i] - ms.x) * ms.y * gg[i] + bb[i]); } }
                __syncthreads();
                { const int g = wave >> 2, ib = wave & 3, gg = gp * 2 + g, r32 = lane & 31, hi = lane >> 5; const int nks = 2 * (ib + 1);
                  const bf16* Wg = WSb + (size_t)gg * 16384 + (size_t)(ib * 32 + r32) * 128 + hi * 8;
                  f32x16 acc[4] = {};
                  const int tokr = R0 + ib * 32 + r32;
                  bf16x8 bwv[8]; v2u uu[4][4];
#pragma unroll
                  for (int ks = 0; ks < 8; ++ks) bwv[ks] = *(const bf16x8*)(Wg + (ks < nks ? ks : 0) * 16);
#pragma unroll
                  for (int db = 0; db < 4; ++db)
#pragma unroll
                      for (int q4 = 0; q4 < 4; ++q4) uu[db][q4] = *(const v2u*)(UV + (size_t)tokr * D + gg * 128 + db * 32 + 8 * q4 + 4 * hi);
                  __builtin_amdgcn_sched_barrier(0);
#pragma unroll
                  for (int ks = 0; ks < 8; ++ks) { if (ks >= nks) break;
                      const bf16x8 bw = bwv[ks];
#pragma unroll
                      for (int db = 0; db < 4; ++db) { const bf16x8 av = *(const LAS bf16x8*)(vT + (size_t)(g * 128 + db * 32 + r32) * VP + ks * 16 + hi * 8);
                          acc[db] = __builtin_amdgcn_mfma_f32_32x32x16_bf16(av, bw, acc[db], 0, 0, 0); }
                  }
                  const float bs = sgu_b_s[gg * 128 + ib * 32 + r32];
#pragma unroll
                  for (int db = 0; db < 4; ++db)
#pragma unroll
                      for (int q4 = 0; q4 < 4; ++q4) { const int d = db * 32 + 8 * q4 + 4 * hi;
                          const v2u u2 = uu[db][q4];
                          v2u w; w.x = cvt_pk_bf16(bflo(u2.x) * (acc[db][4 * q4 + 0] + bs), bfhi(u2.x) * (acc[db][4 * q4 + 1] + bs));
                          w.y = cvt_pk_bf16(bflo(u2.y) * (acc[db][4 * q4 + 2] + bs), bfhi(u2.y) * (acc[db][4 * q4 + 3] + bs));
                          *(v2u*)(SGUO + (size_t)tokr * SGW + gg * 128 + d) = w; } }
                __syncthreads();
            }
        }
    }
    GRID_BAR();
    }

    if ((BX & 1) == 0) { const int tid = ltid(wave0); conv_run(lds, tid, __builtin_amdgcn_readfirstlane(tid >> 6), tid & 63, NCONV_EARLY + VCU, NCONV); }
    {
        char* al = (char*)lds_raw;
        ArgsP A = kargs(); unsigned char* ws = A->ws; const int tid = ltid(wave0), lane = tid & 63, wave = __builtin_amdgcn_readfirstlane(tid >> 6); (void)lane; (void)wave;
        att::Seam S;
        att::moba_prime(att::make_ref(ws, VCU, 0), al, S, tid);
        constexpr int NBLK = 4 * ((((PROBE_DUP) >> 4) & 1) + 1);
        for (int k = 0; k < NBLK; ++k) att::moba_block(att::make_ref(ws, VCU, k & 3), att::make_ref(ws, VCU, (k + 1) & 3), al, S, tid);
    }
    if ((BX & 1) != 0) { asm volatile("s_waitcnt vmcnt(0)" ::: "memory"); __syncthreads(); const int tid = ltid(wave0); conv_run(lds, tid, __builtin_amdgcn_readfirstlane(tid >> 6), tid & 63, NCONV_EARLY + VCU, NCONV); }
    GRID_BAR();

    DUPLOOP(5) {
    {
        ArgsP A = kargs(); unsigned char* ws = A->ws; const int tid = ltid(wave0), lane = tid & 63, wave = __builtin_amdgcn_readfirstlane(tid >> 6); (void)lane; (void)wave;
        const bf16* SAg = WSP(bf16, WS_SA); const bf16* SBg = WSP(bf16, WS_SB); bf16* T1 = WSP(bf16, WS_Q); unsigned char* MERGED = ws + WS_MERGED;
        { pg8::StaticOrder S; S.init(T, D, SGW * 2, G, BX, ws + WS_WSO);
          pg8::EpiGateSeg E{SAg, SBg, T1, MERGED, 0};
          pg8::gemm_phase<false>(lds, (const char*)(ws + WS_SGUO), SGW * 2, S, E, tid); }
        { pg8::StaticOrder S; S.init(T, D, D, G, BX, ws + WS_WMO8);
          pg8::EpiGateSeg E{SAg, SBg, T1, MERGED, 1};
          pg8::gemm_phase<true>(lds, (const char*)(ws + WS_O8), D, S, E, tid, att::O8_SHIFT); }
    }
    GRID_BAR();
    }

    DUPLOOP(6) {
    {
        ArgsP A = kargs(); unsigned char* ws = A->ws; const int tid = ltid(wave0), lane = tid & 63, wave = __builtin_amdgcn_readfirstlane(tid >> 6); (void)lane; (void)wave;
        const float* ada = WSP(float, WS_ADA); bf16* DELTA = WSP(bf16, WS_DELTA);
        pg8::StaticOrder S; S.init(T, D, D, G, BX, ws + WS_WOUT);
        pg8::EpiDelta E{ada + 4096, DELTA};
        pg8::gemm_phase<true>(lds, (const char*)(ws + WS_MERGED), D, S, E, tid, pg8::M8_SHIFT);
    }
    GRID_BAR();
    }

    DUPLOOP(10) {
    {
        ArgsP A = kargs(); unsigned char* ws = A->ws; const int tid = ltid(wave0), lane = tid & 63, wave = __builtin_amdgcn_readfirstlane(tid >> 6); (void)lane; (void)wave; gu32* ctl = (gu32*)(ws + WS_CTL);
        const float* g_ffn = A->in[14]; const float* b_rg = A->in[16]; const float* b_re = A->in[18]; const float* __restrict__ x = A->in[0]; const bf16* __restrict__ DELTA = WSP(bf16, WS_DELTA);
        const float* ada = WSP(float, WS_ADA); const bf16* __restrict__ RT = WSP(bf16, WS_RT); unsigned char* __restrict__ N28 = ws + WS_N2F8;
        int* tok_e = WSP(int, WS_TOKE); int* tok_p = WSP(int, WS_TOKP); float* tok_w = WSP(float, WS_TOKW); int* elist = WSP(int, WS_LIST);
        if (rep_ == 1) { ctl += 32768; tok_e = WSP(int, WS_K); tok_p = tok_e + 2 * T; tok_w = (float*)(tok_p + 2 * T); elist = (int*)(ws + WS_K + 8 * MiB); }
        LAS unsigned char* At = lds;
        LAS float* lgx = (LAS float*)(lds + TAB_OFF);
        const int row0 = VCU * 64, b = row0 >> 12;
        LAS float* tgs = (LAS float*)(lds + TAB_OFF + 12288); LAS float* tsh = tgs + D;
        for (int i = tid; i < D; i += NWAVES * 64) { tgs[i] = g_ffn[i] * (ada[b * 12288 + 8192 + i] + 1.0f); tsh[i] = ada[b * 12288 + 6144 + i]; }
        __syncthreads();
        for (int ps = 0; ps < 2; ++ps) {
            { const LAS f32x4* gp = (const LAS f32x4*)tgs + lane; const LAS f32x4* shp = (const LAS f32x4*)tsh + lane;
#pragma unroll
              for (int rp = 0; rp < 2; ++rp) {
                  f32x4 v[2][8]; v2u dl[2][8];
#pragma unroll
                  for (int q = 0; q < 2; ++q) { const int row = row0 + ps * 32 + wave * 4 + rp * 2 + q;
#pragma unroll
                      for (int j = 0; j < 8; ++j) { v[q][j] = *((const f32x4*)(x + (size_t)row * D) + lane + 64 * j); dl[q][j] = *((const v2u*)(DELTA + (size_t)row * D) + lane + 64 * j); } }
#pragma unroll
                  for (int q = 0; q < 2; ++q) { const int rl = wave * 4 + rp * 2 + q, row = row0 + ps * 32 + rl; float ss = 0.f;
#pragma unroll
                      for (int j = 0; j < 8; ++j) { v[q][j] += (f32x4){bflo(dl[q][j].x), bfhi(dl[q][j].x), bflo(dl[q][j].y), bfhi(dl[q][j].y)};
                          ss += (v[q][j].x * v[q][j].x + v[q][j].y * v[q][j].y) + (v[q][j].z * v[q][j].z + v[q][j].w * v[q][j].w); }
                      const float rstd = rsqrtf(wave_sum(ss) * (1.f / D) + EPS);
#pragma unroll
                      for (int j = 0; j < 8; ++j) { const f32x4 y = v[q][j] * rstd * gp[64 * j] + shp[64 * j];
                          *((unsigned*)(N28 + (size_t)row * D) + lane + 64 * j) = pk_fp8x4(y.x, y.y, y.z, y.w);
                          v2u w; w.x = cvt_pk_bf16(y.x, y.y); w.y = cvt_pk_bf16(y.z, y.w);
                          *(LAS v2u*)(At + rl * 4096 + ((((lane >> 1) + 32 * j) ^ (rl & 15)) << 4) + ((lane & 1) << 3)) = w; } } } }
            __syncthreads();
            { const int i = lane & 15, kq = lane >> 4;
                f32x4 acc[2][3];
#pragma unroll
                for (int mt = 0; mt < 2; ++mt)
#pragma unroll
                    for (int nt = 0; nt < 3; ++nt) acc[mt][nt] = (f32x4){0.f, 0.f, 0.f, 0.f};
                unsigned voff = (unsigned)((wave * 8) * (2 * 48 * 32) + i * 32 + 8 * kq) * 2u;
#pragma unroll 1
                for (int ks = 0; ks < 8; ++ks, voff += 6144u) { const int kg = wave * 8 + ks;
                    bf16x8 wh[3], wl[3];
                    const char* ph = (const char*)RT + voff; const char* pl = ph + 3072;
#pragma unroll
                    for (int nt = 0; nt < 3; ++nt) { wh[nt] = *(const bf16x8*)(ph + nt * 1024); wl[nt] = *(const bf16x8*)(pl + nt * 1024); }
#pragma unroll
                    for (int mt = 0; mt < 2; ++mt) { const bf16x8 af = *(const LAS bf16x8*)(At + (16 * mt + i) * 4096 + (((4 * kg + kq) ^ i) << 4));
#pragma unroll
                        for (int nt = 0; nt < 3; ++nt) { acc[mt][nt] = __builtin_amdgcn_mfma_f32_16x16x32_bf16(af, wh[nt], acc[mt][nt], 0, 0, 0); acc[mt][nt] = __builtin_amdgcn_mfma_f32_16x16x32_bf16(af, wl[nt], acc[mt][nt], 0, 0, 0); } } }
                __syncthreads();
                LAS float* part = (LAS float*)At + wave * 1536;
#pragma unroll
                for (int mt = 0; mt < 2; ++mt)
#pragma unroll
                    for (int nt = 0; nt < 3; ++nt)
#pragma unroll
                        for (int e = 0; e < 4; ++e) part[(16 * mt + 4 * kq + e) * 48 + nt * 16 + i] = acc[mt][nt][e];
                __syncthreads();
#pragma unroll
                for (int q = 0; q < 3; ++q) { const int idx = tid + 512 * q; float sum = 0.f;
#pragma unroll
                    for (int w8 = 0; w8 < 8; ++w8) sum += ((const LAS float*)At)[w8 * 1536 + idx];
                    lgx[ps * 1536 + idx] = sum; }
                __syncthreads(); }
        }
        if (wave == 7) {
            const LAS float* l = lgx + lane * 48; const int tokn = row0 + lane;
            float gl[4]; int gs = 0; float gmax;
#pragma unroll
            for (int q = 0; q < 4; ++q) gl[q] = l[q] + b_rg[q];
            gmax = gl[0];
#pragma unroll
            for (int q = 1; q < 4; ++q) if (gl[q] > gmax) { gmax = gl[q]; gs = q; }
            float den = 0.f;
#pragma unroll
            for (int q = 0; q < 4; ++q) den += __expf(gl[q] - gmax);
            const float pg = 1.0f / den;
            float v0 = -3.0e38f, v1 = -3.0e38f; int i0 = 0, i1 = 0;
#pragma unroll
            for (int q = 0; q < 8; ++q) { const float ev = l[4 + gs * 8 + q] + b_re[gs * 8 + q];
                if (ev > v0) { v1 = v0; i1 = i0; v0 = ev; i0 = q; } else if (ev > v1) { v1 = ev; i1 = q; } }
            const float t = __expf(v1 - v0), w0 = pg / (1.0f + t), w1 = pg * t / (1.0f + t);
            const int e0 = gs * 8 + i0, e1 = gs * 8 + i1;
            const int p0 = (int)__hip_atomic_fetch_add(ctl + CW_CNT + 64 * e0, 1u, RLX_AGENT);
            const int p1 = (int)__hip_atomic_fetch_add(ctl + CW_CNT + 64 * e1, 1u, RLX_AGENT);
            elist[e0 * LCAP + p0] = tokn; elist[e1 * LCAP + p1] = tokn;
            tok_e[2 * tokn] = e0; tok_e[2 * tokn + 1] = e1; tok_p[2 * tokn] = p0; tok_p[2 * tokn + 1] = p1; tok_w[2 * tokn] = w0; tok_w[2 * tokn + 1] = w1;
        }
    }
    GRID_BAR();
    }

    LAS int* bstart = (LAS int*)(lds + TAB_OFF); LAS int* cntl = (LAS int*)(lds + TAB_OFF + 256);
    { const int t = ltid(wave0);
      if (t < 64) { gu32* ctl = (gu32*)(kargs()->ws + WS_CTL);
          const int c = (t < NEXP) ? (int)__hip_atomic_load(ctl + CW_CNT + 64 * (t & 31), RLX_AGENT) : 0, nb = (c + 255) >> 8;
          int incl = nb;
#pragma unroll
          for (int o = 1; o < 32; o <<= 1) { const int v = __shfl_up(incl, o); if (t >= o) incl += v; }
          if (t < NEXP) { cntl[t] = c; bstart[t] = incl - nb; if (t == NEXP - 1) bstart[NEXP] = incl; } } }
    __syncthreads();
    const int RB = bstart[NEXP];
    DUPLOOP(7) {
        ArgsP A = kargs(); unsigned char* ws = A->ws; const int tid = ltid(wave0), lane = tid & 63, wave = __builtin_amdgcn_readfirstlane(tid >> 6); (void)lane; (void)wave;
        const int* elist = WSP(int, WS_LIST);
        pg8::MoeSched S{bstart, cntl, elist, 4, RB * 4, G, BX, D / 128, (const char*)(ws + WS_WGU8), (size_t)1024 * D, (size_t)256 * D, true};
        pg8::EpiSwiGLU E{ws + WS_HID8};
        pg8::gemm_phase<true>(lds, (const char*)(ws + WS_N2F8), D, S, E, tid);
        GRID_BAR();
    }
    DUPLOOP(8) {
        ArgsP A = kargs(); unsigned char* ws = A->ws; const int tid = ltid(wave0), lane = tid & 63, wave = __builtin_amdgcn_readfirstlane(tid >> 6); (void)lane; (void)wave;
        const int* elist = WSP(int, WS_LIST);
        pg8::MoeSched S{bstart, cntl, elist, 8, RB * 8, G, BX, DFF / 128, (const char*)(ws + WS_WD8), (size_t)D * DFF, (size_t)256 * DFF, false};
        pg8::EpiStoreF8 E{ws + WS_YROW};
        pg8::gemm_phase<true>(lds, (const char*)(ws + WS_HID8), DFF, S, E, tid);
        GRID_BAR();
    }

    DUPLOOP(9)
    {
        ArgsP A = kargs(); unsigned char* ws = A->ws; const int tid = ltid(wave0), lane = tid & 63, wave = __builtin_amdgcn_readfirstlane(tid >> 6); (void)lane; (void)wave;
        float* out = A->out; const float* x = A->in[0]; const bf16* DELTA = WSP(bf16, WS_DELTA); const float* g_fin = A->in[22]; const float* ada = WSP(float, WS_ADA); const unsigned char* YROW = ws + WS_YROW;
        const int* tok_e = WSP(int, WS_TOKE); const int* tok_p = WSP(int, WS_TOKP); const float* tok_w = WSP(float, WS_TOKW);
        const bool poison = __hip_atomic_load((gu32*)(ws + WS_CTL) + CW_BAR + XB_TMO, RLX_AGENT) != 0u;
        LAS float* tgf = (LAS float*)lds; LAS float* tgn = tgf + D;
        { const int b0 = (VCU * NWAVES * 8) >> 12; for (int i = tid; i < D; i += NWAVES * 64) { tgf[i] = ada[(size_t)b0 * 12288 + 10240 + i]; tgn[i] = g_fin[i]; } }
        __syncthreads();
        for (int rr = 0; rr < 8; ++rr) {
            const int row = (VCU * NWAVES + wave) * 8 + rr;
            const int e0 = tok_e[2 * row], e1 = tok_e[2 * row + 1];
            const size_t s0 = (size_t)(bstart[e0] * 256 + tok_p[2 * row]), s1 = (size_t)(bstart[e1] * 256 + tok_p[2 * row + 1]);
            const float w0 = tok_w[2 * row] * (1.0f / (float)(1 << pg8::Y8_SHIFT)), w1 = tok_w[2 * row + 1] * (1.0f / (float)(1 << pg8::Y8_SHIFT));
            f32x4* hr = (f32x4*)(out + (size_t)row * D) + lane; const f32x4* xr = (const f32x4*)(x + (size_t)row * D) + lane; const v2u* dr = (const v2u*)(DELTA + (size_t)row * D) + lane;
            const unsigned* y0 = (const unsigned*)(YROW + s0 * D) + lane; const unsigned* y1 = (const unsigned*)(YROW + s1 * D) + lane;
            const LAS f32x4* gf = (const LAS f32x4*)tgf + lane;
            f32x4 v[8]; float ss = 0.f;
#pragma unroll
            for (int j = 0; j < 8; ++j) { const v2u dl = dr[64 * j]; const f32x4 hv = xr[64 * j] + (f32x4){bflo(dl.x), bfhi(dl.x), bflo(dl.y), bfhi(dl.y)}, gg = gf[64 * j]; const unsigned a = y0[64 * j], c = y1[64 * j];
                const f32x2 a0 = __builtin_amdgcn_cvt_pk_f32_fp8((int)a, false), a1 = __builtin_amdgcn_cvt_pk_f32_fp8((int)a, true), c0 = __builtin_amdgcn_cvt_pk_f32_fp8((int)c, false), c1 = __builtin_amdgcn_cvt_pk_f32_fp8((int)c, true);
                f32x4 y; y.x = w0 * a0.x + w1 * c0.x; y.y = w0 * a0.y + w1 * c0.y; y.z = w0 * a1.x + w1 * c1.x; y.w = w0 * a1.y + w1 * c1.y;
                v[j] = hv + gg * y; ss += (v[j].x * v[j].x + v[j].y * v[j].y) + (v[j].z * v[j].z + v[j].w * v[j].w); }
            const float rstd = rsqrtf(wave_sum(ss) * (1.f / D) + EPS);
#pragma unroll
            for (int j = 0; j < 8; ++j) { const f32x4 gg = *((const LAS f32x4*)tgn + lane + 64 * j); hr[64 * j] = poison ? (f32x4){__builtin_nanf(""), __builtin_nanf(""), __builtin_nanf(""), __builtin_nanf("")} : v[j] * rstd * gg; }
        }
    }
}

extern "C" void kernel_launch(void* const* d_in, const int* in_sizes, int n_in, void* d_out, int out_size, void* d_ws, size_t ws_size, hipStream_t stream) {
    static int grid = 0;
    if (grid == 0) {
        if (n_in != 23 || in_sizes[0] != T * D || out_size != T * D || ws_size < WS_END) { fprintf(stderr, "kernel_launch: unexpected shapes (n_in %d, out %d, ws %zu)\n", n_in, out_size, ws_size); grid = -1; return; }
        int dev = 0, cus = 0, per_cu = 0;
        if (hipGetDevice(&dev) != hipSuccess || hipDeviceGetAttribute(&cus, hipDeviceAttributeMultiprocessorCount, dev) != hipSuccess) { grid = -1; return; }
        if (hipFuncSetAttribute((const void*)fwd_kernel, hipFuncAttributeMaxDynamicSharedMemorySize, LDS_BYTES) != hipSuccess) { fprintf(stderr, "kernel_launch: hipFuncSetAttribute failed\n"); grid = -1; return; }
        if (hipOccupancyMaxActiveBlocksPerMultiprocessor(&per_cu, (const void*)fwd_kernel, NWAVES * 64, LDS_BYTES) != hipSuccess || per_cu < 1) fprintf(stderr, "kernel_launch: occupancy query reports %d\n", per_cu);
        (void)hipGetLastError();
        grid = cus;
        if (grid != 256) { fprintf(stderr, "kernel_launch: this kernel is built for 256 CUs, got %d\n", grid); grid = -1; return; }
    }
    if (grid < 0) return;
    (void)hipMemsetAsync((char*)d_ws + WS_CTL, 0, CTL_ZERO_BYTES, stream);
    Args a{};
    for (int i = 0; i < 23; ++i) a.in[i] = (const float*)d_in[i];
    a.out = (float*)d_out; a.ws = (unsigned char*)d_ws;
    hipLaunchKernelGGL(fwd_kernel, dim3(grid), dim3(NWAVES * 64), LDS_BYTES, stream, a);
}
```

```cpp
#include <hip/hip_runtime.h>
#include <cstdio>
#include <cstdint>

#define GAS __attribute__((address_space(1)))
#define LAS __attribute__((address_space(3)))
typedef unsigned short bf16;
typedef unsigned v4u __attribute__((ext_vector_type(4)));
typedef unsigned v2u __attribute__((ext_vector_type(2)));
typedef float f32x2 __attribute__((ext_vector_type(2)));
typedef float f32x4 __attribute__((ext_vector_type(4)));
typedef float f32x16 __attribute__((ext_vector_type(16)));
typedef short bf16x8 __attribute__((ext_vector_type(8)));
typedef short s16x4 __attribute__((ext_vector_type(4)));
typedef GAS unsigned gu32;
#define RLX_AGENT __ATOMIC_RELAXED, __HIP_MEMORY_SCOPE_AGENT
#define LDS_WAIT() asm volatile("s_waitcnt lgkmcnt(0)" ::: "memory")
#define VM_WAIT() asm volatile("s_waitcnt vmcnt(0)" ::: "memory")

constexpr int BATCH = 4, SEQ = 4096, T = BATCH * SEQ, D = 2048;
constexpr int SGW = 1024, NHEAD = 16, HD = 128, INC = 12288;
constexpr int NEXP = 32, DFF = 512, LCAP = 16384;
constexpr float EPS = 1e-6f;
constexpr int NWAVES = 8;
#ifndef PROBE_DUP
#define PROBE_DUP 0
#endif
#define DUPLOOP(k) for (int rep_ = 0; rep_ < (((PROBE_DUP) >> (k)) & 1) + 1; ++rep_)

constexpr size_t MiB = 1u << 20;
constexpr size_t WS_CTL = 0, CTL_ZERO_BYTES = 1 * MiB;
constexpr size_t WS_ADAP = 1 * MiB;
constexpr size_t WS_ADA = 1 * MiB + 786432;
constexpr size_t WS_COS = 2 * MiB, WS_SIN = 6 * MiB;
constexpr size_t WS_KM = 10 * MiB;
constexpr size_t WS_WS = 10 * MiB + 512 * 1024;
constexpr size_t WS_RT = 11 * MiB;
constexpr size_t WS_TOKE = 12 * MiB, WS_TOKP = WS_TOKE + 128 * 1024, WS_TOKW = WS_TOKP + 128 * 1024;
constexpr size_t WS_LIST = 13 * MiB;
constexpr size_t WS_WINZ = 16 * MiB;
constexpr size_t WS_WIN8 = 24 * MiB;
constexpr size_t WS_WSO = 48 * MiB;
constexpr size_t WS_WMO8 = 52 * MiB;
constexpr size_t WS_WOUT = 60 * MiB;
constexpr size_t WS_WGU8 = 68 * MiB;
constexpr size_t WS_WD8 = 132 * MiB;
constexpr size_t WS_N = 164 * MiB;
constexpr size_t WS_N1F8 = 228 * MiB;
constexpr size_t WS_UV = 260 * MiB;
constexpr size_t WS_Q = 324 * MiB, WS_K = 388 * MiB, WS_V = 452 * MiB;
constexpr size_t WS_SA = 516 * MiB, WS_SB = 580 * MiB;
constexpr size_t WS_END = 644 * MiB;
constexpr size_t WS_Q8 = WS_Q, WS_K8 = WS_K, WS_VT8 = WS_V;
constexpr size_t WS_SGUO = WS_N, WS_O8 = WS_N + 32 * MiB, WS_N2F8 = WS_UV, WS_MERGED = WS_UV, WS_HID8 = WS_N, WS_YROW = WS_Q, WS_DELTA = WS_SA;
constexpr int CW_BAR = 4096, CW_QUEUE = 8192, CW_CNT = 8192 + 64;

constexpr int RING_BYTES = 131072, LDSCTL_OFF = RING_BYTES, MISC_OFF = LDSCTL_OFF + 320, TAB_OFF = LDSCTL_OFF + 1024;
constexpr int LDS_BYTES = 163840;

__device__ __forceinline__ unsigned f2bf(float f) { unsigned u = __builtin_bit_cast(unsigned, f); return (u + 0x7fffu + ((u >> 16) & 1u)) >> 16; }
__device__ __forceinline__ unsigned pk2(float lo, float hi) { return f2bf(lo) | (f2bf(hi) << 16); }
typedef __bf16 bf16x2_t __attribute__((ext_vector_type(2)));
__device__ __forceinline__ unsigned cvt_pk_bf16(float lo, float hi) { f32x2 v = {lo, hi}; bf16x2_t b = __builtin_convertvector(v, bf16x2_t); return __builtin_bit_cast(unsigned, b); }
__device__ __forceinline__ unsigned pk_fp8x4(float a, float b, float c, float d) { unsigned w = 0u; w = __builtin_amdgcn_cvt_pk_fp8_f32(a, b, w, false); w = __builtin_amdgcn_cvt_pk_fp8_f32(c, d, w, true); return w; }
__device__ __forceinline__ float bflo(unsigned w) { return __builtin_bit_cast(float, w << 16); }
__device__ __forceinline__ float bfhi(unsigned w) { return __builtin_bit_cast(float, w & 0xffff0000u); }
__device__ __forceinline__ float wave_sum(float v) {
#pragma unroll
    for (int o = 1; o < 64; o <<= 1) v += __shfl_xor(v, o);
    return v;
}
__device__ __forceinline__ float fast_sigmoid(float x) { return __builtin_amdgcn_rcpf(1.0f + __builtin_amdgcn_exp2f(-1.4426950408889634f * x)); }
__device__ __forceinline__ float gelu_tanh(float x) { const float u = x * (1.0f + 0.044715f * x * x); return x * __builtin_amdgcn_rcpf(1.0f + __builtin_amdgcn_exp2f(-2.3022081985f * u)); }

#define XB_TMO      128
#define XB_XCNT(j)  (256  + 64 * (j))
#define XB_XSUB(j)  (1280 + 64 * (j))
#define XB_XGEN(j)  (2304 + 64 * (j))
#define XB_TOP      3328
#define XB_TOPGEN   3392
#define XCD_BAR_WORDS 3456
#define XB_SPIN_CAP (1u << 18)
__device__ __forceinline__ unsigned xb_ld(unsigned* p)              { return __hip_atomic_load(p, __ATOMIC_RELAXED, __HIP_MEMORY_SCOPE_AGENT); }
__device__ __forceinline__ unsigned xb_add(unsigned* p, unsigned v) { return __hip_atomic_fetch_add(p, v, __ATOMIC_RELAXED, __HIP_MEMORY_SCOPE_AGENT); }
__device__ __forceinline__ unsigned xb_xcc_id() { return (unsigned)__builtin_amdgcn_s_getreg((3 << 11) | 20) & 0xFu; }
#define XB_SPIN(cond, bar) do { unsigned _sp = 0; while (cond) { __builtin_amdgcn_s_sleep(1); \
    if ((++_sp & 255u) == 0u) { if (xb_ld(&(bar)[XB_TMO])) break; if (_sp > XB_SPIN_CAP) { atomicAdd(&(bar)[XB_TMO], 1u); break; } } } } while (0)
struct XcdBarrier { unsigned* bar; unsigned x; volatile LAS unsigned* st; };
__device__ __forceinline__ XcdBarrier xcd_barrier_post(unsigned* bar, volatile LAS unsigned* st, int tid) {
    XcdBarrier b; b.bar = bar; b.x = xb_xcc_id(); b.st = st;
    if (tid == 0) (void)xb_add(&bar[XB_XCNT(b.x)], 1u);
    return b;
}
__device__ __forceinline__ void xcd_barrier_complete(unsigned* bar, unsigned x, unsigned& nloc, unsigned& nx) {
    const unsigned G = gridDim.x * gridDim.y * gridDim.z;
    unsigned sum, cnt, mine, sp = 0u;
    for (;;) {
        sum = 0u; cnt = 0u; mine = 0u;
#pragma unroll
        for (unsigned j = 0; j < 16; ++j) { const unsigned c = xb_ld(&bar[XB_XCNT(j)]); sum += c; cnt += (c > 0u) ? 1u : 0u; mine = (j == x) ? c : mine; }
        if (sum == G) break;
        __builtin_amdgcn_s_sleep(1);
        if ((++sp & 255u) == 0u) { if (xb_ld(&bar[XB_TMO])) break; if (sp > XB_SPIN_CAP) { atomicAdd(&bar[XB_TMO], 1u); break; } }
    }
    nloc = mine > 0u ? mine : 1u; nx = cnt > 0u ? cnt : 1u;
}
__device__ __forceinline__ void xcd_barrier(const XcdBarrier& b, int tid) {
    asm volatile("s_waitcnt vmcnt(0)" ::: "memory");
    __syncthreads();
    if (tid == 0) {
        unsigned* bar = b.bar;
        __builtin_amdgcn_s_waitcnt(0);
        unsigned nloc = b.st[0], nx = b.st[1];
        if (nloc == 0u) { xcd_barrier_complete(bar, b.x, nloc, nx); b.st[0] = nloc; b.st[1] = nx; }
        const unsigned old = xb_add(&bar[XB_XSUB(b.x)], 1u);
        const unsigned gen = old / nloc;
        if (old + 1u == (gen + 1u) * nloc) {
            __builtin_amdgcn_fence(__ATOMIC_RELEASE, "agent");
            asm volatile("s_waitcnt vmcnt(0)" ::: "memory");
            const unsigned og = xb_add(&bar[XB_TOP], 1u);
            const unsigned tg = og / nx;
            if (og + 1u == (tg + 1u) * nx) xb_add(&bar[XB_TOPGEN], 1u);
            else XB_SPIN(xb_ld(&bar[XB_TOPGEN]) == tg, bar);
            __builtin_amdgcn_fence(__ATOMIC_ACQUIRE, "agent");
            xb_add(&bar[XB_XGEN(b.x)], 1u);
            asm volatile("s_waitcnt vmcnt(0)" ::: "memory");
        } else {
            XB_SPIN(xb_ld(&bar[XB_XGEN(b.x)]) == gen, bar);
            __builtin_amdgcn_fence(__ATOMIC_ACQUIRE, "agent");
            asm volatile("s_waitcnt vmcnt(0)" ::: "memory");
        }
    }
    __syncthreads();
}

namespace pg8 {
constexpr int BM = 256, BK = 64, HALF = 128, HTB = HALF * BK * 2, STAGE_BYTES = 8 * HTB, NXCD = 8, WGM = 4;
__device__ __forceinline__ int lds_byte(int r, int c) { const int st = (r >> 4) * 2 + (c >> 5), rr = r & 15, cc = c & 31, ob = rr * 64 + cc * 2; return st * 1024 + (ob ^ (((ob >> 9) & 1) << 5)); }
__device__ __forceinline__ void stage_rc(int b, int& R, int& C) { const int st = b / 1024, sb = b % 1024, swz = sb ^ (((sb >> 9) & 1) << 5); R = (st >> 1) * 16 + swz / 64; C = (st & 1) * 32 + (swz % 64) / 2; }
__device__ __forceinline__ int perm32(int rho) { const int n = rho >> 4, i = rho & 15; return 8 * (i >> 2) + 4 * n + (i & 3); }
typedef int v8i __attribute__((ext_vector_type(8)));
typedef int v4i __attribute__((ext_vector_type(4)));
constexpr int M8_SHIFT = 4;
constexpr int W8_SHIFT = 5;
__device__ __forceinline__ v8i cat8(bf16x8 lo, bf16x8 hi) { const v4i a = __builtin_bit_cast(v4i, lo), b = __builtin_bit_cast(v4i, hi); return __builtin_shufflevector(a, b, 0, 1, 2, 3, 4, 5, 6, 7); }
struct Unit { int pm, pn, ex, kt0, nkt; };

struct StaticOrder {
    int nM, nN, nwg, G, c, nkt; const char* Bt; size_t tstepB;
    __device__ __forceinline__ void init(int M, int N, int rowbytes, int G_, int c_, const void* Bt_) { nM = M / BM; nN = N / BM; nwg = nM * nN; G = G_; c = c_; Bt = (const char*)Bt_; tstepB = (size_t)BM * rowbytes; nkt = rowbytes / 128; }
    __device__ __forceinline__ bool next(int i, Unit& u) const {
        const long L = (long)i * G + c; if (L >= nwg) return false;
        int wgid = (int)L; { const int q = nwg / NXCD, r = nwg % NXCD, xcd = wgid % NXCD, off = wgid / NXCD; wgid = (xcd < r ? xcd * (q + 1) : r * (q + 1) + (xcd - r) * q) + off; }
        const int nig = WGM * nN, gid = wgid / nig, fm = gid * WGM, gsz = (nM - fm) < WGM ? (nM - fm) : WGM;
        u.pm = fm + ((wgid % nig) % gsz); u.pn = (wgid % nig) / gsz; u.ex = 0; u.kt0 = 0; u.nkt = nkt; return true;
    }
    __device__ __forceinline__ const char* b_ptr(const Unit& u) const { return Bt + (size_t)u.pn * tstepB; }
    __device__ __forceinline__ unsigned a_row(const Unit& u, int r) const { return (unsigned)(u.pm * BM + r); }
};

template <bool F8, class Epi, class Sched>
__device__ __forceinline__ void gemm_phase(LAS unsigned char* lds, const char* Ab, const int rowbytes, const Sched& S, const Epi& E, const int tid, const int a8shift = 0) {
    const int wid = __builtin_amdgcn_readfirstlane(tid >> 6), lane = tid & 63, wr = wid >> 2, wc = wid & 3, fr = lane & 15, fq = lane >> 4;
    int Rs[2]; unsigned Cs[2], voffB[2];
#pragma unroll
    for (int i = 0; i < 2; ++i) { int R, C; stage_rc(tid * 16 + i * 8192, R, C); const int Rb = Epi::PERM ? ((R & ~31) + perm32(R & 31)) : R;
        Rs[i] = R; Cs[i] = (unsigned)C * 2u; voffB[i] = (unsigned)(Rb * rowbytes + C * 2); }
    const size_t kstep = (size_t)(BK * 2);
    const size_t hstep = (size_t)HALF * rowbytes;
    const unsigned rowb = (unsigned)rowbytes;
    const unsigned ldsw = (unsigned)wid * 1024u;
    const int aoff = lds_byte(wr * 64 + fr, fq * 8), boff = lds_byte(wc * 32 + fr, fq * 8);
#define PG8_SA(b, h) (((b) * 2 + (h)) * HTB)
#define PG8_SB(b, h) ((4 + (b) * 2 + (h)) * HTB)
#define PG8_STAGE_B(bufoff, gbase) do { _Pragma("unroll") for (int _i = 0; _i < 2; ++_i) \
        __builtin_amdgcn_global_load_lds((const unsigned*)((const char*)(gbase) + voffB[_i]), (LAS unsigned*)(lds + (bufoff) + ldsw + _i * 8192), 16, 0, 0); } while (0)
#define PG8_STAGE_A(bufoff, kbyte, h) do { _Pragma("unroll") for (int _i = 0; _i < 2; ++_i) \
        __builtin_amdgcn_global_load_lds((const unsigned*)(Ab + (kbyte) + vC[h][_i]), (LAS unsigned*)(lds + (bufoff) + ldsw + _i * 8192), 16, 0, 0); } while (0)
#define PG8_LDA(dst, b, h) do { _Pragma("unroll") for (int m = 0; m < 4; ++m) _Pragma("unroll") for (int k = 0; k < 2; ++k) dst[m][k] = *(const LAS bf16x8*)(lds + PG8_SA(b, h) + aoff + m * 2048 + k * 1024); } while (0)
#define PG8_LDB(dst, b, h) do { _Pragma("unroll") for (int n = 0; n < 2; ++n) _Pragma("unroll") for (int k = 0; k < 2; ++k) dst[n][k] = *(const LAS bf16x8*)(lds + PG8_SB(b, h) + boff + n * 2048 + k * 1024); } while (0)
#define PG8_MMA(ai, bj, At, Bt) do { __builtin_amdgcn_s_setprio(1); _Pragma("unroll") for (int m = 0; m < 4; ++m) _Pragma("unroll") for (int n = 0; n < 2; ++n) { \
        if constexpr (F8) acc[ai][bj][m][n] = __builtin_amdgcn_mfma_scale_f32_16x16x128_f8f6f4(cat8(Bt[n][0], Bt[n][1]), cat8(At[m][0], At[m][1]), acc[ai][bj][m][n], 0, 0, 0, 127 - W8_SHIFT, 0, 127 - a8shift); \
        else { _Pragma("unroll") for (int k = 0; k < 2; ++k) acc[ai][bj][m][n] = __builtin_amdgcn_mfma_f32_16x16x32_bf16(Bt[n][k], At[m][k], acc[ai][bj][m][n], 0, 0, 0); } } __builtin_amdgcn_s_setprio(0); } while (0)
#define PG8_WAIT_V(n) asm volatile("s_waitcnt vmcnt(" #n ")" ::: "memory")
#define PG8_WAIT_L(n) asm volatile("s_waitcnt lgkmcnt(" #n ")" ::: "memory")
#define PG8_BAR __builtin_amdgcn_s_barrier()
#define PG8_SCHED __builtin_amdgcn_sched_barrier(0)
    Unit cur, nxt; int ui = 0;
    if (!S.next(0, cur)) return;
    f32x4 acc[2][2][4][2];
#pragma unroll
    for (int a = 0; a < 2; ++a)
#pragma unroll
        for (int b = 0; b < 2; ++b)
#pragma unroll
            for (int m = 0; m < 4; ++m)
#pragma unroll
                for (int n = 0; n < 2; ++n) acc[a][b][m][n] = (f32x4){0.f, 0.f, 0.f, 0.f};
    bf16x8 At[4][2], B0[2][2], B1[2][2];
    unsigned vC[2][2], vN[2][2];
#pragma unroll
    for (int h = 0; h < 2; ++h)
#pragma unroll
        for (int i = 0; i < 2; ++i) vC[h][i] = S.a_row(cur, h * HALF + Rs[i]) * rowb + Cs[i];
    const char* cB = S.b_ptr(cur) + (size_t)cur.kt0 * kstep; size_t kc = (size_t)cur.kt0 * kstep; int nt = cur.nkt;
    PG8_STAGE_B(PG8_SB(0, 0), cB); PG8_STAGE_B(PG8_SB(0, 1), cB + hstep); PG8_STAGE_A(PG8_SA(0, 0), kc, 0); PG8_STAGE_A(PG8_SA(0, 1), kc, 1);
    if (wr == 1) PG8_BAR;
    PG8_WAIT_V(2); PG8_BAR;
    PG8_STAGE_B(PG8_SB(1, 0), cB + kstep); PG8_STAGE_A(PG8_SA(1, 0), kc + kstep, 0); PG8_STAGE_B(PG8_SB(1, 1), cB + hstep + kstep);
    PG8_WAIT_V(6); PG8_BAR;
    for (;;) {
        const bool has_next = S.next(ui + 1, nxt);
        const char* nB = has_next ? S.b_ptr(nxt) + (size_t)nxt.kt0 * kstep : cB; const size_t kn = has_next ? (size_t)nxt.kt0 * kstep : kc;
#pragma unroll
        for (int h = 0; h < 2; ++h)
#pragma unroll
            for (int i = 0; i < 2; ++i) vN[h][i] = has_next ? (S.a_row(nxt, h * HALF + Rs[i]) * rowb + Cs[i]) : vC[h][i];
        for (int t = 0; t < nt; t += 2) {
            const bool last = (t == nt - 2);
            const size_t ka1 = kc + (size_t)(t + 1) * kstep;
            const size_t ka2 = last ? kn : kc + (size_t)(t + 2) * kstep;
            const char* b2 = last ? nB : cB + (size_t)(t + 2) * kstep; const char* b3 = b2 + kstep;
            PG8_LDB(B0, 0, 0); PG8_LDB(B1, 0, 1); PG8_SCHED; PG8_LDA(At, 0, 0); PG8_STAGE_A(PG8_SA(1, 1), ka1, 1);
            if (last) {
#pragma unroll
                for (int h = 0; h < 2; ++h)
#pragma unroll
                    for (int i = 0; i < 2; ++i) vC[h][i] = vN[h][i];
            }
            PG8_WAIT_V(8); PG8_WAIT_L(0); PG8_BAR; PG8_MMA(0, 0, At, B0); PG8_MMA(0, 1, At, B1); PG8_BAR; PG8_SCHED;
            PG8_LDA(At, 0, 1); PG8_STAGE_B(PG8_SB(0, 0), b2); PG8_STAGE_B(PG8_SB(0, 1), b2 + hstep); PG8_STAGE_A(PG8_SA(0, 0), ka2, 0);
            PG8_WAIT_V(8); PG8_WAIT_L(0); PG8_BAR; PG8_MMA(1, 0, At, B0); PG8_MMA(1, 1, At, B1); PG8_BAR; PG8_SCHED;
            PG8_LDB(B0, 1, 0); PG8_LDB(B1, 1, 1); PG8_SCHED; PG8_LDA(At, 1, 0); PG8_STAGE_A(PG8_SA(0, 1), ka2, 1);
            PG8_WAIT_V(8); PG8_WAIT_L(0); PG8_BAR; PG8_MMA(0, 0, At, B0); PG8_MMA(0, 1, At, B1); PG8_BAR; PG8_SCHED;
            PG8_LDA(At, 1, 1); PG8_STAGE_B(PG8_SB(1, 0), b3); PG8_STAGE_B(PG8_SB(1, 1), b3 + hstep); PG8_STAGE_A(PG8_SA(1, 0), ka2 + kstep, 0);
            PG8_WAIT_V(8); PG8_WAIT_L(0); PG8_BAR; PG8_MMA(1, 0, At, B0); PG8_MMA(1, 1, At, B1); PG8_BAR; PG8_SCHED;
        }
        if (wr == 0) PG8_BAR;
        E(acc, cur, wr, wc, fr, fq);
        if (!has_next) break;
#pragma unroll
        for (int a = 0; a < 2; ++a)
#pragma unroll
            for (int b = 0; b < 2; ++b)
#pragma unroll
                for (int m = 0; m < 4; ++m)
#pragma unroll
                    for (int n = 0; n < 2; ++n) acc[a][b][m][n] = (f32x4){0.f, 0.f, 0.f, 0.f};
        cur = nxt; cB = nB; kc = kn; nt = cur.nkt; ++ui;
        if (wr == 1) PG8_BAR;
    }
    PG8_WAIT_V(0);
    PG8_BAR;
#undef PG8_SA
#undef PG8_SB
#undef PG8_STAGE_A
#undef PG8_STAGE_B
#undef PG8_LDA
#undef PG8_LDB
#undef PG8_MMA
#undef PG8_WAIT_V
#undef PG8_WAIT_L
#undef PG8_BAR
#undef PG8_SCHED
}

typedef const f32x4 (&AccRef)[2][2][4][2];

struct EpiInProj {
    static constexpr bool PERM = true;
    bf16* UV; unsigned char* Q8; unsigned char* K8; unsigned char* VT8; bf16* SA; bf16* SB; const float* cosT; const float* sinT; int pn_off;
    __device__ __forceinline__ void operator()(AccRef acc, const Unit& u, int wr, int wc, int fr, int fq) const {
        asm volatile("" : "+v"(fr), "+v"(fq));
        const int pn = u.pn + pn_off, rbase = u.pm * BM + wr * 64 + fr, cl = wc * 32 + 8 * fq;
        if (pn < 8) {
#pragma unroll
            for (int ai = 0; ai < 2; ++ai)
#pragma unroll
                for (int m = 0; m < 4; ++m) { bf16* rp = UV + (size_t)(rbase + ai * HALF + m * 16) * D + pn * BM + cl;
#pragma unroll
                    for (int bj = 0; bj < 2; ++bj) { const f32x4 a = acc[ai][bj][m][0], b = acc[ai][bj][m][1];
                        v4u w; w.x = cvt_pk_bf16(gelu_tanh(a[0]), gelu_tanh(a[1])); w.y = cvt_pk_bf16(gelu_tanh(a[2]), gelu_tanh(a[3]));
                        w.z = cvt_pk_bf16(gelu_tanh(b[0]), gelu_tanh(b[1])); w.w = cvt_pk_bf16(gelu_tanh(b[2]), gelu_tanh(b[3]));
                        *(v4u*)(rp + bj * HALF) = w; } }
        } else if (pn < 24) {
            unsigned char* dst = (pn < 16) ? Q8 : K8; const int hp = ((pn - 8) & 7) * 2, j0 = cl >> 1;
#pragma unroll
            for (int ai = 0; ai < 2; ++ai) {
                f32x4 cc[4], sn[4];
#pragma unroll
                for (int m = 0; m < 4; ++m) { const int row = rbase + ai * HALF + m * 16; cc[m] = *(const f32x4*)(cosT + (size_t)row * 64 + j0); sn[m] = *(const f32x4*)(sinT + (size_t)row * 64 + j0); }
#pragma unroll
                for (int m = 0; m < 4; ++m) { const int row = rbase + ai * HALF + m * 16, b = row >> 12, s = row & 4095;
                    const f32x4 c4 = cc[m], s4 = sn[m];
#pragma unroll
                    for (int bj = 0; bj < 2; ++bj) { const f32x4 x0 = acc[ai][bj][m][0], x1 = acc[ai][bj][m][1];
                        v2u w;
                        w.x = pk_fp8x4(x0[0] * c4[0] - x0[1] * s4[0], x0[1] * c4[0] + x0[0] * s4[0], x0[2] * c4[1] - x0[3] * s4[1], x0[3] * c4[1] + x0[2] * s4[1]);
                        w.y = pk_fp8x4(x1[0] * c4[2] - x1[1] * s4[2], x1[1] * c4[2] + x1[0] * s4[2], x1[2] * c4[3] - x1[3] * s4[3], x1[3] * c4[3] + x1[2] * s4[3]);
                        *(v2u*)(dst + ((size_t)(b * NHEAD + hp + bj) * SEQ + s) * HD + cl) = w; } }
            }
        } else if (pn < 32) {
            const int hp = (pn - 24) * 2, lane = fr + 16 * fq, jq = lane & 3;
#pragma unroll
            for (int ai = 0; ai < 2; ++ai)
#pragma unroll
                for (int m = 0; m < 4; ++m) { const int row = rbase + ai * HALF + m * 16, b = row >> 12, s0 = (row & 4095) & ~3;
#pragma unroll
                    for (int bj = 0; bj < 2; ++bj) { const f32x4 a = acc[ai][bj][m][0], c = acc[ai][bj][m][1];
                        const unsigned w0 = pk_fp8x4(a[0], a[1], a[2], a[3]), w1 = pk_fp8x4(c[0], c[1], c[2], c[3]);
                        unsigned o0 = 0u, o1 = 0u;
#define VQ(q) { const unsigned t0 = (unsigned)__builtin_amdgcn_mov_dpp((int)w0, (q) * 0x55, 0xf, 0xf, true), t1 = (unsigned)__builtin_amdgcn_mov_dpp((int)w1, (q) * 0x55, 0xf, 0xf, true); \
                            o0 |= ((t0 >> (8 * jq)) & 0xffu) << (8 * (q)); o1 |= ((t1 >> (8 * jq)) & 0xffu) << (8 * (q)); }
                        VQ(0) VQ(1) VQ(2) VQ(3)
#undef VQ
                        unsigned char* vp = VT8 + ((size_t)(b * NHEAD + hp + bj) * HD + cl + jq) * SEQ + s0;
                        *(unsigned*)vp = o0; *(unsigned*)(vp + 4 * SEQ) = o1; } }
        } else {
            bf16* dst = (pn < 40) ? SA : SB; const int colt = ((pn - 32) & 7) * BM;
#pragma unroll
            for (int ai = 0; ai < 2; ++ai)
#pragma unroll
                for (int m = 0; m < 4; ++m) { bf16* rp = dst + (size_t)(rbase + ai * HALF + m * 16) * D + colt + cl;
#pragma unroll
                    for (int bj = 0; bj < 2; ++bj) { const f32x4 a = acc[ai][bj][m][0], b = acc[ai][bj][m][1];
                        v4u w; w.x = cvt_pk_bf16(fast_sigmoid(a[0]), fast_sigmoid(a[1])); w.y = cvt_pk_bf16(fast_sigmoid(a[2]), fast_sigmoid(a[3]));
                        w.z = cvt_pk_bf16(fast_sigmoid(b[0]), fast_sigmoid(b[1])); w.w = cvt_pk_bf16(fast_sigmoid(b[2]), fast_sigmoid(b[3]));
                        *(v4u*)(rp + bj * HALF) = w; } }
        }
    }
};
struct EpiGateSeg {
    static constexpr bool PERM = true;
    const bf16* SAg; const bf16* SBg; bf16* T1; unsigned char* Mg; int seg;
    __device__ __forceinline__ void operator()(AccRef acc, const Unit& u, int wr, int wc, int fr, int fq) const {
        const int rbase = u.pm * BM + wr * 64 + fr, col0 = u.pn * BM + wc * 32 + 8 * fq;
        if (seg == 0) {
#pragma unroll
            for (int ai = 0; ai < 2; ++ai) {
                v4u g[4][2];
#pragma unroll
                for (int m = 0; m < 4; ++m)
#pragma unroll
                    for (int bj = 0; bj < 2; ++bj) g[m][bj] = *(const v4u*)(SAg + (size_t)(rbase + ai * HALF + m * 16) * D + col0 + bj * HALF);
#pragma unroll
                for (int m = 0; m < 4; ++m) { const size_t off = (size_t)(rbase + ai * HALF + m * 16) * D + col0;
#pragma unroll
                    for (int bj = 0; bj < 2; ++bj) { const v4u gg = g[m][bj]; const f32x4 a = acc[ai][bj][m][0], b = acc[ai][bj][m][1];
                        v4u w; w.x = cvt_pk_bf16(bflo(gg.x) * a[0], bfhi(gg.x) * a[1]); w.y = cvt_pk_bf16(bflo(gg.y) * a[2], bfhi(gg.y) * a[3]);
                        w.z = cvt_pk_bf16(bflo(gg.z) * b[0], bfhi(gg.z) * b[1]); w.w = cvt_pk_bf16(bflo(gg.w) * b[2], bfhi(gg.w) * b[3]);
                        *(v4u*)(T1 + off + bj * HALF) = w; } }
            }
        } else {
#pragma unroll
            for (int ai = 0; ai < 2; ++ai)
#pragma unroll
                for (int mp = 0; mp < 2; ++mp) {
                    v4u tt[2][2], g[2][2];
#pragma unroll
                    for (int mm = 0; mm < 2; ++mm)
#pragma unroll
                        for (int bj = 0; bj < 2; ++bj) { const size_t off = (size_t)(rbase + ai * HALF + (2 * mp + mm) * 16) * D + col0 + bj * HALF; tt[mm][bj] = *(const v4u*)(T1 + off); g[mm][bj] = *(const v4u*)(SBg + off); }
#pragma unroll
                    for (int mm = 0; mm < 2; ++mm) { const int m = 2 * mp + mm; const size_t off = (size_t)(rbase + ai * HALF + m * 16) * D + col0;
#pragma unroll
                        for (int bj = 0; bj < 2; ++bj) { const v4u t = tt[mm][bj], gg = g[mm][bj]; const f32x4 a = acc[ai][bj][m][0], b = acc[ai][bj][m][1];
                            constexpr float MS = (float)(1 << M8_SHIFT);
                            v2u w; w.x = pk_fp8x4((bflo(t.x) + bflo(gg.x) * a[0]) * MS, (bfhi(t.x) + bfhi(gg.x) * a[1]) * MS, (bflo(t.y) + bflo(gg.y) * a[2]) * MS, (bfhi(t.y) + bfhi(gg.y) * a[3]) * MS);
                            w.y = pk_fp8x4((bflo(t.z) + bflo(gg.z) * b[0]) * MS, (bfhi(t.z) + bfhi(gg.z) * b[1]) * MS, (bflo(t.w) + bflo(gg.w) * b[2]) * MS, (bfhi(t.w) + bfhi(gg.w) * b[3]) * MS);
                            *(v2u*)(Mg + off + bj * HALF) = w; } }
                }
        }
    }
};
struct EpiDelta {
    static constexpr bool PERM = true;
    const float* gm; bf16* Dl;
    __device__ __forceinline__ void operator()(AccRef acc, const Unit& u, int wr, int wc, int fr, int fq) const {
        const int rbase = u.pm * BM + wr * 64 + fr, col0 = u.pn * BM + wc * 32 + 8 * fq, b = (u.pm * BM) >> 12;
        f32x4 gv[2][2];
#pragma unroll
        for (int bj = 0; bj < 2; ++bj)
#pragma unroll
            for (int n = 0; n < 2; ++n) gv[bj][n] = *(const f32x4*)(gm + (size_t)b * 12288 + col0 + bj * HALF + 4 * n);
#pragma unroll
        for (int ai = 0; ai < 2; ++ai)
#pragma unroll
            for (int m = 0; m < 4; ++m) { bf16* rp = Dl + (size_t)(rbase + ai * HALF + m * 16) * D + col0;
#pragma unroll
                for (int bj = 0; bj < 2; ++bj) { const f32x4 a = acc[ai][bj][m][0] * gv[bj][0], c = acc[ai][bj][m][1] * gv[bj][1];
                    v4u w; w.x = cvt_pk_bf16(a[0], a[1]); w.y = cvt_pk_bf16(a[2], a[3]); w.z = cvt_pk_bf16(c[0], c[1]); w.w = cvt_pk_bf16(c[2], c[3]);
                    *(v4u*)(rp + bj * HALF) = w; } }
    }
};
struct MoeSched {
    const LAS int* bstart; const LAS int* cntl; const int* list; int npn, total, G, c, nkt; const char* Bt; size_t estride, tstepB; bool gather;
    __device__ __forceinline__ bool next(int i, Unit& u) const {
        const int L = i * G + c; if (L >= total) return false;
        const int rb = L / npn; int e = 0;
        for (int j = 1; j < NEXP; ++j) e += (bstart[j] <= rb) ? 1 : 0;
        u.pm = rb; u.pn = L - rb * npn; u.ex = e; u.kt0 = 0; u.nkt = nkt; return true;
    }
    __device__ __forceinline__ const char* b_ptr(const Unit& u) const { return Bt + (size_t)u.ex * estride + (size_t)u.pn * tstepB; }
    __device__ __forceinline__ unsigned a_row(const Unit& u, int r) const {
        if (!gather) return (unsigned)(u.pm * BM + r);
        const int pos = (u.pm - bstart[u.ex]) * BM + r;
        return (pos < cntl[u.ex]) ? (unsigned)list[u.ex * LCAP + pos] : 0u;
    }
};
struct EpiSwiGLU {
    static constexpr bool PERM = true;
    unsigned char* HID;
    __device__ __forceinline__ void operator()(AccRef acc, const Unit& u, int wr, int wc, int fr, int fq) const {
        const int rbase = u.pm * BM + wr * 64 + fr, hc0 = u.pn * 128 + wc * 16 + 4 * fq;
#pragma unroll
        for (int ai = 0; ai < 2; ++ai)
#pragma unroll
            for (int m = 0; m < 4; ++m) { unsigned char* rp = HID + (size_t)(rbase + ai * HALF + m * 16) * DFF + hc0;
#pragma unroll
                for (int bj = 0; bj < 2; ++bj) { const f32x4 g = acc[ai][bj][m][0], up = acc[ai][bj][m][1];
                    *(unsigned*)(rp + bj * 64) = pk_fp8x4(g[0] * fast_sigmoid(g[0]) * up[0], g[1] * fast_sigmoid(g[1]) * up[1], g[2] * fast_sigmoid(g[2]) * up[2], g[3] * fast_sigmoid(g[3]) * up[3]); } }
    }
};
constexpr int Y8_SHIFT = 4;
struct EpiStoreF8 {
    static constexpr bool PERM = true;
    unsigned char* Y;
    __device__ __forceinline__ void operator()(AccRef acc, const Unit& u, int wr, int wc, int fr, int fq) const {
        const int rbase = u.pm * BM + wr * 64 + fr, col0 = u.pn * BM + wc * 32 + 8 * fq;
        constexpr float YS = (float)(1 << Y8_SHIFT);
#pragma unroll
        for (int ai = 0; ai < 2; ++ai)
#pragma unroll
            for (int m = 0; m < 4; ++m) { unsigned char* rp = Y + (size_t)(rbase + ai * HALF + m * 16) * D + col0;
#pragma unroll
                for (int bj = 0; bj < 2; ++bj) { const f32x4 a = acc[ai][bj][m][0], b = acc[ai][bj][m][1];
                    v2u w; w.x = pk_fp8x4(a[0] * YS, a[1] * YS, a[2] * YS, a[3] * YS); w.y = pk_fp8x4(b[0] * YS, b[1] * YS, b[2] * YS, b[3] * YS);
                    *(v2u*)(rp + bj * HALF) = w; } }
    }
};
}

namespace att {
constexpr int NW = 8, QBLK = 32, KVBLK = 64, QB = 256, OP = 2048;
constexpr int KPITCH = 144, VPITCH = 144;
constexpr int SHM_K = 2 * KVBLK * KPITCH, SHM_V = HD * VPITCH;
constexpr int LDS_BYTES = 2 * SHM_V + 2 * SHM_K + NW * 64 * 4;
constexpr float SCALE = 0.08838834764831845f, THR = 4.f;
constexpr int O8_SHIFT = 4;
constexpr int KM_SHIFT = 4;
#define SBAR() __builtin_amdgcn_sched_barrier(0)
typedef pg8::v8i v8i; typedef pg8::v4i v4i;
__device__ __forceinline__ v8i cat32(v4i a, v4i b) { return __builtin_shufflevector(a, b, 0, 1, 2, 3, 4, 5, 6, 7); }
__device__ __forceinline__ v4i ld16(const unsigned char* p) { return *reinterpret_cast<const v4i*>(p); }
__device__ __forceinline__ f32x16 mma8(v8i a, v8i b, f32x16 c) { return __builtin_amdgcn_mfma_scale_f32_32x32x64_f8f6f4(a, b, c, 0, 0, 0, 127, 0, 127); }
__device__ __forceinline__ int crow(int r, int hi) { return (r & 3) + 8 * (r >> 2) + 4 * hi; }
__device__ __forceinline__ void mask_tile(f32x16& p0, f32x16& p1, int dq) {
    const float NEG = -__builtin_inff();
#pragma unroll
    for (int r = 0; r < 16; ++r) {
        const int c = (r & 3) + 8 * (r >> 2);
        if (dq - c < 0) p0[r] = NEG;
        if (dq - c - 32 < 0) p1[r] = NEG;
    }
}
__device__ __forceinline__ void partialSM(f32x16& p0, f32x16& p1, float& m_reg, float& mn, float& alpha, bool keep) {
    float pmax = p0[0];
#pragma unroll
    for (int r = 1; r < 16; ++r) pmax = fmaxf(pmax, p0[r]);
#pragma unroll
    for (int r = 0; r < 16; ++r) pmax = fmaxf(pmax, p1[r]);
    { auto rr = __builtin_amdgcn_permlane32_swap(__float_as_uint(pmax), __float_as_uint(pmax), false, false);
      pmax = fmaxf(__uint_as_float(rr[0]), __uint_as_float(rr[1])); }
    const float NEG = -__builtin_inff();
    pmax = keep ? pmax : NEG;
    constexpr float C2 = 1.4426950408889634f * SCALE;
    if (__builtin_expect(__all((pmax - m_reg) * SCALE <= THR), 1)) { mn = m_reg; alpha = 1.f; }
    else { mn = fmaxf(m_reg, pmax); alpha = __builtin_amdgcn_exp2f((m_reg - mn) * C2); m_reg = mn; }
    const float c2l = keep ? C2 : 0.f;
    const float mnL = keep ? -mn * C2 : NEG;
#pragma unroll
    for (int r = 0; r < 16; ++r) p0[r] = fmaf(p0[r], c2l, mnL);
#pragma unroll
    for (int r = 0; r < 16; ++r) p1[r] = fmaf(p1[r], c2l, mnL);
#pragma unroll
    for (int r = 0; r < 16; ++r) p0[r] = __builtin_amdgcn_exp2f(p0[r]);
}
__device__ __forceinline__ void finishSM(f32x16& p0, f32x16& p1, float alpha, float& l_reg, v8i& pf) {
#pragma unroll
    for (int r = 0; r < 16; ++r) p1[r] = __builtin_amdgcn_exp2f(p1[r]);
    float ps = 0;
#pragma unroll
    for (int r = 0; r < 16; ++r) ps += p0[r];
#pragma unroll
    for (int r = 0; r < 16; ++r) ps += p1[r];
    { auto rr = __builtin_amdgcn_permlane32_swap(__float_as_uint(ps), __float_as_uint(ps), false, false);
      ps = __uint_as_float(rr[0]) + __uint_as_float(rr[1]); }
    l_reg = l_reg * alpha + ps;
#pragma unroll
    for (int q = 0; q < 4; ++q) { pf[q] = (int)pk_fp8x4(p0[4 * q], p0[4 * q + 1], p0[4 * q + 2], p0[4 * q + 3]); pf[4 + q] = (int)pk_fp8x4(p1[4 * q], p1[4 * q + 1], p1[4 * q + 2], p1[4 * q + 3]); }
}
template <int SUB>
__device__ __forceinline__ void qkt(int KB, f32x16& p0, f32x16& p1, const unsigned char* K_lds, int r32, int hi, const v8i* qf) {
    p0 = f32x16{}; p1 = f32x16{};
    const unsigned char* kb = K_lds + KB * SHM_K + (SUB * KVBLK + r32) * KPITCH + hi * 32;
#pragma unroll
    for (int ks = 0; ks < 2; ++ks) {
        const v8i a0 = cat32(ld16(kb + ks * 64), ld16(kb + ks * 64 + 16)), a1 = cat32(ld16(kb + 32 * KPITCH + ks * 64), ld16(kb + 32 * KPITCH + ks * 64 + 16));
        p0 = mma8(a0, qf[ks], p0); p1 = mma8(a1, qf[ks], p1); }
}
template <int SUB>
__device__ __forceinline__ void pv_tile(int VB, f32x16* o, const unsigned char* V_lds, int r32, int hi, v8i pf) {
    const unsigned char* vb = V_lds + VB * SHM_V + r32 * VPITCH + SUB * KVBLK + hi * 32;
#pragma unroll
    for (int d0 = 0; d0 < 4; ++d0) { const v8i a = cat32(ld16(vb + d0 * 32 * VPITCH), ld16(vb + d0 * 32 * VPITCH + 16)); o[d0] = mma8(a, pf, o[d0]); }
}
__device__ __forceinline__ unsigned moba_sel(const v8i* qf, const unsigned char* KM, int qb, int r32, int hi) {
    f32x16 g = f32x16{}; const unsigned char* kp = KM + (r32 & 15) * HD + hi * 32;
#pragma unroll
    for (int ks = 0; ks < 2; ++ks) g = mma8(cat32(ld16(kp + ks * 64), ld16(kp + ks * 64 + 16)), qf[ks], g);
    float v[16];
#pragma unroll
    for (int r = 0; r < 8; ++r) { const float mine = g[r], oth = __shfl_xor(mine, 32); const int base = (r & 3) + 8 * (r >> 2);
        v[base] = hi ? oth : mine; v[base + 4] = hi ? mine : oth; }
#pragma unroll
    for (int n = 0; n < 16; ++n) v[n] = (n < qb) ? v[n] : -1e30f;
    unsigned sel = 0u;
#pragma unroll
    for (int pass = 0; pass < 3; ++pass) {
        float best = v[0]; int bi = 0;
#pragma unroll
        for (int n = 1; n < 16; ++n) { const bool gt = v[n] > best; best = gt ? v[n] : best; bi = gt ? n : bi; }
        if (best > -1e29f) sel |= 1u << bi;
#pragma unroll
        for (int n = 0; n < 16; ++n) v[n] = (n == bi) ? -__builtin_inff() : v[n];
    }
    return sel;
}
struct BlockRef { const unsigned char* Q; const unsigned char* K; const unsigned char* V; unsigned char* O; const unsigned char* KM; int qb; };
struct Seam { v8i qf[2]; v4i st_k[2], st_v[2]; };
__device__ __forceinline__ BlockRef make_ref(unsigned char* ws, int vcu, int k) {
    const int x8 = vcu & 7, bh = (k < 2) ? (vcu >> 3) : 32 + (vcu >> 3), qb = (k & 1) ? 15 - x8 : x8, b = bh >> 4, h = bh & 15;
    BlockRef r; r.Q = ws + WS_Q8 + ((size_t)bh * SEQ + (size_t)qb * 256) * HD; r.K = ws + WS_K8 + (size_t)bh * SEQ * HD; r.V = ws + WS_VT8 + (size_t)bh * HD * SEQ;
    r.O = ws + WS_O8 + ((size_t)(b * SEQ + qb * 256)) * OP + h * HD; r.KM = ws + WS_KM + (size_t)bh * 16 * HD; r.qb = qb; return r;
}
#define VMW() asm volatile("s_waitcnt vmcnt(0)" ::: "memory")
#define VMWN(n) asm volatile("s_waitcnt vmcnt(%0)" :: "i"(n) : "memory")
#define SLOAD_H(Kp, Vp, k0) do { const unsigned char* kp_ = (Kp) + (size_t)(k0) * HD + klo; const unsigned char* vp_ = (Vp) + (size_t)(k0) + vlo; \
        S.st_k[0] = ld16(kp_); S.st_k[1] = ld16(kp_ + KVBLK * HD); S.st_v[0] = ld16(vp_); S.st_v[1] = ld16(vp_ + KVBLK); } while (0)
#define SWRITE_HK(bf) do { *(v4i*)(K_lds + (bf) * SHM_K + kws) = S.st_k[0]; *(v4i*)(K_lds + (bf) * SHM_K + kws + KVBLK * KPITCH) = S.st_k[1]; } while (0)
#define SWRITE_HV(bf) do { _Pragma("unroll") for (int i_ = 0; i_ < 2; ++i_) { unsigned char* vd_ = V_lds + (bf) * SHM_V + vws + i_ * KVBLK; \
        *(int*)(vd_) = S.st_v[i_][0]; *(int*)(vd_ + 32) = S.st_v[i_][1]; *(int*)(vd_ + 4) = S.st_v[i_][2]; *(int*)(vd_ + 36) = S.st_v[i_][3]; } } while (0)
#define SWRITE_H(bf) do { SWRITE_HV(bf); SWRITE_HK(bf); } while (0)
#define QLOAD(Qp) do { const unsigned char* qp_ = (Qp) + qoff; S.qf[0] = cat32(ld16(qp_), ld16(qp_ + 16)); S.qf[1] = cat32(ld16(qp_ + 64), ld16(qp_ + 80)); } while (0)
#define ATT_GEOM() const int wid = __builtin_amdgcn_readfirstlane(tid >> 6), lane = tid & 63, r32 = lane & 31, hi = lane >> 5; \
    const unsigned klo = (unsigned)((tid >> 3) * HD + (tid & 7) * 16), kws = (unsigned)((tid >> 3) * KPITCH + (tid & 7) * 16); \
    const unsigned vlo = (unsigned)((tid >> 2) * SEQ + (tid & 3) * 16), vws = (unsigned)((tid >> 2) * VPITCH + (tid & 3) * 8); \
    const unsigned qoff = (unsigned)((wid * QBLK + r32) * HD + hi * 32); \
    unsigned char* V_lds = (unsigned char*)lds; unsigned char* K_lds = (unsigned char*)lds + 2 * SHM_V
__device__ __forceinline__ void moba_prime(const BlockRef& cur, char* lds, Seam& S, const int tid) {
    ATT_GEOM(); (void)V_lds; (void)vws;
    QLOAD(cur.Q);
    SLOAD_H(cur.K, cur.V, 0); VMW(); SWRITE_HK(0);
    __syncthreads();
}
__device__ __forceinline__ void moba_block(const BlockRef& cur, const BlockRef& nxt, char* lds, Seam& S, const int tid) {
    ATT_GEOM();
    const int qb = cur.qb, NS = 2 * (qb + 1);
    const int qlo = qb * QB + wid * QBLK;
    unsigned* sel_l = (unsigned*)(lds + 2 * SHM_V + 2 * SHM_K) + wid * 64;
    { const unsigned sel0 = (qb > 0) ? moba_sel(S.qf, cur.KM, qb, r32, hi) : 0u; if (hi == 0) sel_l[r32] = sel0; }
    float m_reg = -1e30f, l_reg = 0; f32x16 o[4] = {};
    const unsigned char* Kh = cur.K; const unsigned char* Vh = cur.V;
#define RESC(a) do { if (__any((a) < 1.f)) { for (int d_ = 0; d_ < 4; ++d_) for (int r = 0; r < 16; ++r) o[d_][r] *= (a); } } while (0)
#define KBASE(t) ((t) * KVBLK)
#define KEEP(t) ((((t) >> 2) >= qb) || (((sel_l[r32] >> ((t) >> 2)) & 1u) != 0u))
#define MASKT(P0_, P1_, t) do { const int kb_ = KBASE(t); if (kb_ + KVBLK - 1 > qlo) mask_tile(P0_, P1_, qlo - kb_ + r32 - 4 * hi); } while (0)
    f32x16 pA0, pA1, pB0, pB1; float mnA, mnB, alA, alB; v8i pf;
#define STEP_A(T_, B_, LOADNEXT) do { SBAR(); qkt<0>(B_, pA0, pA1, K_lds, r32, hi, S.qf); finishSM(pB0, pB1, alB, l_reg, pf); SBAR(); \
        if (LOADNEXT) { SLOAD_H(Kh, Vh, KBASE(2 * (T_) + 2)); SBAR(); } \
        pv_tile<1>(1 - (B_), o, V_lds, r32, hi, pf); MASKT(pA0, pA1, 2 * (T_)); partialSM(pA0, pA1, m_reg, mnA, alA, KEEP(2 * (T_))); RESC(alA); } while (0)
#define STEP_B(T_, B_, WRITENEXT) do { SBAR(); qkt<1>(B_, pB0, pB1, K_lds, r32, hi, S.qf); finishSM(pA0, pA1, alA, l_reg, pf); SBAR(); \
        pv_tile<0>(B_, o, V_lds, r32, hi, pf); MASKT(pB0, pB1, 2 * (T_) + 1); partialSM(pB0, pB1, m_reg, mnB, alB, KEEP(2 * (T_) + 1)); \
        if (WRITENEXT) { __syncthreads(); VMW(); SWRITE_H(1 - (B_)); RESC(alB); __syncthreads(); } else { RESC(alB); } } while (0)
    SWRITE_HV(0); SBAR();
    SLOAD_H(Kh, Vh, KBASE(2));
    SBAR(); qkt<0>(0, pA0, pA1, K_lds, r32, hi, S.qf);
    MASKT(pA0, pA1, 0); partialSM(pA0, pA1, m_reg, mnA, alA, KEEP(0));
    __syncthreads();
    STEP_B(0, 0, true);
    for (int T_ = 1; T_ + 1 < NS; ++T_) { const int bsel = T_ & 1; STEP_A(T_, bsel, true); STEP_B(T_, bsel, true); }
    STEP_A(NS - 1, 1, false);
    SBAR(); qkt<1>(1, pB0, pB1, K_lds, r32, hi, S.qf); SBAR();
    SLOAD_H(nxt.K, nxt.V, 0); SBAR();
    QLOAD(nxt.Q);
    SBAR();
    finishSM(pA0, pA1, alA, l_reg, pf); SBAR();
    pv_tile<0>(1, o, V_lds, r32, hi, pf);
    MASKT(pB0, pB1, 2 * NS - 1); partialSM(pB0, pB1, m_reg, mnB, alB, true); RESC(alB);
    finishSM(pB0, pB1, alB, l_reg, pf); SBAR(); pv_tile<1>(1, o, V_lds, r32, hi, pf);
    SBAR(); VMWN(4); SWRITE_HK(0); SBAR();
    { const float rl = __builtin_amdgcn_rcpf(l_reg) * (float)(1 << O8_SHIFT);
      int r32e = r32, hie = hi; asm volatile("" : "+v"(r32e), "+v"(hie));
      unsigned char* Ow = cur.O + (size_t)(wid * QBLK + r32e) * OP + 4 * hie;
#pragma unroll
      for (int d0 = 0; d0 < 4; ++d0)
#pragma unroll
          for (int g4 = 0; g4 < 4; ++g4) *(unsigned*)(Ow + d0 * 32 + 8 * g4) = pk_fp8x4(o[d0][4 * g4] * rl, o[d0][4 * g4 + 1] * rl, o[d0][4 * g4 + 2] * rl, o[d0][4 * g4 + 3] * rl); }
    __syncthreads();
#undef RESC
#undef KBASE
#undef KEEP
#undef MASKT
#undef STEP_A
#undef STEP_B
}
#undef VMW
#undef VMWN
#undef SLOAD_H
#undef SWRITE_HK
#undef SWRITE_HV
#undef SWRITE_H
#undef QLOAD
#undef ATT_GEOM
}

struct Args { const float* in[23]; float* out; unsigned char* ws; };
typedef const __attribute__((address_space(4))) Args* ArgsP;
__device__ __forceinline__ int ltid(int wave0) { int l; asm volatile("v_mbcnt_lo_u32_b32 %0, -1, 0\n\tv_mbcnt_hi_u32_b32 %0, -1, %0" : "=v"(l)); return (wave0 << 6) | l; }
__device__ __forceinline__ ArgsP kargs() { ArgsP p = (ArgsP)__builtin_amdgcn_kernarg_segment_ptr(); asm volatile("" : "+s"(p)); return p; }
#define WSP(T_, off) ((T_*)(ws + (off)))

struct ConvUnit { const float* W; void* WT; int ldw, ldt, k0, n0, kind, add; };
__device__ __forceinline__ int conv_row(const ConvUnit& c, int n) {
    if (c.kind == 2) { if (n >= 6144) return n - 2048; const int p = n & 127; return (n & ~127) + 2 * (p & 63) + (p >> 6) - 2048; }
    if (c.kind == 3) return (n >> 2) * 8 + (n & 3) + c.add;
    return n;
}
constexpr int CBUF = 65536, OP8 = 144, OP16 = 272;
__device__ __forceinline__ void conv_dma(const ConvUnit& c, int wave, int lane, LAS unsigned char* buf) {
    const float* Wl = c.W + (size_t)(c.k0 + 16 * wave + (lane >> 5)) * c.ldw + c.n0 + 4 * (lane & 31);
#pragma unroll
    for (int i = 0; i < 8; ++i) __builtin_amdgcn_global_load_lds((const unsigned*)(Wl + (size_t)(2 * i) * c.ldw), (LAS unsigned*)(buf + (16 * wave + 2 * i) * 512), 16, 0, 0);
}
__device__ __forceinline__ void conv_read(int wave, int lane, const LAS unsigned char* buf, float (&f)[32]) {
    const LAS float* p = (const LAS float*)(buf + (16 * wave) * 512 + 4 * lane);
#pragma unroll
    for (int i = 0; i < 16; ++i) { f[i] = p[i * 128]; f[16 + i] = p[i * 128 + 64]; }
}
__device__ __forceinline__ void conv_park8(int wave, int lane, LAS unsigned char* img, const float (&f)[32]) {
    constexpr float SC = (float)(1 << pg8::W8_SHIFT);
#pragma unroll
    for (int h = 0; h < 2; ++h) { v4u o; o.x = pk_fp8x4(f[16 * h] * SC, f[16 * h + 1] * SC, f[16 * h + 2] * SC, f[16 * h + 3] * SC); o.y = pk_fp8x4(f[16 * h + 4] * SC, f[16 * h + 5] * SC, f[16 * h + 6] * SC, f[16 * h + 7] * SC);
        o.z = pk_fp8x4(f[16 * h + 8] * SC, f[16 * h + 9] * SC, f[16 * h + 10] * SC, f[16 * h + 11] * SC); o.w = pk_fp8x4(f[16 * h + 12] * SC, f[16 * h + 13] * SC, f[16 * h + 14] * SC, f[16 * h + 15] * SC);
        *(LAS v4u*)(img + (lane + 64 * h) * OP8 + 16 * wave) = o; }
}
__device__ __forceinline__ void conv_out8(const ConvUnit& c, int tid, const LAS unsigned char* img) {
#pragma unroll
    for (int j = 0; j < 2; ++j) { const int row = (tid >> 3) + 64 * j, ch = tid & 7; const v4u v = *(const LAS v4u*)(img + row * OP8 + 16 * ch);
        *(v4u*)((unsigned char*)c.WT + (size_t)conv_row(c, c.n0 + row) * c.ldt + c.k0 + 16 * ch) = v; }
}
__device__ __forceinline__ void conv_park16(int wave, int lane, LAS unsigned char* img, const float (&f)[32], const int h) {
    v4u o0, o1; o0.x = pk2(f[16 * h], f[16 * h + 1]); o0.y = pk2(f[16 * h + 2], f[16 * h + 3]); o0.z = pk2(f[16 * h + 4], f[16 * h + 5]); o0.w = pk2(f[16 * h + 6], f[16 * h + 7]);
    o1.x = pk2(f[16 * h + 8], f[16 * h + 9]); o1.y = pk2(f[16 * h + 10], f[16 * h + 11]); o1.z = pk2(f[16 * h + 12], f[16 * h + 13]); o1.w = pk2(f[16 * h + 14], f[16 * h + 15]);
    LAS unsigned char* q = img + lane * OP16 + 32 * wave; *(LAS v4u*)q = o0; *(LAS v4u*)(q + 16) = o1;
}
__device__ __forceinline__ void conv_out16(const ConvUnit& c, int tid, const LAS unsigned char* img, const int h) {
#pragma unroll
    for (int j = 0; j < 2; ++j) { const int row = (tid >> 4) + 32 * j, ch = tid & 15; const v4u v = *(const LAS v4u*)(img + row * OP16 + 16 * ch);
        *(v4u*)((bf16*)c.WT + (size_t)conv_row(c, c.n0 + 64 * h + row) * c.ldt + c.k0 + 8 * ch) = v; }
}
constexpr int NCONV = 8320;
__device__ __forceinline__ ConvUnit conv_decode(int u, ArgsP A, unsigned char* ws) {
    ConvUnit c; c.add = 0;
    if (u < 1536) { const int kp = u / 96, g = u - kp * 96; c.W = A->in[6]; c.ldw = INC; c.k0 = kp * 128; c.n0 = g * 128; c.ldt = D;
        if (g < 16) { c.WT = ws + WS_WINZ; c.kind = 0; } else { c.WT = ws + WS_WIN8; c.kind = 2; } return c; }
    u -= 1536;
    if (u < 128) { c.W = A->in[11]; c.ldw = D; c.k0 = (u >> 4) * 128; c.n0 = (u & 15) * 128; c.WT = ws + WS_WSO; c.ldt = SGW; c.kind = 0; return c; }
    u -= 128;
    if (u < 256) { c.W = A->in[12]; c.ldw = D; c.k0 = (u >> 4) * 128; c.n0 = (u & 15) * 128; c.WT = ws + WS_WMO8; c.ldt = D; c.kind = 1; return c; }
    u -= 256;
    if (u < 256) { c.W = A->in[13]; c.ldw = D; c.k0 = (u >> 4) * 128; c.n0 = (u & 15) * 128; c.WT = ws + WS_WOUT; c.ldt = D; c.kind = 1; return c; }
    u -= 256;
    const int m = u >> 11, r = u & 2047, e = r >> 6, q = r & 63;
    if (m < 2) { c.W = A->in[19 + m] + (size_t)e * D * DFF; c.ldw = DFF; c.k0 = (q >> 2) * 128; c.n0 = (q & 3) * 128; c.WT = ws + WS_WGU8 + (size_t)e * 1024 * D; c.ldt = D; c.kind = 3; c.add = 4 * m; return c; }
    c.W = A->in[21] + (size_t)e * DFF * D; c.ldw = D; c.k0 = (q >> 4) * 128; c.n0 = (q & 15) * 128; c.WT = ws + WS_WD8 + (size_t)e * D * DFF; c.ldt = DFF; c.kind = 1; return c;
}
constexpr int NCONV_EARLY = 1536;
__device__ __forceinline__ void conv_run(LAS unsigned char* lds, const int tid, const int wave, const int lane, int u, const int uend) {
    float f[32];
    LAS unsigned char* b0 = lds; LAS unsigned char* b1 = lds + CBUF; LAS unsigned char* img = lds + TAB_OFF;
#define CONV_CLAMP(x) ((x) < uend ? (x) : uend - 1)
#define CONV_BAR() do { asm volatile("s_waitcnt lgkmcnt(0)" ::: "memory"); __builtin_amdgcn_s_barrier(); asm volatile("" ::: "memory"); } while (0)
#define CONV_STEP(N, buf) do { \
        asm volatile("s_waitcnt vmcnt(" #N ")" ::: "memory"); __builtin_amdgcn_s_barrier(); asm volatile("" ::: "memory"); \
        conv_read(wave, lane, buf, f); CONV_BAR(); \
        { ArgsP Ai = kargs(); const ConvUnit cn = conv_decode(CONV_CLAMP(u + 512), Ai, Ai->ws); conv_dma(cn, wave, lane, buf); } \
        { ArgsP Ai = kargs(); const ConvUnit c = conv_decode(u, Ai, Ai->ws); \
          if (c.kind != 0) { conv_park8(wave, lane, img, f); CONV_BAR(); conv_out8(c, tid, img); } \
          else { conv_park16(wave, lane, img, f, 0); CONV_BAR(); conv_out16(c, tid, img, 0); CONV_BAR(); conv_park16(wave, lane, img, f, 1); CONV_BAR(); conv_out16(c, tid, img, 1); } } \
        u += 256; } while (0)
    { ArgsP Ai = kargs(); const ConvUnit c = conv_decode(u, Ai, Ai->ws); conv_dma(c, wave, lane, b0); }
    { ArgsP Ai = kargs(); const ConvUnit c = conv_decode(CONV_CLAMP(u + 256), Ai, Ai->ws); conv_dma(c, wave, lane, b1); }
    CONV_STEP(8, b0);
    if (u < uend) { CONV_STEP(10, b1);
        for (;;) {
            if (u >= uend) break; CONV_STEP(12, b0);
            if (u >= uend) break; CONV_STEP(12, b1);
        } }
    asm volatile("s_waitcnt vmcnt(0)" ::: "memory");
    __builtin_amdgcn_s_barrier();
#undef CONV_STEP
#undef CONV_BAR
#undef CONV_CLAMP
}

__global__ void __launch_bounds__(NWAVES * 64, 2) fwd_kernel(Args args) {
    extern __shared__ __attribute__((aligned(16))) unsigned char lds_raw[];
    LAS unsigned char* lds = (LAS unsigned char*)lds_raw;
    const int wave0 = __builtin_amdgcn_readfirstlane((int)threadIdx.x >> 6);
    constexpr int G = 256;
#define BX ((int)blockIdx.x)
#define VCU (((int)blockIdx.x & 7) * 32 + ((int)blockIdx.x >> 3))
    volatile LAS unsigned* MISC = (volatile LAS unsigned*)(lds + MISC_OFF);
    for (int u = ltid(wave0); u < (LDS_BYTES - LDSCTL_OFF) / 4; u += NWAVES * 64) ((LAS unsigned*)(lds + LDSCTL_OFF))[u] = 0u;
    __syncthreads();
    (void)xcd_barrier_post((unsigned*)(args.ws + WS_CTL) + CW_BAR, MISC + 8, ltid(wave0));
#define GRID_BAR() do { XcdBarrier b_; b_.bar = (unsigned*)(kargs()->ws + WS_CTL) + CW_BAR; b_.x = xb_xcc_id(); b_.st = (volatile LAS unsigned*)(lds + MISC_OFF) + 8; xcd_barrier(b_, ltid(wave0)); } while (0)

    DUPLOOP(0) {
    {
        ArgsP A = kargs(); unsigned char* ws = A->ws; const int tid = ltid(wave0), lane = tid & 63, wave = __builtin_amdgcn_readfirstlane(tid >> 6); (void)lane; (void)wave; gu32* ctl = (gu32*)(ws + WS_CTL);
        const float* cin = A->in[1];
        LAS float* cact = (LAS float*)(lds + 98304);
        for (int i = tid; i < BATCH * D; i += NWAVES * 64) { const float v = cin[i]; cact[i] = v / (1.0f + __expf(-v)); }
        __syncthreads();
        { const int it = (wave < 6) ? VCU * 6 + wave : 1536 + VCU * 2 + (wave - 6); ArgsP Ai = kargs(); unsigned char* wsi = Ai->ws;
            if (it < 1536) {
                const int qd = it / 384, col = (it - qd * 384) * 32 + 4 * (lane & 7), rq = lane >> 3;
                f32x4 a0 = {0.f, 0.f, 0.f, 0.f}, a1 = a0, a2 = a0, a3 = a0;
                for (int k0 = qd * 512; k0 < qd * 512 + 512; k0 += 256) {
                    f32x4 w[32];
#pragma unroll
                    for (int i = 0; i < 32; ++i) w[i] = *(const f32x4*)(Ai->in[3] + (size_t)(k0 + rq + 8 * i) * 12288 + col);
#pragma unroll
                    for (int i = 0; i < 32; ++i) { const int k = k0 + rq + 8 * i;
                        a0 += cact[k] * w[i]; a1 += cact[D + k] * w[i]; a2 += cact[2 * D + k] * w[i]; a3 += cact[3 * D + k] * w[i]; }
                }
#pragma unroll
                for (int e = 0; e < 4; ++e)
#pragma unroll
                    for (int o = 8; o < 64; o <<= 1) { a0[e] += __shfl_xor(a0[e], o); a1[e] += __shfl_xor(a1[e], o); a2[e] += __shfl_xor(a2[e], o); a3[e] += __shfl_xor(a3[e], o); }
                if (rq == 0) { const f32x4 bb = (qd == 0) ? *(const f32x4*)(Ai->in[4] + col) : (f32x4){0.f, 0.f, 0.f, 0.f}; float* ap = ((float*)(wsi + WS_ADAP)) + (size_t)qd * 49152 + col;
                    *(f32x4*)(ap) = a0 + bb; *(f32x4*)(ap + 12288) = a1 + bb; *(f32x4*)(ap + 2 * 12288) = a2 + bb; *(f32x4*)(ap + 3 * 12288) = a3 + bb; }
            } else if (it < 1792) {
                const int tok = (it - 1536) * 64 + lane; const double pos = (double)((const int*)Ai->in[2])[tok];
                float* cosT = (float*)(wsi + WS_COS); float* sinT = (float*)(wsi + WS_SIN);
                double inv = 1.0;
                for (int j = 0; j < 64; ++j) {
                    const double rev = pos * inv * 0.15915494309189535;
                    const float fr = (float)(rev - __builtin_floor(rev));
                    cosT[(size_t)tok * 64 + j] = __builtin_amdgcn_cosf(fr); sinT[(size_t)tok * 64 + j] = __builtin_amdgcn_sinf(fr);
                    inv *= 0.8659643233600653;
                }
            } else if (it < 1824) {
                const int g = (it - 1792) >> 2, part = (it - 1792) & 3; bf16* WSb = (bf16*)(wsi + WS_WS);
                for (int i = part * 4096 + lane; i < part * 4096 + 4096; i += 64) { const int r = i >> 7, c = i & 127; WSb[g * 16384 + i] = (c <= r) ? (bf16)f2bf(Ai->in[9][g * 16384 + i]) : (bf16)0; }
            } else if (it < 2016) {
                const int q = it - 1824, u = q & 7, n0 = (q >> 3) * 2; bf16* RT = (bf16*)(wsi + WS_RT);
#pragma unroll
                for (int nn = 0; nn < 2; ++nn) { const int n = n0 + nn;
#pragma unroll
                    for (int i = 0; i < 4; ++i) { const int k = u * 256 + lane + 64 * i; const float w = (n < 4) ? Ai->in[15][k * 4 + n] : (n < 36) ? Ai->in[17][k * 32 + (n - 4)] : 0.f;
                        const unsigned hi = f2bf(w); const int ks = k >> 5, kk = k & 31; RT[((ks * 2) * 48 + n) * 32 + kk] = (bf16)hi; RT[((ks * 2 + 1) * 48 + n) * 32 + kk] = (bf16)f2bf(w - __builtin_bit_cast(float, hi << 16)); } }
            }
        }
        __syncthreads();
        conv_run(lds, tid, wave, lane, VCU, NCONV_EARLY);
    }
    GRID_BAR();
    }

    DUPLOOP(1) {
    {
        ArgsP A = kargs(); unsigned char* ws = A->ws; const int tid = ltid(wave0), lane = tid & 63, wave = __builtin_amdgcn_readfirstlane(tid >> 6); (void)lane; (void)wave;
        const float* x = A->in[0]; const float* g_mix = A->in[5]; const float* adap = WSP(float, WS_ADAP); float* adaf = WSP(float, WS_ADA); bf16* Nb = WSP(bf16, WS_N); unsigned char* N8 = ws + WS_N1F8;
        LAS float* tg = (LAS float*)(lds); LAS float* tb = (LAS float*)(lds + 8192);
        const int row0 = VCU * 64, b = row0 >> 12;
        for (int i = tid; i < D; i += NWAVES * 64) { const float* ap = adap + b * 12288 + i;
            tg[i] = g_mix[i] * (1.0f + ((ap[2048] + ap[49152 + 2048]) + (ap[2 * 49152 + 2048] + ap[3 * 49152 + 2048]))); tb[i] = (ap[0] + ap[49152]) + (ap[2 * 49152] + ap[3 * 49152]); }
        if (tid < 192) { const int i = VCU * 192 + tid; adaf[i] = (adap[i] + adap[49152 + i]) + (adap[2 * 49152 + i] + adap[3 * 49152 + i]); }
        __syncthreads();
        for (int rq = 0; rq < 2; ++rq) {
            f32x4 v[4][8];
#pragma unroll
            for (int q = 0; q < 4; ++q) { const f32x4* xr = (const f32x4*)(x + (size_t)(row0 + wave * 8 + rq * 4 + q) * D) + lane;
#pragma unroll
                for (int j = 0; j < 8; ++j) v[q][j] = xr[64 * j]; }
#pragma unroll
            for (int q = 0; q < 4; ++q) { const int row = row0 + wave * 8 + rq * 4 + q; float ss = 0.f;
#pragma unroll
                for (int j = 0; j < 8; ++j) ss += (v[q][j].x * v[q][j].x + v[q][j].y * v[q][j].y) + (v[q][j].z * v[q][j].z + v[q][j].w * v[q][j].w);
                const float rstd = rsqrtf(wave_sum(ss) * (1.f / D) + EPS);
                v2u* o8 = (v2u*)(Nb + (size_t)row * D) + lane;
#pragma unroll
                for (int j = 0; j < 8; ++j) { const f32x4 gg = *(const LAS f32x4*)(tg + 4 * lane + 256 * j), bb = *(const LAS f32x4*)(tb + 4 * lane + 256 * j);
                    const f32x4 y = v[q][j] * rstd * gg + bb; v2u w; w.x = cvt_pk_bf16(y.x, y.y); w.y = cvt_pk_bf16(y.z, y.w); o8[64 * j] = w;
                    *((unsigned*)(N8 + (size_t)row * D) + lane + 64 * j) = pk_fp8x4(y.x, y.y, y.z, y.w); } }
        }
    }
    GRID_BAR();
    }

    DUPLOOP(2) {
    {
        ArgsP A = kargs(); unsigned char* ws = A->ws; const int tid = ltid(wave0), lane = tid & 63, wave = __builtin_amdgcn_readfirstlane(tid >> 6); (void)lane; (void)wave;
        bf16* Nb = WSP(bf16, WS_N); bf16* UV = WSP(bf16, WS_UV); unsigned char* Qh = ws + WS_Q8; unsigned char* Kh = ws + WS_K8; unsigned char* Vh = ws + WS_VT8;
        bf16* SAg = WSP(bf16, WS_SA); bf16* SBg = WSP(bf16, WS_SB); const float* cosT = WSP(float, WS_COS); const float* sinT = WSP(float, WS_SIN);
        { pg8::StaticOrder S; S.init(T, 2048, D * 2, G, BX, ws + WS_WINZ);
          pg8::EpiInProj E{UV, Qh, Kh, Vh, SAg, SBg, cosT, sinT, 0};
          pg8::gemm_phase<false>(lds, (const char*)Nb, D * 2, S, E, tid); }
        { pg8::StaticOrder S; S.init(T, 10240, D, G, BX, ws + WS_WIN8);
          pg8::EpiInProj E{UV, Qh, Kh, Vh, SAg, SBg, cosT, sinT, 8};
          pg8::gemm_phase<true>(lds, (const char*)(ws + WS_N1F8), D, S, E, tid); }
    }
    GRID_BAR();
    }

    DUPLOOP(3) {
    {
        ArgsP A = kargs(); unsigned char* ws = A->ws; const int tid = ltid(wave0), lane = tid & 63, wave = __builtin_amdgcn_readfirstlane(tid >> 6); (void)lane; (void)wave;
        const float* sgu_ln_g = A->in[7]; const float* sgu_ln_b = A->in[8]; const float* sgu_b_s = A->in[10];
        const bf16* UV = WSP(bf16, WS_UV); const bf16* WSb = WSP(bf16, WS_WS); bf16* SGUO = WSP(bf16, WS_SGUO); const unsigned char* K8 = ws + WS_K8; unsigned char* KM = ws + WS_KM;
        constexpr int VP = 136;
        LAS bf16* vT = (LAS bf16*)lds; LAS f32x2* st = (LAS f32x2*)(lds + 2 * 128 * VP * 2); LAS float* kx = (LAS float*)(lds + 73728);
        { const int item = VCU * NWAVES + wave, blk = item >> 1, half = item & 1, c8 = (lane & 15) * 8, r0 = lane >> 4;
          const unsigned char* kp = K8 + ((size_t)blk * 256 + half * 128 + r0) * HD + c8;
          float sacc[8] = {0.f, 0.f, 0.f, 0.f, 0.f, 0.f, 0.f, 0.f};
          { v2u w[32];
#pragma unroll
              for (int u = 0; u < 32; ++u) w[u] = *(const v2u*)(kp + (size_t)(4 * u) * HD);
#pragma unroll
              for (int u = 0; u < 32; ++u) { const f32x2 a0 = __builtin_amdgcn_cvt_pk_f32_fp8((int)w[u].x, false), a1 = __builtin_amdgcn_cvt_pk_f32_fp8((int)w[u].x, true), a2 = __builtin_amdgcn_cvt_pk_f32_fp8((int)w[u].y, false), a3 = __builtin_amdgcn_cvt_pk_f32_fp8((int)w[u].y, true);
                  sacc[0] += a0.x; sacc[1] += a0.y; sacc[2] += a1.x; sacc[3] += a1.y; sacc[4] += a2.x; sacc[5] += a2.y; sacc[6] += a3.x; sacc[7] += a3.y; } }
#pragma unroll
          for (int e = 0; e < 8; ++e) { sacc[e] += __shfl_xor(sacc[e], 16); sacc[e] += __shfl_xor(sacc[e], 32); }
          LAS float* kxp = kx + (wave >> 1) * 128 + c8;
          if (half == 1 && lane < 16) {
#pragma unroll
              for (int e = 0; e < 8; ++e) kxp[e] = sacc[e]; }
          __syncthreads();
          if (half == 0 && lane < 16) {
#pragma unroll
              for (int e = 0; e < 8; ++e) sacc[e] = (sacc[e] + kxp[e]) * ((float)(1 << att::KM_SHIFT) / 256.f);
              v2u o; o.x = pk_fp8x4(sacc[0], sacc[1], sacc[2], sacc[3]); o.y = pk_fp8x4(sacc[4], sacc[5], sacc[6], sacc[7]);
              *(v2u*)(KM + (size_t)blk * HD + c8) = o; } }
        {
            const int ch = VCU >> 1, hf = VCU & 1, R0 = ch * 128;
            LAS float* lng = (LAS float*)(lds + 81920); LAS float* lnb = lng + 512;
            lng[tid] = sgu_ln_g[hf * 512 + tid]; lnb[tid] = sgu_ln_b[hf * 512 + tid];
            v4u aa[4][8];
#pragma unroll
            for (int it4 = 0; it4 < 4; ++it4) { const v4u* vp = (const v4u*)(UV + (size_t)(R0 + wave * 16 + it4 * 4 + (lane >> 4)) * D + SGW) + (lane & 15);
#pragma unroll
                for (int q = 0; q < 8; ++q) aa[it4][q] = vp[16 * q]; }
#pragma unroll
            for (int it4 = 0; it4 < 4; ++it4) { const int j = wave * 16 + it4 * 4 + (lane >> 4);
                const v4u (&a)[8] = aa[it4];
                float s = 0.f;
#pragma unroll
                for (int q = 0; q < 8; ++q) s += ((bflo(a[q].x) + bfhi(a[q].x)) + (bflo(a[q].y) + bfhi(a[q].y))) + ((bflo(a[q].z) + bfhi(a[q].z)) + (bflo(a[q].w) + bfhi(a[q].w)));
#pragma unroll
                for (int o = 1; o < 16; o <<= 1) s += __shfl_xor(s, o);
                const float mean = s * (1.f / SGW); float qv = 0.f;
#pragma unroll
                for (int q = 0; q < 8; ++q) { float d;
                    d = bflo(a[q].x) - mean; qv += d * d; d = bfhi(a[q].x) - mean; qv += d * d; d = bflo(a[q].y) - mean; qv += d * d; d = bfhi(a[q].y) - mean; qv += d * d;
                    d = bflo(a[q].z) - mean; qv += d * d; d = bfhi(a[q].z) - mean; qv += d * d; d = bflo(a[q].w) - mean; qv += d * d; d = bfhi(a[q].w) - mean; qv += d * d; }
#pragma unroll
                for (int o = 1; o < 16; o <<= 1) qv += __shfl_xor(qv, o);
                if ((lane & 15) == 0) st[j] = (f32x2){mean, rsqrtf(qv * (1.f / SGW) + EPS)};
            }
            __syncthreads();
            for (int ps = 0; ps < 2; ++ps) {
                const int gp = hf * 2 + ps;
                { const int j = lane + 64 * (wave & 1), cb = 64 * (wave >> 1); const f32x2 ms = st[j];
                  v4u a[8];
#pragma unroll
                  for (int cq = 0; cq < 8; ++cq) a[cq] = *(const v4u*)(UV + (size_t)(R0 + j) * D + SGW + gp * 256 + cb + 8 * cq);
#pragma unroll
                  for (int cq = 0; cq < 8; ++cq) { const int c0 = cb + 8 * cq, chn = gp * 256 + c0;
                      const int cl_ = chn - hf * 512; const f32x4 g0 = *(const LAS f32x4*)(lng + cl_), g1 = *(const LAS f32x4*)(lng + cl_ + 4), b0 = *(const LAS f32x4*)(lnb + cl_), b1 = *(const LAS f32x4*)(lnb + cl_ + 4);
                      const float e[8] = {bflo(a[cq].x), bfhi(a[cq].x), bflo(a[cq].y), bfhi(a[cq].y), bflo(a[cq].z), bfhi(a[cq].z), bflo(a[cq].w), bfhi(a[cq].w)};
                      const float gg[8] = {g0[0], g0[1], g0[2], g0[3], g1[0], g1[1], g1[2], g1[3]}, bb[8] = {b0[0], b0[1], b0[2], b0[3], b1[0], b1[1], b1[2], b1[3]};
#pragma unroll
                      for (int i = 0; i < 8; ++i) vT[(c0 + i) * VP + j] = (bf16)f2bf((e[i] - ms.x) * ms.y * gg[i] + bb[i]); } }
                __syncthreads();
                { const int g = wave >> 2, ib = wave & 3, gg = gp * 2 + g, r32 = lane & 31, hi = lane >> 5; const int nks = 2 * (ib + 1);
                  const bf16* Wg = WSb + (size_t)gg * 16384 + (size_t)(ib * 32 + r32) * 128 + hi * 8;
                  f32x16 acc[4] = {};
                  const int tokr = R0 + ib * 32 + r32;
                  bf16x8 bwv[8]; v2u uu[4][4];
#pragma unroll
                  for (int ks = 0; ks < 8; ++ks) bwv[ks] = *(const bf16x8*)(Wg + (ks < nks ? ks : 0) * 16);
#pragma unroll
                  for (int db = 0; db < 4; ++db)
#pragma unroll
                      for (int q4 = 0; q4 < 4; ++q4) uu[db][q4] = *(const v2u*)(UV + (size_t)tokr * D + gg * 128 + db * 32 + 8 * q4 + 4 * hi);
                  __builtin_amdgcn_sched_barrier(0);
#pragma unroll
                  for (int ks = 0; ks < 8; ++ks) { if (ks >= nks) break;
                      const bf16x8 bw = bwv[ks];
#pragma unroll
                      for (int db = 0; db < 4; ++db) { const bf16x8 av = *(const LAS bf16x8*)(vT + (size_t)(g * 128 + db * 32 + r32) * VP + ks * 16 + hi * 8);
                          acc[db] = __builtin_amdgcn_mfma_f32_32x32x16_bf16(av, bw, acc[db], 0, 0, 0); }
                  }
                  const float bs = sgu_b_s[gg * 128 + ib * 32 + r32];
#pragma unroll
                  for (int db = 0; db < 4; ++db)
#pragma unroll
                      for (int q4 = 0; q4 < 4; ++q4) { const int d = db * 32 + 8 * q4 + 4 * hi;
                          const v2u u2 = uu[db][q4];
                          v2u w; w.x = cvt_pk_bf16(bflo(u2.x) * (acc[db][4 * q4 + 0] + bs), bfhi(u2.x) * (acc[db][4 * q4 + 1] + bs));
                          w.y = cvt_pk_bf16(bflo(u2.y) * (acc[db][4 * q4 + 2] + bs), bfhi(u2.y) * (acc[db][4 * q4 + 3] + bs));
                          *(v2u*)(SGUO + (size_t)tokr * SGW + gg * 128 + d) = w; } }
                __syncthreads();
            }
        }
    }
    GRID_BAR();
    }

    if ((BX & 1) == 0) { const int tid = ltid(wave0); conv_run(lds, tid, __builtin_amdgcn_readfirstlane(tid >> 6), tid & 63, NCONV_EARLY + VCU, NCONV); }
    {
        char* al = (char*)lds_raw;
        ArgsP A = kargs(); unsigned char* ws = A->ws; const int tid = ltid(wave0), lane = tid & 63, wave = __builtin_amdgcn_readfirstlane(tid >> 6); (void)lane; (void)wave;
        att::Seam S;
        att::moba_prime(att::make_ref(ws, VCU, 0), al, S, tid);
        constexpr int NBLK = 4 * ((((PROBE_DUP) >> 4) & 1) + 1);
        for (int k = 0; k < NBLK; ++k) att::moba_block(att::make_ref(ws, VCU, k & 3), att::make_ref(ws, VCU, (k + 1) & 3), al, S, tid);
    }
    if ((BX & 1) != 0) { asm volatile("s_waitcnt vmcnt(0)" ::: "memory"); __syncthreads(); const int tid = ltid(wave0); conv_run(lds, tid, __builtin_amdgcn_readfirstlane(tid >> 6), tid & 63, NCONV_EARLY + VCU, NCONV); }
    GRID_BAR();

    DUPLOOP(5) {
    {
        ArgsP A = kargs(); unsigned char* ws = A->ws; const int tid = ltid(wave0), lane = tid & 63, wave = __builtin_amdgcn_readfirstlane(tid >> 6); (void)lane; (void)wave;
        const bf16* SAg = WSP(bf16, WS_SA); const bf16* SBg = WSP(bf16, WS_SB); bf16* T1 = WSP(bf16, WS_Q); unsigned char* MERGED = ws + WS_MERGED;
        { pg8::StaticOrder S; S.init(T, D, SGW * 2, G, BX, ws + WS_WSO);
          pg8::EpiGateSeg E{SAg, SBg, T1, MERGED, 0};
          pg8::gemm_phase<false>(lds, (const char*)(ws + WS_SGUO), SGW * 2, S, E, tid); }
        { pg8::StaticOrder S; S.init(T, D, D, G, BX, ws + WS_WMO8);
          pg8::EpiGateSeg E{SAg, SBg, T1, MERGED, 1};
          pg8::gemm_phase<true>(lds, (const char*)(ws + WS_O8), D, S, E, tid, att::O8_SHIFT); }
    }
    GRID_BAR();
    }

    DUPLOOP(6) {
    {
        ArgsP A = kargs(); unsigned char* ws = A->ws; const int tid = ltid(wave0), lane = tid & 63, wave = __builtin_amdgcn_readfirstlane(tid >> 6); (void)lane; (void)wave;
        const float* ada = WSP(float, WS_ADA); bf16* DELTA = WSP(bf16, WS_DELTA);
        pg8::StaticOrder S; S.init(T, D, D, G, BX, ws + WS_WOUT);
        pg8::EpiDelta E{ada + 4096, DELTA};
        pg8::gemm_phase<true>(lds, (const char*)(ws + WS_MERGED), D, S, E, tid, pg8::M8_SHIFT);
    }
    GRID_BAR();
    }

    DUPLOOP(10) {
    {
        ArgsP A = kargs(); unsigned char* ws = A->ws; const int tid = ltid(wave0), lane = tid & 63, wave = __builtin_amdgcn_readfirstlane(tid >> 6); (void)lane; (void)wave; gu32* ctl = (gu32*)(ws + WS_CTL);
        const float* g_ffn = A->in[14]; const float* b_rg = A->in[16]; const float* b_re = A->in[18]; const float* __restrict__ x = A->in[0]; const bf16* __restrict__ DELTA = WSP(bf16, WS_DELTA);
        const float* ada = WSP(float, WS_ADA); const bf16* __restrict__ RT = WSP(bf16, WS_RT); unsigned char* __restrict__ N28 = ws + WS_N2F8;
        int* tok_e = WSP(int, WS_TOKE); int* tok_p = WSP(int, WS_TOKP); float* tok_w = WSP(float, WS_TOKW); int* elist = WSP(int, WS_LIST);
        if (rep_ == 1) { ctl += 32768; tok_e = WSP(int, WS_K); tok_p = tok_e + 2 * T; tok_w = (float*)(tok_p + 2 * T); elist = (int*)(ws + WS_K + 8 * MiB); }
        LAS unsigned char* At = lds;
        LAS float* lgx = (LAS float*)(lds + TAB_OFF);
        const int row0 = VCU * 64, b = row0 >> 12;
        LAS float* tgs = (LAS float*)(lds + TAB_OFF + 12288); LAS float* tsh = tgs + D;
        for (int i = tid; i < D; i += NWAVES * 64) { tgs[i] = g_ffn[i] * (ada[b * 12288 + 8192 + i] + 1.0f); tsh[i] = ada[b * 12288 + 6144 + i]; }
        __syncthreads();
        for (int ps = 0; ps < 2; ++ps) {
            { const LAS f32x4* gp = (const LAS f32x4*)tgs + lane; const LAS f32x4* shp = (const LAS f32x4*)tsh + lane;
#pragma unroll
              for (int rp = 0; rp < 2; ++rp) {
                  f32x4 v[2][8]; v2u dl[2][8];
#pragma unroll
                  for (int q = 0; q < 2; ++q) { const int row = row0 + ps * 32 + wave * 4 + rp * 2 + q;
#pragma unroll
                      for (int j = 0; j < 8; ++j) { v[q][j] = *((const f32x4*)(x + (size_t)row * D) + lane + 64 * j); dl[q][j] = *((const v2u*)(DELTA + (size_t)row * D) + lane + 64 * j); } }
#pragma unroll
                  for (int q = 0; q < 2; ++q) { const int rl = wave * 4 + rp * 2 + q, row = row0 + ps * 32 + rl; float ss = 0.f;
#pragma unroll
                      for (int j = 0; j < 8; ++j) { v[q][j] += (f32x4){bflo(dl[q][j].x), bfhi(dl[q][j].x), bflo(dl[q][j].y), bfhi(dl[q][j].y)};
                          ss += (v[q][j].x * v[q][j].x + v[q][j].y * v[q][j].y) + (v[q][j].z * v[q][j].z + v[q][j].w * v[q][j].w); }
                      const float rstd = rsqrtf(wave_sum(ss) * (1.f / D) + EPS);
#pragma unroll
                      for (int j = 0; j < 8; ++j) { const f32x4 y = v[q][j] * rstd * gp[64 * j] + shp[64 * j];
                          *((unsigned*)(N28 + (size_t)row * D) + lane + 64 * j) = pk_fp8x4(y.x, y.y, y.z, y.w);
                          v2u w; w.x = cvt_pk_bf16(y.x, y.y); w.y = cvt_pk_bf16(y.z, y.w);
                          *(LAS v2u*)(At + rl * 4096 + ((((lane >> 1) + 32 * j) ^ (rl & 15)) << 4) + ((lane & 1) << 3)) = w; } } } }
            __syncthreads();
            { const int i = lane & 15, kq = lane >> 4;
                f32x4 acc[2][3];
#pragma unroll
                for (int mt = 0; mt < 2; ++mt)
#pragma unroll
                    for (int nt = 0; nt < 3; ++nt) acc[mt][nt] = (f32x4){0.f, 0.f, 0.f, 0.f};
                unsigned voff = (unsigned)((wave * 8) * (2 * 48 * 32) + i * 32 + 8 * kq) * 2u;
#pragma unroll 1
                for (int ks = 0; ks < 8; ++ks, voff += 6144u) { const int kg = wave * 8 + ks;
                    bf16x8 wh[3], wl[3];
                    const char* ph = (const char*)RT + voff; const char* pl = ph + 3072;
#pragma unroll
                    for (int nt = 0; nt < 3; ++nt) { wh[nt] = *(const bf16x8*)(ph + nt * 1024); wl[nt] = *(const bf16x8*)(pl + nt * 1024); }
#pragma unroll
                    for (int mt = 0; mt < 2; ++mt) { const bf16x8 af = *(const LAS bf16x8*)(At + (16 * mt + i) * 4096 + (((4 * kg + kq) ^ i) << 4));
#pragma unroll
                        for (int nt = 0; nt < 3; ++nt) { acc[mt][nt] = __builtin_amdgcn_mfma_f32_16x16x32_bf16(af, wh[nt], acc[mt][nt], 0, 0, 0); acc[mt][nt] = __builtin_amdgcn_mfma_f32_16x16x32_bf16(af, wl[nt], acc[mt][nt], 0, 0, 0); } } }
                __syncthreads();
                LAS float* part = (LAS float*)At + wave * 1536;
#pragma unroll
                for (int mt = 0; mt < 2; ++mt)
#pragma unroll
                    for (int nt = 0; nt < 3; ++nt)
#pragma unroll
                        for (int e = 0; e < 4; ++e) part[(16 * mt + 4 * kq + e) * 48 + nt * 16 + i] = acc[mt][nt][e];
                __syncthreads();
#pragma unroll
                for (int q = 0; q < 3; ++q) { const int idx = tid + 512 * q; float sum = 0.f;
#pragma unroll
                    for (int w8 = 0; w8 < 8; ++w8) sum += ((const LAS float*)At)[w8 * 1536 + idx];
                    lgx[ps * 1536 + idx] = sum; }
                __syncthreads(); }
        }
        if (wave == 7) {
            const LAS float* l = lgx + lane * 48; const int tokn = row0 + lane;
            float gl[4]; int gs = 0; float gmax;
#pragma unroll
            for (int q = 0; q < 4; ++q) gl[q] = l[q] + b_rg[q];
            gmax = gl[0];
#pragma unroll
            for (int q = 1; q < 4; ++q) if (gl[q] > gmax) { gmax = gl[q]; gs = q; }
            float den = 0.f;
#pragma unroll
            for (int q = 0; q < 4; ++q) den += __expf(gl[q] - gmax);
            const float pg = 1.0f / den;
            float v0 = -3.0e38f, v1 = -3.0e38f; int i0 = 0, i1 = 0;
#pragma unroll
            for (int q = 0; q < 8; ++q) { const float ev = l[4 + gs * 8 + q] + b_re[gs * 8 + q];
                if (ev > v0) { v1 = v0; i1 = i0; v0 = ev; i0 = q; } else if (ev > v1) { v1 = ev; i1 = q; } }
            const float t = __expf(v1 - v0), w0 = pg / (1.0f + t), w1 = pg * t / (1.0f + t);
            const int e0 = gs * 8 + i0, e1 = gs * 8 + i1;
            const int p0 = (int)__hip_atomic_fetch_add(ctl + CW_CNT + 64 * e0, 1u, RLX_AGENT);
            const int p1 = (int)__hip_atomic_fetch_add(ctl + CW_CNT + 64 * e1, 1u, RLX_AGENT);
            elist[e0 * LCAP + p0] = tokn; elist[e1 * LCAP + p1] = tokn;
            tok_e[2 * tokn] = e0; tok_e[2 * tokn + 1] = e1; tok_p[2 * tokn] = p0; tok_p[2 * tokn + 1] = p1; tok_w[2 * tokn] = w0; tok_w[2 * tokn + 1] = w1;
        }
    }
    GRID_BAR();
    }

    LAS int* bstart = (LAS int*)(lds + TAB_OFF); LAS int* cntl = (LAS int*)(lds + TAB_OFF + 256);
    { const int t = ltid(wave0);
      if (t < 64) { gu32* ctl = (gu32*)(kargs()->ws + WS_CTL);
          const int c = (t < NEXP) ? (int)__hip_atomic_load(ctl + CW_CNT + 64 * (t & 31), RLX_AGENT) : 0, nb = (c + 255) >> 8;
          int incl = nb;
#pragma unroll
          for (int o = 1; o < 32; o <<= 1) { const int v = __shfl_up(incl, o); if (t >= o) incl += v; }
          if (t < NEXP) { cntl[t] = c; bstart[t] = incl - nb; if (t == NEXP - 1) bstart[NEXP] = incl; } } }
    __syncthreads();
    const int RB = bstart[NEXP];
    DUPLOOP(7) {
        ArgsP A = kargs(); unsigned char* ws = A->ws; const int tid = ltid(wave0), lane = tid & 63, wave = __builtin_amdgcn_readfirstlane(tid >> 6); (void)lane; (void)wave;
        const int* elist = WSP(int, WS_LIST);
        pg8::MoeSched S{bstart, cntl, elist, 4, RB * 4, G, BX, D / 128, (const char*)(ws + WS_WGU8), (size_t)1024 * D, (size_t)256 * D, true};
        pg8::EpiSwiGLU E{ws + WS_HID8};
        pg8::gemm_phase<true>(lds, (const char*)(ws + WS_N2F8), D, S, E, tid);
        GRID_BAR();
    }
    DUPLOOP(8) {
        ArgsP A = kargs(); unsigned char* ws = A->ws; const int tid = ltid(wave0), lane = tid & 63, wave = __builtin_amdgcn_readfirstlane(tid >> 6); (void)lane; (void)wave;
        const int* elist = WSP(int, WS_LIST);
        pg8::MoeSched S{bstart, cntl, elist, 8, RB * 8, G, BX, DFF / 128, (const char*)(ws + WS_WD8), (size_t)D * DFF, (size_t)256 * DFF, false};
        pg8::EpiStoreF8 E{ws + WS_YROW};
        pg8::gemm_phase<true>(lds, (const char*)(ws + WS_HID8), DFF, S, E, tid);
        GRID_BAR();
    }

    DUPLOOP(9)
    {
        ArgsP A = kargs(); unsigned char* ws = A->ws; const int tid = ltid(wave0), lane = tid & 63, wave = __builtin_amdgcn_readfirstlane(tid >> 6); (void)lane; (void)wave;
        float* out = A->out; const float* x = A->in[0]; const bf16* DELTA = WSP(bf16, WS_DELTA); const float* g_fin = A->in[22]; const float* ada = WSP(float, WS_ADA); const unsigned char* YROW = ws + WS_YROW;
        const int* tok_e = WSP(int, WS_TOKE); const int* tok_p = WSP(int, WS_TOKP); const float* tok_w = WSP(float, WS_TOKW);
        const bool poison = __hip_atomic_load((gu32*)(ws + WS_CTL) + CW_BAR + XB_TMO, RLX_AGENT) != 0u;
        LAS float* tgf = (LAS float*)lds; LAS float* tgn = tgf + D;
        { const int b0 = (VCU * NWAVES * 8) >> 12; for (int i = tid; i < D; i += NWAVES * 64) { tgf[i] = ada[(size_t)b0 * 12288 + 10240 + i]; tgn[i] = g_fin[i]; } }
        __syncthreads();
        for (int rr = 0; rr < 8; ++rr) {
            const int row = (VCU * NWAVES + wave) * 8 + rr;
            const int e0 = tok_e[2 * row], e1 = tok_e[2 * row + 1];
            const size_t s0 = (size_t)(bstart[e0] * 256 + tok_p[2 * row]), s1 = (size_t)(bstart[e1] * 256 + tok_p[2 * row + 1]);
            const float w0 = tok_w[2 * row] * (1.0f / (float)(1 << pg8::Y8_SHIFT)), w1 = tok_w[2 * row + 1] * (1.0f / (float)(1 << pg8::Y8_SHIFT));
            f32x4* hr = (f32x4*)(out + (size_t)row * D) + lane; const f32x4* xr = (const f32x4*)(x + (size_t)row * D) + lane; const v2u* dr = (const v2u*)(DELTA + (size_t)row * D) + lane;
            const unsigned* y0 = (const unsigned*)(YROW + s0 * D) + lane; const unsigned* y1 = (const unsigned*)(YROW + s1 * D) + lane;
            const LAS f32x4* gf = (const LAS f32x4*)tgf + lane;
            f32x4 v[8]; float ss = 0.f;
#pragma unroll
            for (int j = 0; j < 8; ++j) { const v2u dl = dr[64 * j]; const f32x4 hv = xr[64 * j] + (f32x4){bflo(dl.x), bfhi(dl.x), bflo(dl.y), bfhi(dl.y)}, gg = gf[64 * j]; const unsigned a = y0[64 * j], c = y1[64 * j];
                const f32x2 a0 = __builtin_amdgcn_cvt_pk_f32_fp8((int)a, false), a1 = __builtin_amdgcn_cvt_pk_f32_fp8((int)a, true), c0 = __builtin_amdgcn_cvt_pk_f32_fp8((int)c, false), c1 = __builtin_amdgcn_cvt_pk_f32_fp8((int)c, true);
                f32x4 y; y.x = w0 * a0.x + w1 * c0.x; y.y = w0 * a0.y + w1 * c0.y; y.z = w0 * a1.x + w1 * c1.x; y.w = w0 * a1.y + w1 * c1.y;
                v[j] = hv + gg * y; ss += (v[j].x * v[j].x + v[j].y * v[j].y) + (v[j].z * v[j].z + v[j].w * v[j].w); }
            const float rstd = rsqrtf(wave_sum(ss) * (1.f / D) + EPS);
#pragma unroll
            for (int j = 0; j < 8; ++j) { const f32x4 gg = *((const LAS f32x4*)tgn + lane + 64 * j); hr[64 * j] = poison ? (f32x4){__builtin_nanf(""), __builtin_nanf(""), __builtin_nanf(""), __builtin_nanf("")} : v[j] * rstd * gg; }
        }
    }
}

extern "C" void kernel_launch(void* const* d_in, const int* in_sizes, int n_in, void* d_out, int out_size, void* d_ws, size_t ws_size, hipStream_t stream) {
    static int grid = 0;
    if (grid == 0) {
        if (n_in != 23 || in_sizes[0] != T * D || out_size != T * D || ws_size < WS_END) { fprintf(stderr, "kernel_launch: unexpected shapes (n_in %d, out %d, ws %zu)\n", n_in, out_size, ws_size); grid = -1; return; }
        int dev = 0, cus = 0, per_cu = 0;
        if (hipGetDevice(&dev) != hipSuccess || hipDeviceGetAttribute(&cus, hipDeviceAttributeMultiprocessorCount, dev) != hipSuccess) { grid = -1; return; }
        if (hipFuncSetAttribute((const void*)fwd_kernel, hipFuncAttributeMaxDynamicSharedMemorySize, LDS_BYTES) != hipSuccess) { fprintf(stderr, "kernel_launch: hipFuncSetAttribute failed\n"); grid = -1; return; }
        if (hipOccupancyMaxActiveBlocksPerMultiprocessor(&per_cu, (const void*)fwd_kernel, NWAVES * 64, LDS_BYTES) != hipSuccess || per_cu < 1) fprintf(stderr, "kernel_launch: occupancy query reports %d\n", per_cu);
        (void)hipGetLastError();
        grid = cus;
        if (grid != 256) { fprintf(stderr, "kernel_launch: this kernel is built for 256 CUs, got %d\n", grid); grid = -1; return; }
    }
    if (grid < 0) return;
    (void)hipMemsetAsync((char*)d_ws + WS_CTL, 0, CTL_ZERO_BYTES, stream);
    Args a{};
    for (int i = 0; i < 23; ++i) a.in[i] = (const float*)d_in[i];
    a.out = (float*)d_out; a.ws = (unsigned char*)d_ws;
    hipLaunchKernelGGL(fwd_kernel, dim3(grid), dim3(NWAVES * 64), LDS_BYTES, stream, a);
}
```

```cpp
#include <hip/hip_runtime.h>
#include <cstdio>
#include <cstdint>

#define GAS __attribute__((address_space(1)))
#define LAS __attribute__((address_space(3)))
typedef unsigned short bf16;
typedef unsigned v4u __attribute__((ext_vector_type(4)));
typedef unsigned v2u __attribute__((ext_vector_type(2)));
typedef float f32x2 __attribute__((ext_vector_type(2)));
typedef float f32x4 __attribute__((ext_vector_type(4)));
typedef float f32x16 __attribute__((ext_vector_type(16)));
typedef short bf16x8 __attribute__((ext_vector_type(8)));
typedef short s16x4 __attribute__((ext_vector_type(4)));
typedef GAS unsigned gu32;
#define RLX_AGENT __ATOMIC_RELAXED, __HIP_MEMORY_SCOPE_AGENT
#define LDS_WAIT() asm volatile("s_waitcnt lgkmcnt(0)" ::: "memory")
#define VM_WAIT() asm volatile("s_waitcnt vmcnt(0)" ::: "memory")

constexpr int BATCH = 4, SEQ = 4096, T = BATCH * SEQ, D = 2048;
constexpr int SGW = 1024, NHEAD = 16, HD = 128, INC = 12288;
constexpr int NEXP = 32, DFF = 512, LCAP = 16384;
constexpr float EPS = 1e-6f;
constexpr int NWAVES = 8;
#ifndef PROBE_DUP
#define PROBE_DUP 0
#endif
#define DUPLOOP(k) for (int rep_ = 0; rep_ < (((PROBE_DUP) >> (k)) & 1) + 1; ++rep_)

constexpr size_t MiB = 1u << 20;
constexpr size_t WS_CTL = 0, CTL_ZERO_BYTES = 1 * MiB;
constexpr size_t WS_ADAP = 1 * MiB;
constexpr size_t WS_ADA = 1 * MiB + 786432;
constexpr size_t WS_COS = 2 * MiB, WS_SIN = 6 * MiB;
constexpr size_t WS_KM = 10 * MiB;
constexpr size_t WS_WS = 10 * MiB + 512 * 1024;
constexpr size_t WS_RT = 11 * MiB;
constexpr size_t WS_TOKE = 12 * MiB, WS_TOKP = WS_TOKE + 128 * 1024, WS_TOKW = WS_TOKP + 128 * 1024;
constexpr size_t WS_LIST = 13 * MiB;
constexpr size_t WS_WINZ = 16 * MiB;
constexpr size_t WS_WIN8 = 24 * MiB;
constexpr size_t WS_WSO = 48 * MiB;
constexpr size_t WS_WMO8 = 52 * MiB;
constexpr size_t WS_WOUT = 60 * MiB;
constexpr size_t WS_WGU8 = 68 * MiB;
constexpr size_t WS_WD8 = 132 * MiB;
constexpr size_t WS_N = 164 * MiB;
constexpr size_t WS_N1F8 = 228 * MiB;
constexpr size_t WS_UV = 260 * MiB;
constexpr size_t WS_Q = 324 * MiB, WS_K = 388 * MiB, WS_V = 452 * MiB;
constexpr size_t WS_SA = 516 * MiB, WS_SB = 580 * MiB;
constexpr size_t WS_END = 644 * MiB;
constexpr size_t WS_Q8 = WS_Q, WS_K8 = WS_K, WS_VT8 = WS_V;
constexpr size_t WS_SGUO = WS_N, WS_O8 = WS_N + 32 * MiB, WS_N2F8 = WS_UV, WS_MERGED = WS_UV, WS_HID8 = WS_N, WS_YROW = WS_Q, WS_DELTA = WS_SA;
constexpr int CW_BAR = 4096, CW_QUEUE = 8192, CW_CNT = 8192 + 64;

constexpr int RING_BYTES = 131072, LDSCTL_OFF = RING_BYTES, MISC_OFF = LDSCTL_OFF + 320, TAB_OFF = LDSCTL_OFF + 1024;
constexpr int LDS_BYTES = 163840;

__device__ __forceinline__ unsigned f2bf(float f) { unsigned u = __builtin_bit_cast(unsigned, f); return (u + 0x7fffu + ((u >> 16) & 1u)) >> 16; }
__device__ __forceinline__ unsigned pk2(float lo, float hi) { return f2bf(lo) | (f2bf(hi) << 16); }
typedef __bf16 bf16x2_t __attribute__((ext_vector_type(2)));
__device__ __forceinline__ unsigned cvt_pk_bf16(float lo, float hi) { f32x2 v = {lo, hi}; bf16x2_t b = __builtin_convertvector(v, bf16x2_t); return __builtin_bit_cast(unsigned, b); }
__device__ __forceinline__ unsigned pk_fp8x4(float a, float b, float c, float d) { unsigned w = 0u; w = __builtin_amdgcn_cvt_pk_fp8_f32(a, b, w, false); w = __builtin_amdgcn_cvt_pk_fp8_f32(c, d, w, true); return w; }
__device__ __forceinline__ float bflo(unsigned w) { return __builtin_bit_cast(float, w << 16); }
__device__ __forceinline__ float bfhi(unsigned w) { return __builtin_bit_cast(float, w & 0xffff0000u); }
__device__ __forceinline__ float wave_sum(float v) {
#pragma unroll
    for (int o = 1; o < 64; o <<= 1) v += __shfl_xor(v, o);
    return v;
}
__device__ __forceinline__ float fast_sigmoid(float x) { return __builtin_amdgcn_rcpf(1.0f + __builtin_amdgcn_exp2f(-1.4426950408889634f * x)); }
__device__ __forceinline__ float gelu_tanh(float x) { const float u = x * (1.0f + 0.044715f * x * x); return x * __builtin_amdgcn_rcpf(1.0f + __builtin_amdgcn_exp2f(-2.3022081985f * u)); }

#define XB_TMO      128
#define XB_XCNT(j)  (256  + 64 * (j))
#define XB_XSUB(j)  (1280 + 64 * (j))
#define XB_XGEN(j)  (2304 + 64 * (j))
#define XB_TOP      3328
#define XB_TOPGEN   3392
#define XCD_BAR_WORDS 3456
#define XB_SPIN_CAP (1u << 18)
__device__ __forceinline__ unsigned xb_ld(unsigned* p)              { return __hip_atomic_load(p, __ATOMIC_RELAXED, __HIP_MEMORY_SCOPE_AGENT); }
__device__ __forceinline__ unsigned xb_add(unsigned* p, unsigned v) { return __hip_atomic_fetch_add(p, v, __ATOMIC_RELAXED, __HIP_MEMORY_SCOPE_AGENT); }
__device__ __forceinline__ unsigned xb_xcc_id() { return (unsigned)__builtin_amdgcn_s_getreg((3 << 11) | 20) & 0xFu; }
#define XB_SPIN(cond, bar) do { unsigned _sp = 0; while (cond) { __builtin_amdgcn_s_sleep(1); \
    if ((++_sp & 255u) == 0u) { if (xb_ld(&(bar)[XB_TMO])) break; if (_sp > XB_SPIN_CAP) { atomicAdd(&(bar)[XB_TMO], 1u); break; } } } } while (0)
struct XcdBarrier { unsigned* bar; unsigned x; volatile LAS unsigned* st; };
__device__ __forceinline__ XcdBarrier xcd_barrier_post(unsigned* bar, volatile LAS unsigned* st, int tid) {
    XcdBarrier b; b.bar = bar; b.x = xb_xcc_id(); b.st = st;
    if (tid == 0) (void)xb_add(&bar[XB_XCNT(b.x)], 1u);
    return b;
}
__device__ __forceinline__ void xcd_barrier_complete(unsigned* bar, unsigned x, unsigned& nloc, unsigned& nx) {
    const unsigned G = gridDim.x * gridDim.y * gridDim.z;
    unsigned sum, cnt, mine, sp = 0u;
    for (;;) {
        sum = 0u; cnt = 0u; mine = 0u;
#pragma unroll
        for (unsigned j = 0; j < 16; ++j) { const unsigned c = xb_ld(&bar[XB_XCNT(j)]); sum += c; cnt += (c > 0u) ? 1u : 0u; mine = (j == x) ? c : mine; }
        if (sum == G) break;
        __builtin_amdgcn_s_sleep(1);
        if ((++sp & 255u) == 0u) { if (xb_ld(&bar[XB_TMO])) break; if (sp > XB_SPIN_CAP) { atomicAdd(&bar[XB_TMO], 1u); break; } }
    }
    nloc = mine > 0u ? mine : 1u; nx = cnt > 0u ? cnt : 1u;
}
__device__ __forceinline__ void xcd_barrier(const XcdBarrier& b, int tid) {
    asm volatile("s_waitcnt vmcnt(0)" ::: "memory");
    __syncthreads();
    if (tid == 0) {
        unsigned* bar = b.bar;
        __builtin_amdgcn_s_waitcnt(0);
        unsigned nloc = b.st[0], nx = b.st[1];
        if (nloc == 0u) { xcd_barrier_complete(bar, b.x, nloc, nx); b.st[0] = nloc; b.st[1] = nx; }
        const unsigned old = xb_add(&bar[XB_XSUB(b.x)], 1u);
        const unsigned gen = old / nloc;
        if (old + 1u == (gen + 1u) * nloc) {
            __builtin_amdgcn_fence(__ATOMIC_RELEASE, "agent");
            asm volatile("s_waitcnt vmcnt(0)" ::: "memory");
            const unsigned og = xb_add(&bar[XB_TOP], 1u);
            const unsigned tg = og / nx;
            if (og + 1u == (tg + 1u) * nx) xb_add(&bar[XB_TOPGEN], 1u);
            else XB_SPIN(xb_ld(&bar[XB_TOPGEN]) == tg, bar);
            __builtin_amdgcn_fence(__ATOMIC_ACQUIRE, "agent");
            xb_add(&bar[XB_XGEN(b.x)], 1u);
            asm volatile("s_waitcnt vmcnt(0)" ::: "memory");
        } else {
            XB_SPIN(xb_ld(&bar[XB_XGEN(b.x)]) == gen, bar);
            __builtin_amdgcn_fence(__ATOMIC_ACQUIRE, "agent");
            asm volatile("s_waitcnt vmcnt(0)" ::: "memory");
        }
    }
    __syncthreads();
}

namespace pg8 {
constexpr int BM = 256, BK = 64, HALF = 128, HTB = HALF * BK * 2, STAGE_BYTES = 8 * HTB, NXCD = 8, WGM = 4;
__device__ __forceinline__ int lds_byte(int r, int c) { const int st = (r >> 4) * 2 + (c >> 5), rr = r & 15, cc = c & 31, ob = rr * 64 + cc * 2; return st * 1024 + (ob ^ (((ob >> 9) & 1) << 5)); }
__device__ __forceinline__ void stage_rc(int b, int& R, int& C) { const int st = b / 1024, sb = b % 1024, swz = sb ^ (((sb >> 9) & 1) << 5); R = (st >> 1) * 16 + swz / 64; C = (st & 1) * 32 + (swz % 64) / 2; }
__device__ __forceinline__ int perm32(int rho) { const int n = rho >> 4, i = rho & 15; return 8 * (i >> 2) + 4 * n + (i & 3); }
typedef int v8i __attribute__((ext_vector_type(8)));
typedef int v4i __attribute__((ext_vector_type(4)));
constexpr int M8_SHIFT = 4;
constexpr int W8_SHIFT = 5;
__device__ __forceinline__ v8i cat8(bf16x8 lo, bf16x8 hi) { const v4i a = __builtin_bit_cast(v4i, lo), b = __builtin_bit_cast(v4i, hi); return __builtin_shufflevector(a, b, 0, 1, 2, 3, 4, 5, 6, 7); }
struct Unit { int pm, pn, ex, kt0, nkt; };

struct StaticOrder {
    int nM, nN, nwg, G, c, nkt; const char* Bt; size_t tstepB;
    __device__ __forceinline__ void init(int M, int N, int rowbytes, int G_, int c_, const void* Bt_) { nM = M / BM; nN = N / BM; nwg = nM * nN; G = G_; c = c_; Bt = (const char*)Bt_; tstepB = (size_t)BM * rowbytes; nkt = rowbytes / 128; }
    __device__ __forceinline__ bool next(int i, Unit& u) const {
        const long L = (long)i * G + c; if (L >= nwg) return false;
        int wgid = (int)L; { const int q = nwg / NXCD, r = nwg % NXCD, xcd = wgid % NXCD, off = wgid / NXCD; wgid = (xcd < r ? xcd * (q + 1) : r * (q + 1) + (xcd - r) * q) + off; }
        const int nig = WGM * nN, gid = wgid / nig, fm = gid * WGM, gsz = (nM - fm) < WGM ? (nM - fm) : WGM;
        u.pm = fm + ((wgid % nig) % gsz); u.pn = (wgid % nig) / gsz; u.ex = 0; u.kt0 = 0; u.nkt = nkt; return true;
    }
    __device__ __forceinline__ const char* b_ptr(const Unit& u) const { return Bt + (size_t)u.pn * tstepB; }
    __device__ __forceinline__ unsigned a_row(const Unit& u, int r) const { return (unsigned)(u.pm * BM + r); }
};

template <bool F8, class Epi, class Sched>
__device__ __forceinline__ void gemm_phase(LAS unsigned char* lds, const char* Ab, const int rowbytes, const Sched& S, const Epi& E, const int tid, const int a8shift = 0) {
    const int wid = __builtin_amdgcn_readfirstlane(tid >> 6), lane = tid & 63, wr = wid >> 2, wc = wid & 3, fr = lane & 15, fq = lane >> 4;
    int Rs[2]; unsigned Cs[2], voffB[2];
#pragma unroll
    for (int i = 0; i < 2; ++i) { int R, C; stage_rc(tid * 16 + i * 8192, R, C); const int Rb = Epi::PERM ? ((R & ~31) + perm32(R & 31)) : R;
        Rs[i] = R; Cs[i] = (unsigned)C * 2u; voffB[i] = (unsigned)(Rb * rowbytes + C * 2); }
    const size_t kstep = (size_t)(BK * 2);
    const size_t hstep = (size_t)HALF * rowbytes;
    const unsigned rowb = (unsigned)rowbytes;
    const unsigned ldsw = (unsigned)wid * 1024u;
    const int aoff = lds_byte(wr * 64 + fr, fq * 8), boff = lds_byte(wc * 32 + fr, fq * 8);
#define PG8_SA(b, h) (((b) * 2 + (h)) * HTB)
#define PG8_SB(b, h) ((4 + (b) * 2 + (h)) * HTB)
#define PG8_STAGE_B(bufoff, gbase) do { _Pragma("unroll") for (int _i = 0; _i < 2; ++_i) \
        __builtin_amdgcn_global_load_lds((const unsigned*)((const char*)(gbase) + voffB[_i]), (LAS unsigned*)(lds + (bufoff) + ldsw + _i * 8192), 16, 0, 0); } while (0)
#define PG8_STAGE_A(bufoff, kbyte, h) do { _Pragma("unroll") for (int _i = 0; _i < 2; ++_i) \
        __builtin_amdgcn_global_load_lds((const unsigned*)(Ab + (kbyte) + vC[h][_i]), (LAS unsigned*)(lds + (bufoff) + ldsw + _i * 8192), 16, 0, 0); } while (0)
#define PG8_LDA(dst, b, h) do { _Pragma("unroll") for (int m = 0; m < 4; ++m) _Pragma("unroll") for (int k = 0; k < 2; ++k) dst[m][k] = *(const LAS bf16x8*)(lds + PG8_SA(b, h) + aoff + m * 2048 + k * 1024); } while (0)
#define PG8_LDB(dst, b, h) do { _Pragma("unroll") for (int n = 0; n < 2; ++n) _Pragma("unroll") for (int k = 0; k < 2; ++k) dst[n][k] = *(const LAS bf16x8*)(lds + PG8_SB(b, h) + boff + n * 2048 + k * 1024); } while (0)
#define PG8_MMA(ai, bj, At, Bt) do { __builtin_amdgcn_s_setprio(1); _Pragma("unroll") for (int m = 0; m < 4; ++m) _Pragma("unroll") for (int n = 0; n < 2; ++n) { \
        if constexpr (F8) acc[ai][bj][m][n] = __builtin_amdgcn_mfma_scale_f32_16x16x128_f8f6f4(cat8(Bt[n][0], Bt[n][1]), cat8(At[m][0], At[m][1]), acc[ai][bj][m][n], 0, 0, 0, 127 - W8_SHIFT, 0, 127 - a8shift); \
        else { _Pragma("unroll") for (int k = 0; k < 2; ++k) acc[ai][bj][m][n] = __builtin_amdgcn_mfma_f32_16x16x32_bf16(Bt[n][k], At[m][k], acc[ai][bj][m][n], 0, 0, 0); } } __builtin_amdgcn_s_setprio(0); } while (0)
#define PG8_WAIT_V(n) asm volatile("s_waitcnt vmcnt(" #n ")" ::: "memory")
#define PG8_WAIT_L(n) asm volatile("s_waitcnt lgkmcnt(" #n ")" ::: "memory")
#define PG8_BAR __builtin_amdgcn_s_barrier()
#define PG8_SCHED __builtin_amdgcn_sched_barrier(0)
    Unit cur, nxt; int ui = 0;
    if (!S.next(0, cur)) return;
    f32x4 acc[2][2][4][2];
#pragma unroll
    for (int a = 0; a < 2; ++a)
#pragma unroll
        for (int b = 0; b < 2; ++b)
#pragma unroll
            for (int m = 0; m < 4; ++m)
#pragma unroll
                for (int n = 0; n < 2; ++n) acc[a][b][m][n] = (f32x4){0.f, 0.f, 0.f, 0.f};
    bf16x8 At[4][2], B0[2][2], B1[2][2];
    unsigned vC[2][2], vN[2][2];
#pragma unroll
    for (int h = 0; h < 2; ++h)
#pragma unroll
        for (int i = 0; i < 2; ++i) vC[h][i] = S.a_row(cur, h * HALF + Rs[i]) * rowb + Cs[i];
    const char* cB = S.b_ptr(cur) + (size_t)cur.kt0 * kstep; size_t kc = (size_t)cur.kt0 * kstep; int nt = cur.nkt;
    PG8_STAGE_B(PG8_SB(0, 0), cB); PG8_STAGE_B(PG8_SB(0, 1), cB + hstep); PG8_STAGE_A(PG8_SA(0, 0), kc, 0); PG8_STAGE_A(PG8_SA(0, 1), kc, 1);
    if (wr == 1) PG8_BAR;
    PG8_WAIT_V(2); PG8_BAR;
    PG8_STAGE_B(PG8_SB(1, 0), cB + kstep); PG8_STAGE_A(PG8_SA(1, 0), kc + kstep, 0); PG8_STAGE_B(PG8_SB(1, 1), cB + hstep + kstep);
    PG8_WAIT_V(6); PG8_BAR;
    for (;;) {
        const bool has_next = S.next(ui + 1, nxt);
        const char* nB = has_next ? S.b_ptr(nxt) + (size_t)nxt.kt0 * kstep : cB; const size_t kn = has_next ? (size_t)nxt.kt0 * kstep : kc;
#pragma unroll
        for (int h = 0; h < 2; ++h)
#pragma unroll
            for (int i = 0; i < 2; ++i) vN[h][i] = has_next ? (S.a_row(nxt, h * HALF + Rs[i]) * rowb + Cs[i]) : vC[h][i];
        for (int t = 0; t < nt; t += 2) {
            const bool last = (t == nt - 2);
            const size_t ka1 = kc + (size_t)(t + 1) * kstep;
            const size_t ka2 = last ? kn : kc + (size_t)(t + 2) * kstep;
            const char* b2 = last ? nB : cB + (size_t)(t + 2) * kstep; const char* b3 = b2 + kstep;
            PG8_LDB(B0, 0, 0); PG8_LDB(B1, 0, 1); PG8_SCHED; PG8_LDA(At, 0, 0); PG8_STAGE_A(PG8_SA(1, 1), ka1, 1);
            if (last) {
#pragma unroll
                for (int h = 0; h < 2; ++h)
#pragma unroll
                    for (int i = 0; i < 2; ++i) vC[h][i] = vN[h][i];
            }
            PG8_WAIT_V(8); PG8_WAIT_L(0); PG8_BAR; PG8_MMA(0, 0, At, B0); PG8_MMA(0, 1, At, B1); PG8_BAR; PG8_SCHED;
            PG8_LDA(At, 0, 1); PG8_STAGE_B(PG8_SB(0, 0), b2); PG8_STAGE_B(PG8_SB(0, 1), b2 + hstep); PG8_STAGE_A(PG8_SA(0, 0), ka2, 0);
            PG8_WAIT_V(8); PG8_WAIT_L(0); PG8_BAR; PG8_MMA(1, 0, At, B0); PG8_MMA(1, 1, At, B1); PG8_BAR; PG8_SCHED;
            PG8_LDB(B0, 1, 0); PG8_LDB(B1, 1, 1); PG8_SCHED; PG8_LDA(At, 1, 0); PG8_STAGE_A(PG8_SA(0, 1), ka2, 1);
            PG8_WAIT_V(8); PG8_WAIT_L(0); PG8_BAR; PG8_MMA(0, 0, At, B0); PG8_MMA(0, 1, At, B1); PG8_BAR; PG8_SCHED;
            PG8_LDA(At, 1, 1); PG8_STAGE_B(PG8_SB(1, 0), b3); PG8_STAGE_B(PG8_SB(1, 1), b3 + hstep); PG8_STAGE_A(PG8_SA(1, 0), ka2 + kstep, 0);
            PG8_WAIT_V(8); PG8_WAIT_L(0); PG8_BAR; PG8_MMA(1, 0, At, B0); PG8_MMA(1, 1, At, B1); PG8_BAR; PG8_SCHED;
        }
        if (wr == 0) PG8_BAR;
        E(acc, cur, wr, wc, fr, fq);
        if (!has_next) break;
#pragma unroll
        for (int a = 0; a < 2; ++a)
#pragma unroll
            for (int b = 0; b < 2; ++b)
#pragma unroll
                for (int m = 0; m < 4; ++m)
#pragma unroll
                    for (int n = 0; n < 2; ++n) acc[a][b][m][n] = (f32x4){0.f, 0.f, 0.f, 0.f};
        cur = nxt; cB = nB; kc = kn; nt = cur.nkt; ++ui;
        if (wr == 1) PG8_BAR;
    }
    PG8_WAIT_V(0);
    PG8_BAR;
#undef PG8_SA
#undef PG8_SB
#undef PG8_STAGE_A
#undef PG8_STAGE_B
#undef PG8_LDA
#undef PG8_LDB
#undef PG8_MMA
#undef PG8_WAIT_V
#undef PG8_WAIT_L
#undef PG8_BAR
#undef PG8_SCHED
}

typedef const f32x4 (&AccRef)[2][2][4][2];

struct EpiInProj {
    static constexpr bool PERM = true;
    bf16* UV; unsigned char* Q8; unsigned char* K8; unsigned char* VT8; bf16* SA; bf16* SB; const float* cosT; const float* sinT; int pn_off;
    __device__ __forceinline__ void operator()(AccRef acc, const Unit& u, int wr, int wc, int fr, int fq) const {
        asm volatile("" : "+v"(fr), "+v"(fq));
        const int pn = u.pn + pn_off, rbase = u.pm * BM + wr * 64 + fr, cl = wc * 32 + 8 * fq;
        if (pn < 8) {
#pragma unroll
            for (int ai = 0; ai < 2; ++ai)
#pragma unroll
                for (int m = 0; m < 4; ++m) { bf16* rp = UV + (size_t)(rbase + ai * HALF + m * 16) * D + pn * BM + cl;
#pragma unroll
                    for (int bj = 0; bj < 2; ++bj) { const f32x4 a = acc[ai][bj][m][0], b = acc[ai][bj][m][1];
                        v4u w; w.x = cvt_pk_bf16(gelu_tanh(a[0]), gelu_tanh(a[1])); w.y = cvt_pk_bf16(gelu_tanh(a[2]), gelu_tanh(a[3]));
                        w.z = cvt_pk_bf16(gelu_tanh(b[0]), gelu_tanh(b[1])); w.w = cvt_pk_bf16(gelu_tanh(b[2]), gelu_tanh(b[3]));
                        *(v4u*)(rp + bj * HALF) = w; } }
        } else if (pn < 24) {
            unsigned char* dst = (pn < 16) ? Q8 : K8; const int hp = ((pn - 8) & 7) * 2, j0 = cl >> 1;
#pragma unroll
            for (int ai = 0; ai < 2; ++ai) {
                f32x4 cc[4], sn[4];
#pragma unroll
                for (int m = 0; m < 4; ++m) { const int row = rbase + ai * HALF + m * 16; cc[m] = *(const f32x4*)(cosT + (size_t)row * 64 + j0); sn[m] = *(const f32x4*)(sinT + (size_t)row * 64 + j0); }
#pragma unroll
                for (int m = 0; m < 4; ++m) { const int row = rbase + ai * HALF + m * 16, b = row >> 12, s = row & 4095;
                    const f32x4 c4 = cc[m], s4 = sn[m];
#pragma unroll
                    for (int bj = 0; bj < 2; ++bj) { const f32x4 x0 = acc[ai][bj][m][0], x1 = acc[ai][bj][m][1];
                        v2u w;
                        w.x = pk_fp8x4(x0[0] * c4[0] - x0[1] * s4[0], x0[1] * c4[0] + x0[0] * s4[0], x0[2] * c4[1] - x0[3] * s4[1], x0[3] * c4[1] + x0[2] * s4[1]);
                        w.y = pk_fp8x4(x1[0] * c4[2] - x1[1] * s4[2], x1[1] * c4[2] + x1[0] * s4[2], x1[2] * c4[3] - x1[3] * s4[3], x1[3] * c4[3] + x1[2] * s4[3]);
                        *(v2u*)(dst + ((size_t)(b * NHEAD + hp + bj) * SEQ + s) * HD + cl) = w; } }
            }
        } else if (pn < 32) {
            const int hp = (pn - 24) * 2, lane = fr + 16 * fq, jq = lane & 3;
#pragma unroll
            for (int ai = 0; ai < 2; ++ai)
#pragma unroll
                for (int m = 0; m < 4; ++m) { const int row = rbase + ai * HALF + m * 16, b = row >> 12, s0 = (row & 4095) & ~3;
#pragma unroll
                    for (int bj = 0; bj < 2; ++bj) { const f32x4 a = acc[ai][bj][m][0], c = acc[ai][bj][m][1];
                        const unsigned w0 = pk_fp8x4(a[0], a[1], a[2], a[3]), w1 = pk_fp8x4(c[0], c[1], c[2], c[3]);
                        unsigned o0 = 0u, o1 = 0u;
#define VQ(q) { const unsigned t0 = (unsigned)__builtin_amdgcn_mov_dpp((int)w0, (q) * 0x55, 0xf, 0xf, true), t1 = (unsigned)__builtin_amdgcn_mov_dpp((int)w1, (q) * 0x55, 0xf, 0xf, true); \
                            o0 |= ((t0 >> (8 * jq)) & 0xffu) << (8 * (q)); o1 |= ((t1 >> (8 * jq)) & 0xffu) << (8 * (q)); }
                        VQ(0) VQ(1) VQ(2) VQ(3)
#undef VQ
                        unsigned char* vp = VT8 + ((size_t)(b * NHEAD + hp + bj) * HD + cl + jq) * SEQ + s0;
                        *(unsigned*)vp = o0; *(unsigned*)(vp + 4 * SEQ) = o1; } }
        } else {
            bf16* dst = (pn < 40) ? SA : SB; const int colt = ((pn - 32) & 7) * BM;
#pragma unroll
            for (int ai = 0; ai < 2; ++ai)
#pragma unroll
                for (int m = 0; m < 4; ++m) { bf16* rp = dst + (size_t)(rbase + ai * HALF + m * 16) * D + colt + cl;
#pragma unroll
                    for (int bj = 0; bj < 2; ++bj) { const f32x4 a = acc[ai][bj][m][0], b = acc[ai][bj][m][1];
                        v4u w; w.x = cvt_pk_bf16(fast_sigmoid(a[0]), fast_sigmoid(a[1])); w.y = cvt_pk_bf16(fast_sigmoid(a[2]), fast_sigmoid(a[3]));
                        w.z = cvt_pk_bf16(fast_sigmoid(b[0]), fast_sigmoid(b[1])); w.w = cvt_pk_bf16(fast_sigmoid(b[2]), fast_sigmoid(b[3]));
                        *(v4u*)(rp + bj * HALF) = w; } }
        }
    }
};
struct EpiGateSeg {
    static constexpr bool PERM = true;
    const bf16* SAg; const bf16* SBg; bf16* T1; unsigned char* Mg; int seg;
    __device__ __forceinline__ void operator()(AccRef acc, const Unit& u, int wr, int wc, int fr, int fq) const {
        const int rbase = u.pm * BM + wr * 64 + fr, col0 = u.pn * BM + wc * 32 + 8 * fq;
        if (seg == 0) {
#pragma unroll
            for (int ai = 0; ai < 2; ++ai) {
                v4u g[4][2];
#pragma unroll
                for (int m = 0; m < 4; ++m)
#pragma unroll
                    for (int bj = 0; bj < 2; ++bj) g[m][bj] = *(const v4u*)(SAg + (size_t)(rbase + ai * HALF + m * 16) * D + col0 + bj * HALF);
#pragma unroll
                for (int m = 0; m < 4; ++m) { const size_t off = (size_t)(rbase + ai * HALF + m * 16) * D + col0;
#pragma unroll
                    for (int bj = 0; bj < 2; ++bj) { const v4u gg = g[m][bj]; const f32x4 a = acc[ai][bj][m][0], b = acc[ai][bj][m][1];
                        v4u w; w.x = cvt_pk_bf16(bflo(gg.x) * a[0], bfhi(gg.x) * a[1]); w.y = cvt_pk_bf16(bflo(gg.y) * a[2], bfhi(gg.y) * a[3]);
                        w.z = cvt_pk_bf16(bflo(gg.z) * b[0], bfhi(gg.z) * b[1]); w.w = cvt_pk_bf16(bflo(gg.w) * b[2], bfhi(gg.w) * b[3]);
                        *(v4u*)(T1 + off + bj * HALF) = w; } }
            }
        } else {
#pragma unroll
            for (int ai = 0; ai < 2; ++ai)
#pragma unroll
                for (int mp = 0; mp < 2; ++mp) {
                    v4u tt[2][2], g[2][2];
#pragma unroll
                    for (int mm = 0; mm < 2; ++mm)
#pragma unroll
                        for (int bj = 0; bj < 2; ++bj) { const size_t off = (size_t)(rbase + ai * HALF + (2 * mp + mm) * 16) * D + col0 + bj * HALF; tt[mm][bj] = *(const v4u*)(T1 + off); g[mm][bj] = *(const v4u*)(SBg + off); }
#pragma unroll
                    for (int mm = 0; mm < 2; ++mm) { const int m = 2 * mp + mm; const size_t off = (size_t)(rbase + ai * HALF + m * 16) * D + col0;
#pragma unroll
                        for (int bj = 0; bj < 2; ++bj) { const v4u t = tt[mm][bj], gg = g[mm][bj]; const f32x4 a = acc[ai][bj][m][0], b = acc[ai][bj][m][1];
                            constexpr float MS = (float)(1 << M8_SHIFT);
                            v2u w; w.x = pk_fp8x4((bflo(t.x) + bflo(gg.x) * a[0]) * MS, (bfhi(t.x) + bfhi(gg.x) * a[1]) * MS, (bflo(t.y) + bflo(gg.y) * a[2]) * MS, (bfhi(t.y) + bfhi(gg.y) * a[3]) * MS);
                            w.y = pk_fp8x4((bflo(t.z) + bflo(gg.z) * b[0]) * MS, (bfhi(t.z) + bfhi(gg.z) * b[1]) * MS, (bflo(t.w) + bflo(gg.w) * b[2]) * MS, (bfhi(t.w) + bfhi(gg.w) * b[3]) * MS);
                            *(v2u*)(Mg + off + bj * HALF) = w; } }
                }
        }
    }
};
struct EpiDelta {
    static constexpr bool PERM = true;
    const float* gm; bf16* Dl;
    __device__ __forceinline__ void operator()(AccRef acc, const Unit& u, int wr, int wc, int fr, int fq) const {
        const int rbase = u.pm * BM + wr * 64 + fr, col0 = u.pn * BM + wc * 32 + 8 * fq, b = (u.pm * BM) >> 12;
        f32x4 gv[2][2];
#pragma unroll
        for (int bj = 0; bj < 2; ++bj)
#pragma unroll
            for (int n = 0; n < 2; ++n) gv[bj][n] = *(const f32x4*)(gm + (size_t)b * 12288 + col0 + bj * HALF + 4 * n);
#pragma unroll
        for (int ai = 0; ai < 2; ++ai)
#pragma unroll
            for (int m = 0; m < 4; ++m) { bf16* rp = Dl + (size_t)(rbase + ai * HALF + m * 16) * D + col0;
#pragma unroll
                for (int bj = 0; bj < 2; ++bj) { const f32x4 a = acc[ai][bj][m][0] * gv[bj][0], c = acc[ai][bj][m][1] * gv[bj][1];
                    v4u w; w.x = cvt_pk_bf16(a[0], a[1]); w.y = cvt_pk_bf16(a[2], a[3]); w.z = cvt_pk_bf16(c[0], c[1]); w.w = cvt_pk_bf16(c[2], c[3]);
                    *(v4u*)(rp + bj * HALF) = w; } }
    }
};
struct MoeSched {
    const LAS int* bstart; const LAS int* cntl; const int* list; int npn, total, G, c, nkt; const char* Bt; size_t estride, tstepB; bool gather;
    __device__ __forceinline__ bool next(int i, Unit& u) const {
        const int L = i * G + c; if (L >= total) return false;
        const int rb = L / npn; int e = 0;
        for (int j = 1; j < NEXP; ++j) e += (bstart[j] <= rb) ? 1 : 0;
        u.pm = rb; u.pn = L - rb * npn; u.ex = e; u.kt0 = 0; u.nkt = nkt; return true;
    }
    __device__ __forceinline__ const char* b_ptr(const Unit& u) const { return Bt + (size_t)u.ex * estride + (size_t)u.pn * tstepB; }
    __device__ __forceinline__ unsigned a_row(const Unit& u, int r) const {
        if (!gather) return (unsigned)(u.pm * BM + r);
        const int pos = (u.pm - bstart[u.ex]) * BM + r;
        return (pos < cntl[u.ex]) ? (unsigned)list[u.ex * LCAP + pos] : 0u;
    }
};
struct EpiSwiGLU {
    static constexpr bool PERM = true;
    unsigned char* HID;
    __device__ __forceinline__ void operator()(AccRef acc, const Unit& u, int wr, int wc, int fr, int fq) const {
        const int rbase = u.pm * BM + wr * 64 + fr, hc0 = u.pn * 128 + wc * 16 + 4 * fq;
#pragma unroll
        for (int ai = 0; ai < 2; ++ai)
#pragma unroll
            for (int m = 0; m < 4; ++m) { unsigned char* rp = HID + (size_t)(rbase + ai * HALF + m * 16) * DFF + hc0;
#pragma unroll
                for (int bj = 0; bj < 2; ++bj) { const f32x4 g = acc[ai][bj][m][0], up = acc[ai][bj][m][1];
                    *(unsigned*)(rp + bj * 64) = pk_fp8x4(g[0] * fast_sigmoid(g[0]) * up[0], g[1] * fast_sigmoid(g[1]) * up[1], g[2] * fast_sigmoid(g[2]) * up[2], g[3] * fast_sigmoid(g[3]) * up[3]); } }
    }
};
constexpr int Y8_SHIFT = 4;
struct EpiStoreF8 {
    static constexpr bool PERM = true;
    unsigned char* Y;
    __device__ __forceinline__ void operator()(AccRef acc, const Unit& u, int wr, int wc, int fr, int fq) const {
        const int rbase = u.pm * BM + wr * 64 + fr, col0 = u.pn * BM + wc * 32 + 8 * fq;
        constexpr float YS = (float)(1 << Y8_SHIFT);
#pragma unroll
        for (int ai = 0; ai < 2; ++ai)
#pragma unroll
            for (int m = 0; m < 4; ++m) { unsigned char* rp = Y + (size_t)(rbase + ai * HALF + m * 16) * D + col0;
#pragma unroll
                for (int bj = 0; bj < 2; ++bj) { const f32x4 a = acc[ai][bj][m][0], b = acc[ai][bj][m][1];
                    v2u w; w.x = pk_fp8x4(a[0] * YS, a[1] * YS, a[2] * YS, a[3] * YS); w.y = pk_fp8x4(b[0] * YS, b[1] * YS, b[2] * YS, b[3] * YS);
                    *(v2u*)(rp + bj * HALF) = w; } }
    }
};
}

namespace att {
constexpr int NW = 8, QBLK = 32, KVBLK = 64, QB = 256, OP = 2048;
constexpr int KPITCH = 144, VPITCH = 144;
constexpr int SHM_K = 2 * KVBLK * KPITCH, SHM_V = HD * VPITCH;
constexpr int LDS_BYTES = 2 * SHM_V + 2 * SHM_K + NW * 64 * 4;
constexpr float SCALE = 0.08838834764831845f, THR = 4.f;
constexpr int O8_SHIFT = 4;
constexpr int KM_SHIFT = 4;
#define SBAR() __builtin_amdgcn_sched_barrier(0)
typedef pg8::v8i v8i; typedef pg8::v4i v4i;
__device__ __forceinline__ v8i cat32(v4i a, v4i b) { return __builtin_shufflevector(a, b, 0, 1, 2, 3, 4, 5, 6, 7); }
__device__ __forceinline__ v4i ld16(const unsigned char* p) { return *reinterpret_cast<const v4i*>(p); }
__device__ __forceinline__ f32x16 mma8(v8i a, v8i b, f32x16 c) { return __builtin_amdgcn_mfma_scale_f32_32x32x64_f8f6f4(a, b, c, 0, 0, 0, 127, 0, 127); }
__device__ __forceinline__ int crow(int r, int hi) { return (r & 3) + 8 * (r >> 2) + 4 * hi; }
__device__ __forceinline__ void mask_tile(f32x16& p0, f32x16& p1, int dq) {
    const float NEG = -__builtin_inff();
#pragma unroll
    for (int r = 0; r < 16; ++r) {
        const int c = (r & 3) + 8 * (r >> 2);
        if (dq - c < 0) p0[r] = NEG;
        if (dq - c - 32 < 0) p1[r] = NEG;
    }
}
__device__ __forceinline__ void partialSM(f32x16& p0, f32x16& p1, float& m_reg, float& mn, float& alpha, bool keep) {
    float pmax = p0[0];
#pragma unroll
    for (int r = 1; r < 16; ++r) pmax = fmaxf(pmax, p0[r]);
#pragma unroll
    for (int r = 0; r < 16; ++r) pmax = fmaxf(pmax, p1[r]);
    { auto rr = __builtin_amdgcn_permlane32_swap(__float_as_uint(pmax), __float_as_uint(pmax), false, false);
      pmax = fmaxf(__uint_as_float(rr[0]), __uint_as_float(rr[1])); }
    const float NEG = -__builtin_inff();
    pmax = keep ? pmax : NEG;
    constexpr float C2 = 1.4426950408889634f * SCALE;
    if (__builtin_expect(__all((pmax - m_reg) * SCALE <= THR), 1)) { mn = m_reg; alpha = 1.f; }
    else { mn = fmaxf(m_reg, pmax); alpha = __builtin_amdgcn_exp2f((m_reg - mn) * C2); m_reg = mn; }
    const float c2l = keep ? C2 : 0.f;
    const float mnL = keep ? -mn * C2 : NEG;
#pragma unroll
    for (int r = 0; r < 16; ++r) p0[r] = fmaf(p0[r], c2l, mnL);
#pragma unroll
    for (int r = 0; r < 16; ++r) p1[r] = fmaf(p1[r], c2l, mnL);
#pragma unroll
    for (int r = 0; r < 16; ++r) p0[r] = __builtin_amdgcn_exp2f(p0[r]);
}
__device__ __forceinline__ void finishSM(f32x16& p0, f32x16& p1, float alpha, float& l_reg, v8i& pf) {
#pragma unroll
    for (int r = 0; r < 16; ++r) p1[r] = __builtin_amdgcn_exp2f(p1[r]);
    float ps = 0;
#pragma unroll
    for (int r = 0; r < 16; ++r) ps += p0[r];
#pragma unroll
    for (int r = 0; r < 16; ++r) ps += p1[r];
    { auto rr = __builtin_amdgcn_permlane32_swap(__float_as_uint(ps), __float_as_uint(ps), false, false);
      ps = __uint_as_float(rr[0]) + __uint_as_float(rr[1]); }
    l_reg = l_reg * alpha + ps;
#pragma unroll
    for (int q = 0; q < 4; ++q) { pf[q] = (int)pk_fp8x4(p0[4 * q], p0[4 * q + 1], p0[4 * q + 2], p0[4 * q + 3]); pf[4 + q] = (int)pk_fp8x4(p1[4 * q], p1[4 * q + 1], p1[4 * q + 2], p1[4 * q + 3]); }
}
template <int SUB>
__device__ __forceinline__ void qkt(int KB, f32x16& p0, f32x16& p1, const unsigned char* K_lds, int r32, int hi, const v8i* qf) {
    p0 = f32x16{}; p1 = f32x16{};
    const unsigned char* kb = K_lds + KB * SHM_K + (SUB * KVBLK + r32) * KPITCH + hi * 32;
#pragma unroll
    for (int ks = 0; ks < 2; ++ks) {
        const v8i a0 = cat32(ld16(kb + ks * 64), ld16(kb + ks * 64 + 16)), a1 = cat32(ld16(kb + 32 * KPITCH + ks * 64), ld16(kb + 32 * KPITCH + ks * 64 + 16));
        p0 = mma8(a0, qf[ks], p0); p1 = mma8(a1, qf[ks], p1); }
}
template <int SUB>
__device__ __forceinline__ void pv_tile(int VB, f32x16* o, const unsigned char* V_lds, int r32, int hi, v8i pf) {
    const unsigned char* vb = V_lds + VB * SHM_V + r32 * VPITCH + SUB * KVBLK + hi * 32;
#pragma unroll
    for (int d0 = 0; d0 < 4; ++d0) { const v8i a = cat32(ld16(vb + d0 * 32 * VPITCH), ld16(vb + d0 * 32 * VPITCH + 16)); o[d0] = mma8(a, pf, o[d0]); }
}
__device__ __forceinline__ unsigned moba_sel(const v8i* qf, const unsigned char* KM, int qb, int r32, int hi) {
    f32x16 g = f32x16{}; const unsigned char* kp = KM + (r32 & 15) * HD + hi * 32;
#pragma unroll
    for (int ks = 0; ks < 2; ++ks) g = mma8(cat32(ld16(kp + ks * 64), ld16(kp + ks * 64 + 16)), qf[ks], g);
    float v[16];
#pragma unroll
    for (int r = 0; r < 8; ++r) { const float mine = g[r], oth = __shfl_xor(mine, 32); const int base = (r & 3) + 8 * (r >> 2);
        v[base] = hi ? oth : mine; v[base + 4] = hi ? mine : oth; }
#pragma unroll
    for (int n = 0; n < 16; ++n) v[n] = (n < qb) ? v[n] : -1e30f;
    unsigned sel = 0u;
#pragma unroll
    for (int pass = 0; pass < 3; ++pass) {
        float best = v[0]; int bi = 0;
#pragma unroll
        for (int n = 1; n < 16; ++n) { const bool gt = v[n] > best; best = gt ? v[n] : best; bi = gt ? n : bi; }
        if (best > -1e29f) sel |= 1u << bi;
#pragma unroll
        for (int n = 0; n < 16; ++n) v[n] = (n == bi) ? -__builtin_inff() : v[n];
    }
    return sel;
}
struct BlockRef { const unsigned char* Q; const unsigned char* K; const unsigned char* V; unsigned char* O; const unsigned char* KM; int qb; };
struct Seam { v8i qf[2]; v4i st_k[2], st_v[2]; };
__device__ __forceinline__ BlockRef make_ref(unsigned char* ws, int vcu, int k) {
    const int x8 = vcu & 7, bh = (k < 2) ? (vcu >> 3) : 32 + (vcu >> 3), qb = (k & 1) ? 15 - x8 : x8, b = bh >> 4, h = bh & 15;
    BlockRef r; r.Q = ws + WS_Q8 + ((size_t)bh * SEQ + (size_t)qb * 256) * HD; r.K = ws + WS_K8 + (size_t)bh * SEQ * HD; r.V = ws + WS_VT8 + (size_t)bh * HD * SEQ;
    r.O = ws + WS_O8 + ((size_t)(b * SEQ + qb * 256)) * OP + h * HD; r.KM = ws + WS_KM + (size_t)bh * 16 * HD; r.qb = qb; return r;
}
#define VMW() asm volatile("s_waitcnt vmcnt(0)" ::: "memory")
#define VMWN(n) asm volatile("s_waitcnt vmcnt(%0)" :: "i"(n) : "memory")
#define SLOAD_H(Kp, Vp, k0) do { const unsigned char* kp_ = (Kp) + (size_t)(k0) * HD + klo; const unsigned char* vp_ = (Vp) + (size_t)(k0) + vlo; \
        S.st_k[0] = ld16(kp_); S.st_k[1] = ld16(kp_ + KVBLK * HD); S.st_v[0] = ld16(vp_); S.st_v[1] = ld16(vp_ + KVBLK); } while (0)
#define SWRITE_HK(bf) do { *(v4i*)(K_lds + (bf) * SHM_K + kws) = S.st_k[0]; *(v4i*)(K_lds + (bf) * SHM_K + kws + KVBLK * KPITCH) = S.st_k[1]; } while (0)
#define SWRITE_HV(bf) do { _Pragma("unroll") for (int i_ = 0; i_ < 2; ++i_) { unsigned char* vd_ = V_lds + (bf) * SHM_V + vws + i_ * KVBLK; \
        *(int*)(vd_) = S.st_v[i_][0]; *(int*)(vd_ + 32) = S.st_v[i_][1]; *(int*)(vd_ + 4) = S.st_v[i_][2]; *(int*)(vd_ + 36) = S.st_v[i_][3]; } } while (0)
#define SWRITE_H(bf) do { SWRITE_HV(bf); SWRITE_HK(bf); } while (0)
#define QLOAD(Qp) do { const unsigned char* qp_ = (Qp) + qoff; S.qf[0] = cat32(ld16(qp_), ld16(qp_ + 16)); S.qf[1] = cat32(ld16(qp_ + 64), ld16(qp_ + 80)); } while (0)
#define ATT_GEOM() const int wid = __builtin_amdgcn_readfirstlane(tid >> 6), lane = tid & 63, r32 = lane & 31, hi = lane >> 5; \
    const unsigned klo = (unsigned)((tid >> 3) * HD + (tid & 7) * 16), kws = (unsigned)((tid >> 3) * KPITCH + (tid & 7) * 16); \
    const unsigned vlo = (unsigned)((tid >> 2) * SEQ + (tid & 3) * 16), vws = (unsigned)((tid >> 2) * VPITCH + (tid & 3) * 8); \
    const unsigned qoff = (unsigned)((wid * QBLK + r32) * HD + hi * 32); \
    unsigned char* V_lds = (unsigned char*)lds; unsigned char* K_lds = (unsigned char*)lds + 2 * SHM_V
__device__ __forceinline__ void moba_prime(const BlockRef& cur, char* lds, Seam& S, const int tid) {
    ATT_GEOM(); (void)V_lds; (void)vws;
    QLOAD(cur.Q);
    SLOAD_H(cur.K, cur.V, 0); VMW(); SWRITE_HK(0);
    __syncthreads();
}
__device__ __forceinline__ void moba_block(const BlockRef& cur, const BlockRef& nxt, char* lds, Seam& S, const int tid) {
    ATT_GEOM();
    const int qb = cur.qb, NS = 2 * (qb + 1);
    const int qlo = qb * QB + wid * QBLK;
    unsigned* sel_l = (unsigned*)(lds + 2 * SHM_V + 2 * SHM_K) + wid * 64;
    { const unsigned sel0 = (qb > 0) ? moba_sel(S.qf, cur.KM, qb, r32, hi) : 0u; if (hi == 0) sel_l[r32] = sel0; }
    float m_reg = -1e30f, l_reg = 0; f32x16 o[4] = {};
    const unsigned char* Kh = cur.K; const unsigned char* Vh = cur.V;
#define RESC(a) do { if (__any((a) < 1.f)) { for (int d_ = 0; d_ < 4; ++d_) for (int r = 0; r < 16; ++r) o[d_][r] *= (a); } } while (0)
#define KBASE(t) ((t) * KVBLK)
#define KEEP(t) ((((t) >> 2) >= qb) || (((sel_l[r32] >> ((t) >> 2)) & 1u) != 0u))
#define MASKT(P0_, P1_, t) do { const int kb_ = KBASE(t); if (kb_ + KVBLK - 1 > qlo) mask_tile(P0_, P1_, qlo - kb_ + r32 - 4 * hi); } while (0)
    f32x16 pA0, pA1, pB0, pB1; float mnA, mnB, alA, alB; v8i pf;
#define STEP_A(T_, B_, LOADNEXT) do { SBAR(); qkt<0>(B_, pA0, pA1, K_lds, r32, hi, S.qf); finishSM(pB0, pB1, alB, l_reg, pf); SBAR(); \
        if (LOADNEXT) { SLOAD_H(Kh, Vh, KBASE(2 * (T_) + 2)); SBAR(); } \
        pv_tile<1>(1 - (B_), o, V_lds, r32, hi, pf); MASKT(pA0, pA1, 2 * (T_)); partialSM(pA0, pA1, m_reg, mnA, alA, KEEP(2 * (T_))); RESC(alA); } while (0)
#define STEP_B(T_, B_, WRITENEXT) do { SBAR(); qkt<1>(B_, pB0, pB1, K_lds, r32, hi, S.qf); finishSM(pA0, pA1, alA, l_reg, pf); SBAR(); \
        pv_tile<0>(B_, o, V_lds, r32, hi, pf); MASKT(pB0, pB1, 2 * (T_) + 1); partialSM(pB0, pB1, m_reg, mnB, alB, KEEP(2 * (T_) + 1)); \
        if (WRITENEXT) { __syncthreads(); VMW(); SWRITE_H(1 - (B_)); RESC(alB); __syncthreads(); } else { RESC(alB); } } while (0)
    SWRITE_HV(0); SBAR();
    SLOAD_H(Kh, Vh, KBASE(2));
    SBAR(); qkt<0>(0, pA0, pA1, K_lds, r32, hi, S.qf);
    MASKT(pA0, pA1, 0); partialSM(pA0, pA1, m_reg, mnA, alA, KEEP(0));
    __syncthreads();
    STEP_B(0, 0, true);
    for (int T_ = 1; T_ + 1 < NS; ++T_) { const int bsel = T_ & 1; STEP_A(T_, bsel, true); STEP_B(T_, bsel, true); }
    STEP_A(NS - 1, 1, false);
    SBAR(); qkt<1>(1, pB0, pB1, K_lds, r32, hi, S.qf); SBAR();
    SLOAD_H(nxt.K, nxt.V, 0); SBAR();
    QLOAD(nxt.Q);
    SBAR();
    finishSM(pA0, pA1, alA, l_reg, pf); SBAR();
    pv_tile<0>(1, o, V_lds, r32, hi, pf);
    MASKT(pB0, pB1, 2 * NS - 1); partialSM(pB0, pB1, m_reg, mnB, alB, true); RESC(alB);
    finishSM(pB0, pB1, alB, l_reg, pf); SBAR(); pv_tile<1>(1, o, V_lds, r32, hi, pf);
    SBAR(); VMWN(4); SWRITE_HK(0); SBAR();
    { const float rl = __builtin_amdgcn_rcpf(l_reg) * (float)(1 << O8_SHIFT);
      int r32e = r32, hie = hi; asm volatile("" : "+v"(r32e), "+v"(hie));
      unsigned char* Ow = cur.O + (size_t)(wid * QBLK + r32e) * OP + 4 * hie;
#pragma unroll
      for (int d0 = 0; d0 < 4; ++d0)
#pragma unroll
          for (int g4 = 0; g4 < 4; ++g4) *(unsigned*)(Ow + d0 * 32 + 8 * g4) = pk_fp8x4(o[d0][4 * g4] * rl, o[d0][4 * g4 + 1] * rl, o[d0][4 * g4 + 2] * rl, o[d0][4 * g4 + 3] * rl); }
    __syncthreads();
#undef RESC
#undef KBASE
#undef KEEP
#undef MASKT
#undef STEP_A
#undef STEP_B
}
#undef VMW
#undef VMWN
#undef SLOAD_H
#undef SWRITE_HK
#undef SWRITE_HV
#undef SWRITE_H
#undef QLOAD
#undef ATT_GEOM
}

struct Args { const float* in[23]; float* out; unsigned char* ws; };
typedef const __attribute__((address_space(4))) Args* ArgsP;
__device__ __forceinline__ int ltid(int wave0) { int l; asm volatile("v_mbcnt_lo_u32_b32 %0, -1, 0\n\tv_mbcnt_hi_u32_b32 %0, -1, %0" : "=v"(l)); return (wave0 << 6) | l; }
__device__ __forceinline__ ArgsP kargs() { ArgsP p = (ArgsP)__builtin_amdgcn_kernarg_segment_ptr(); asm volatile("" : "+s"(p)); return p; }
#define WSP(T_, off) ((T_*)(ws + (off)))

struct ConvUnit { const float* W; void* WT; int ldw, ldt, k0, n0, kind, add; };
__device__ __forceinline__ int conv_row(const ConvUnit& c, int n) {
    if (c.kind == 2) { if (n >= 6144) return n - 2048; const int p = n & 127; return (n & ~127) + 2 * (p & 63) + (p >> 6) - 2048; }
    if (c.kind == 3) return (n >> 2) * 8 + (n & 3) + c.add;
    return n;
}
constexpr int CBUF = 65536, OP8 = 144, OP16 = 272;
__device__ __forceinline__ void conv_dma(const ConvUnit& c, int wave, int lane, LAS unsigned char* buf) {
    const float* Wl = c.W + (size_t)(c.k0 + 16 * wave + (lane >> 5)) * c.ldw + c.n0 + 4 * (lane & 31);
#pragma unroll
    for (int i = 0; i < 8; ++i) __builtin_amdgcn_global_load_lds((const unsigned*)(Wl + (size_t)(2 * i) * c.ldw), (LAS unsigned*)(buf + (16 * wave + 2 * i) * 512), 16, 0, 0);
}
__device__ __forceinline__ void conv_read(int wave, int lane, const LAS unsigned char* buf, float (&f)[32]) {
    const LAS float* p = (const LAS float*)(buf + (16 * wave) * 512 + 4 * lane);
#pragma unroll
    for (int i = 0; i < 16; ++i) { f[i] = p[i * 128]; f[16 + i] = p[i * 128 + 64]; }
}
__device__ __forceinline__ void conv_park8(int wave, int lane, LAS unsigned char* img, const float (&f)[32]) {
    constexpr float SC = (float)(1 << pg8::W8_SHIFT);
#pragma unroll
    for (int h = 0; h < 2; ++h) { v4u o; o.x = pk_fp8x4(f[16 * h] * SC, f[16 * h + 1] * SC, f[16 * h + 2] * SC, f[16 * h + 3] * SC); o.y = pk_fp8x4(f[16 * h + 4] * SC, f[16 * h + 5] * SC, f[16 * h + 6] * SC, f[16 * h + 7] * SC);
        o.z = pk_fp8x4(f[16 * h + 8] * SC, f[16 * h + 9] * SC, f[16 * h + 10] * SC, f[16 * h + 11] * SC); o.w = pk_fp8x4(f[16 * h + 12] * SC, f[16 * h + 13] * SC, f[16 * h + 14] * SC, f[16 * h + 15] * SC);
        *(LAS v4u*)(img + (lane + 64 * h) * OP8 + 16 * wave) = o; }
}
__device__ __forceinline__ void conv_out8(const ConvUnit& c, int tid, const LAS unsigned char* img) {
#pragma unroll
    for (int j = 0; j < 2; ++j) { const int row = (tid >> 3) + 64 * j, ch = tid & 7; const v4u v = *(const LAS v4u*)(img + row * OP8 + 16 * ch);
        *(v4u*)((unsigned char*)c.WT + (size_t)conv_row(c, c.n0 + row) * c.ldt + c.k0 + 16 * ch) = v; }
}
__device__ __forceinline__ void conv_park16(int wave, int lane, LAS unsigned char* img, const float (&f)[32], const int h) {
    v4u o0, o1; o0.x = pk2(f[16 * h], f[16 * h + 1]); o0.y = pk2(f[16 * h + 2], f[16 * h + 3]); o0.z = pk2(f[16 * h + 4], f[16 * h + 5]); o0.w = pk2(f[16 * h + 6], f[16 * h + 7]);
    o1.x = pk2(f[16 * h + 8], f[16 * h + 9]); o1.y = pk2(f[16 * h + 10], f[16 * h + 11]); o1.z = pk2(f[16 * h + 12], f[16 * h + 13]); o1.w = pk2(f[16 * h + 14], f[16 * h + 15]);
    LAS unsigned char* q = img + lane * OP16 + 32 * wave; *(LAS v4u*)q = o0; *(LAS v4u*)(q + 16) = o1;
}
__device__ __forceinline__ void conv_out16(const ConvUnit& c, int tid, const LAS unsigned char* img, const int h) {
#pragma unroll
    for (int j = 0; j < 2; ++j) { const int row = (tid >> 4) + 32 * j, ch = tid & 15; const v4u v = *(const LAS v4u*)(img + row * OP16 + 16 * ch);
        *(v4u*)((bf16*)c.WT + (size_t)conv_row(c, c.n0 + 64 * h + row) * c.ldt + c.k0 + 8 * ch) = v; }
}
constexpr int NCONV = 8320;
__device__ __forceinline__ ConvUnit conv_decode(int u, ArgsP A, unsigned char* ws) {
    ConvUnit c; c.add = 0;
    if (u < 1536) { const int kp = u / 96, g = u - kp * 96; c.W = A->in[6]; c.ldw = INC; c.k0 = kp * 128; c.n0 = g * 128; c.ldt = D;
        if (g < 16) { c.WT = ws + WS_WINZ; c.kind = 0; } else { c.WT = ws + WS_WIN8; c.kind = 2; } return c; }
    u -= 1536;
    if (u < 128) { c.W = A->in[11]; c.ldw = D; c.k0 = (u >> 4) * 128; c.n0 = (u & 15) * 128; c.WT = ws + WS_WSO; c.ldt = SGW; c.kind = 0; return c; }
    u -= 128;
    if (u < 256) { c.W = A->in[12]; c.ldw = D; c.k0 = (u >> 4) * 128; c.n0 = (u & 15) * 128; c.WT = ws + WS_WMO8; c.ldt = D; c.kind = 1; return c; }
    u -= 256;
    if (u < 256) { c.W = A->in[13]; c.ldw = D; c.k0 = (u >> 4) * 128; c.n0 = (u & 15) * 128; c.WT = ws + WS_WOUT; c.ldt = D; c.kind = 1; return c; }
    u -= 256;
    const int m = u >> 11, r = u & 2047, e = r >> 6, q = r & 63;
    if (m < 2) { c.W = A->in[19 + m] + (size_t)e * D * DFF; c.ldw = DFF; c.k0 = (q >> 2) * 128; c.n0 = (q & 3) * 128; c.WT = ws + WS_WGU8 + (size_t)e * 1024 * D; c.ldt = D; c.kind = 3; c.add = 4 * m; return c; }
    c.W = A->in[21] + (size_t)e * DFF * D; c.ldw = D; c.k0 = (q >> 4) * 128; c.n0 = (q & 15) * 128; c.WT = ws + WS_WD8 + (size_t)e * D * DFF; c.ldt = DFF; c.kind = 1; return c;
}
constexpr int NCONV_EARLY = 1536;
__device__ __forceinline__ void conv_run(LAS unsigned char* lds, const int tid, const int wave, const int lane, int u, const int uend) {
    float f[32];
    LAS unsigned char* b0 = lds; LAS unsigned char* b1 = lds + CBUF; LAS unsigned char* img = lds + TAB_OFF;
#define CONV_CLAMP(x) ((x) < uend ? (x) : uend - 1)
#define CONV_BAR() do { asm volatile("s_waitcnt lgkmcnt(0)" ::: "memory"); __builtin_amdgcn_s_barrier(); asm volatile("" ::: "memory"); } while (0)
#define CONV_STEP(N, buf) do { \
        asm volatile("s_waitcnt vmcnt(" #N ")" ::: "memory"); __builtin_amdgcn_s_barrier(); asm volatile("" ::: "memory"); \
        conv_read(wave, lane, buf, f); CONV_BAR(); \
        { ArgsP Ai = kargs(); const ConvUnit cn = conv_decode(CONV_CLAMP(u + 512), Ai, Ai->ws); conv_dma(cn, wave, lane, buf); } \
        { ArgsP Ai = kargs(); const ConvUnit c = conv_decode(u, Ai, Ai->ws); \
          if (c.kind != 0) { conv_park8(wave, lane, img, f); CONV_BAR(); conv_out8(c, tid, img); } \
          else { conv_park16(wave, lane, img, f, 0); CONV_BAR(); conv_out16(c, tid, img, 0); CONV_BAR(); conv_park16(wave, lane, img, f, 1); CONV_BAR(); conv_out16(c, tid, img, 1); } } \
        u += 256; } while (0)
    { ArgsP Ai = kargs(); const ConvUnit c = conv_decode(u, Ai, Ai->ws); conv_dma(c, wave, lane, b0); }
    { ArgsP Ai = kargs(); const ConvUnit c = conv_decode(CONV_CLAMP(u + 256), Ai, Ai->ws); conv_dma(c, wave, lane, b1); }
    CONV_STEP(8, b0);
    if (u < uend) { CONV_STEP(10, b1);
        for (;;) {
            if (u >= uend) break; CONV_STEP(12, b0);
            if (u >= uend) break; CONV_STEP(12, b1);
        } }
    asm volatile("s_waitcnt vmcnt(0)" ::: "memory");
    __builtin_amdgcn_s_barrier();
#undef CONV_STEP
#undef CONV_BAR
#undef CONV_CLAMP
}

__global__ void __launch_bounds__(NWAVES * 64, 2) fwd_kernel(Args args) {
    extern __shared__ __attribute__((aligned(16))) unsigned char lds_raw[];
    LAS unsigned char* lds = (LAS unsigned char*)lds_raw;
    const int wave0 = __builtin_amdgcn_readfirstlane((int)threadIdx.x >> 6);
    constexpr int G = 256;
#define BX ((int)blockIdx.x)
#define VCU (((int)blockIdx.x & 7) * 32 + ((int)blockIdx.x >> 3))
    volatile LAS unsigned* MISC = (volatile LAS unsigned*)(lds + MISC_OFF);
    for (int u = ltid(wave0); u < (LDS_BYTES - LDSCTL_OFF) / 4; u += NWAVES * 64) ((LAS unsigned*)(lds + LDSCTL_OFF))[u] = 0u;
    __syncthreads();
    (void)xcd_barrier_post((unsigned*)(args.ws + WS_CTL) + CW_BAR, MISC + 8, ltid(wave0));
#define GRID_BAR() do { XcdBarrier b_; b_.bar = (unsigned*)(kargs()->ws + WS_CTL) + CW_BAR; b_.x = xb_xcc_id(); b_.st = (volatile LAS unsigned*)(lds + MISC_OFF) + 8; xcd_barrier(b_, ltid(wave0)); } while (0)

    DUPLOOP(0) {
    {
        ArgsP A = kargs(); unsigned char* ws = A->ws; const int tid = ltid(wave0), lane = tid & 63, wave = __builtin_amdgcn_readfirstlane(tid >> 6); (void)lane; (void)wave; gu32* ctl = (gu32*)(ws + WS_CTL);
        const float* cin = A->in[1];
        LAS float* cact = (LAS float*)(lds + 98304);
        for (int i = tid; i < BATCH * D; i += NWAVES * 64) { const float v = cin[i]; cact[i] = v / (1.0f + __expf(-v)); }
        __syncthreads();
        { const int it = (wave < 6) ? VCU * 6 + wave : 1536 + VCU * 2 + (wave - 6); ArgsP Ai = kargs(); unsigned char* wsi = Ai->ws;
            if (it < 1536) {
                const int qd = it / 384, col = (it - qd * 384) * 32 + 4 * (lane & 7), rq = lane >> 3;
                f32x4 a0 = {0.f, 0.f, 0.f, 0.f}, a1 = a0, a2 = a0, a3 = a0;
                for (int k0 = qd * 512; k0 < qd * 512 + 512; k0 += 256) {
                    f32x4 w[32];
#pragma unroll
                    for (int i = 0; i < 32; ++i) w[i] = *(const f32x4*)(Ai->in[3] + (size_t)(k0 + rq + 8 * i) * 12288 + col);
#pragma unroll
                    for (int i = 0; i < 32; ++i) { const int k = k0 + rq + 8 * i;
                        a0 += cact[k] * w[i]; a1 += cact[D + k] * w[i]; a2 += cact[2 * D + k] * w[i]; a3 += cact[3 * D + k] * w[i]; }
                }
#pragma unroll
                for (int e = 0; e < 4; ++e)
#pragma unroll
                    for (int o = 8; o < 64; o <<= 1) { a0[e] += __shfl_xor(a0[e], o); a1[e] += __shfl_xor(a1[e], o); a2[e] += __shfl_xor(a2[e], o); a3[e] += __shfl_xor(a3[e], o); }
                if (rq == 0) { const f32x4 bb = (qd == 0) ? *(const f32x4*)(Ai->in[4] + col) : (f32x4){0.f, 0.f, 0.f, 0.f}; float* ap = ((float*)(wsi + WS_ADAP)) + (size_t)qd * 49152 + col;
                    *(f32x4*)(ap) = a0 + bb; *(f32x4*)(ap + 12288) = a1 + bb; *(f32x4*)(ap + 2 * 12288) = a2 + bb; *(f32x4*)(ap + 3 * 12288) = a3 + bb; }
            } else if (it < 1792) {
                const int tok = (it - 1536) * 64 + lane; const double pos = (double)((const int*)Ai->in[2])[tok];
                float* cosT = (float*)(wsi + WS_COS); float* sinT = (float*)(wsi + WS_SIN);
                double inv = 1.0;
                for (int j = 0; j < 64; ++j) {
                    const double rev = pos * inv * 0.15915494309189535;
                    const float fr = (float)(rev - __builtin_floor(rev));
                    cosT[(size_t)tok * 64 + j] = __builtin_amdgcn_cosf(fr); sinT[(size_t)tok * 64 + j] = __builtin_amdgcn_sinf(fr);
                    inv *= 0.8659643233600653;
                }
            } else if (it < 1824) {
                const int g = (it - 1792) >> 2, part = (it - 1792) & 3; bf16* WSb = (bf16*)(wsi + WS_WS);
                for (int i = part * 4096 + lane; i < part * 4096 + 4096; i += 64) { const int r = i >> 7, c = i & 127; WSb[g * 16384 + i] = (c <= r) ? (bf16)f2bf(Ai->in[9][g * 16384 + i]) : (bf16)0; }
            } else if (it < 2016) {
                const int q = it - 1824, u = q & 7, n0 = (q >> 3) * 2; bf16* RT = (bf16*)(wsi + WS_RT);
#pragma unroll
                for (int nn = 0; nn < 2; ++nn) { const int n = n0 + nn;
#pragma unroll
                    for (int i = 0; i < 4; ++i) { const int k = u * 256 + lane + 64 * i; const float w = (n < 4) ? Ai->in[15][k * 4 + n] : (n < 36) ? Ai->in[17][k * 32 + (n - 4)] : 0.f;
                        const unsigned hi = f2bf(w); const int ks = k >> 5, kk = k & 31; RT[((ks * 2) * 48 + n) * 32 + kk] = (bf16)hi; RT[((ks * 2 + 1) * 48 + n) * 32 + kk] = (bf16)f2bf(w - __builtin_bit_cast(float, hi << 16)); } }
            }
        }
        __syncthreads();
        conv_run(lds, tid, wave, lane, VCU, NCONV_EARLY);
    }
    GRID_BAR();
    }

    DUPLOOP(1) {
    {
        ArgsP A = kargs(); unsigned char* ws = A->ws; const int tid = ltid(wave0), lane = tid & 63, wave = __builtin_amdgcn_readfirstlane(tid >> 6); (void)lane; (void)wave;
        const float* x = A->in[0]; const float* g_mix = A->in[5]; const float* adap = WSP(float, WS_ADAP); float* adaf = WSP(float, WS_ADA); bf16* Nb = WSP(bf16, WS_N); unsigned char* N8 = ws + WS_N1F8;
        LAS float* tg = (LAS float*)(lds); LAS float* tb = (LAS float*)(lds + 8192);
        const int row0 = VCU * 64, b = row0 >> 12;
        for (int i = tid; i < D; i += NWAVES * 64) { const float* ap = adap + b * 12288 + i;
            tg[i] = g_mix[i] * (1.0f + ((ap[2048] + ap[49152 + 2048]) + (ap[2 * 49152 + 2048] + ap[3 * 49152 + 2048]))); tb[i] = (ap[0] + ap[49152]) + (ap[2 * 49152] + ap[3 * 49152]); }
        if (tid < 192) { const int i = VCU * 192 + tid; adaf[i] = (adap[i] + adap[49152 + i]) + (adap[2 * 49152 + i] + adap[3 * 49152 + i]); }
        __syncthreads();
        for (int rq = 0; rq < 2; ++rq) {
            f32x4 v[4][8];
#pragma unroll
            for (int q = 0; q < 4; ++q) { const f32x4* xr = (const f32x4*)(x + (size_t)(row0 + wave * 8 + rq * 4 + q) * D) + lane;
#pragma unroll
                for (int j = 0; j < 8; ++j) v[q][j] = xr[64 * j]; }
#pragma unroll
            for (int q = 0; q < 4; ++q) { const int row = row0 + wave * 8 + rq * 4 + q; float ss = 0.f;
#pragma unroll
                for (int j = 0; j < 8; ++j) ss += (v[q][j].x * v[q][j].x + v[q][j].y * v[q][j].y) + (v[q][j].z * v[q][j].z + v[q][j].w * v[q][j].w);
                const float rstd = rsqrtf(wave_sum(ss) * (1.f / D) + EPS);
                v2u* o8 = (v2u*)(Nb + (size_t)row * D) + lane;
#pragma unroll
                for (int j = 0; j < 8; ++j) { const f32x4 gg = *(const LAS f32x4*)(tg + 4 * lane + 256 * j), bb = *(const LAS f32x4*)(tb + 4 * lane + 256 * j);
                    const f32x4 y = v[q][j] * rstd * gg + bb; v2u w; w.x = cvt_pk_bf16(y.x, y.y); w.y = cvt_pk_bf16(y.z, y.w); o8[64 * j] = w;
                    *((unsigned*)(N8 + (size_t)row * D) + lane + 64 * j) = pk_fp8x4(y.x, y.y, y.z, y.w); } }
        }
    }
    GRID_BAR();
    }

    DUPLOOP(2) {
    {
        ArgsP A = kargs(); unsigned char* ws = A->ws; const int tid = ltid(wave0), lane = tid & 63, wave = __builtin_amdgcn_readfirstlane(tid >> 6); (void)lane; (void)wave;
        bf16* Nb = WSP(bf16, WS_N); bf16* UV = WSP(bf16, WS_UV); unsigned char* Qh = ws + WS_Q8; unsigned char* Kh = ws + WS_K8; unsigned char* Vh = ws + WS_VT8;
        bf16* SAg = WSP(bf16, WS_SA); bf16* SBg = WSP(bf16, WS_SB); const float* cosT = WSP(float, WS_COS); const float* sinT = WSP(float, WS_SIN);
        { pg8::StaticOrder S; S.init(T, 2048, D * 2, G, BX, ws + WS_WINZ);
          pg8::EpiInProj E{UV, Qh, Kh, Vh, SAg, SBg, cosT, sinT, 0};
          pg8::gemm_phase<false>(lds, (const char*)Nb, D * 2, S, E, tid); }
        { pg8::StaticOrder S; S.init(T, 10240, D, G, BX, ws + WS_WIN8);
          pg8::EpiInProj E{UV, Qh, Kh, Vh, SAg, SBg, cosT, sinT, 8};
          pg8::gemm_phase<true>(lds, (const char*)(ws + WS_N1F8), D, S, E, tid); }
    }
    GRID_BAR();
    }

    DUPLOOP(3) {
    {
        ArgsP A = kargs(); unsigned char* ws = A->ws; const int tid = ltid(wave0), lane = tid & 63, wave = __builtin_amdgcn_readfirstlane(tid >> 6); (void)lane; (void)wave;
        const float* sgu_ln_g = A->in[7]; const float* sgu_ln_b = A->in[8]; const float* sgu_b_s = A->in[10];
        const bf16* UV = WSP(bf16, WS_UV); const bf16* WSb = WSP(bf16, WS_WS); bf16* SGUO = WSP(bf16, WS_SGUO); const unsigned char* K8 = ws + WS_K8; unsigned char* KM = ws + WS_KM;
        constexpr int VP = 136;
        LAS bf16* vT = (LAS bf16*)lds; LAS f32x2* st = (LAS f32x2*)(lds + 2 * 128 * VP * 2); LAS float* kx = (LAS float*)(lds + 73728);
        { const int item = VCU * NWAVES + wave, blk = item >> 1, half = item & 1, c8 = (lane & 15) * 8, r0 = lane >> 4;
          const unsigned char* kp = K8 + ((size_t)blk * 256 + half * 128 + r0) * HD + c8;
          float sacc[8] = {0.f, 0.f, 0.f, 0.f, 0.f, 0.f, 0.f, 0.f};
          { v2u w[32];
#pragma unroll
              for (int u = 0; u < 32; ++u) w[u] = *(const v2u*)(kp + (size_t)(4 * u) * HD);
#pragma unroll
              for (int u = 0; u < 32; ++u) { const f32x2 a0 = __builtin_amdgcn_cvt_pk_f32_fp8((int)w[u].x, false), a1 = __builtin_amdgcn_cvt_pk_f32_fp8((int)w[u].x, true), a2 = __builtin_amdgcn_cvt_pk_f32_fp8((int)w[u].y, false), a3 = __builtin_amdgcn_cvt_pk_f32_fp8((int)w[u].y, true);
                  sacc[0] += a0.x; sacc[1] += a0.y; sacc[2] += a1.x; sacc[3] += a1.y; sacc[4] += a2.x; sacc[5] += a2.y; sacc[6] += a3.x; sacc[7] += a3.y; } }
#pragma unroll
          for (int e = 0; e < 8; ++e) { sacc[e] += __shfl_xor(sacc[e], 16); sacc[e] += __shfl_xor(sacc[e], 32); }
          LAS float* kxp = kx + (wave >> 1) * 128 + c8;
          if (half == 1 && lane < 16) {
#pragma unroll
              for (int e = 0; e < 8; ++e) kxp[e] = sacc[e]; }
          __syncthreads();
          if (half == 0 && lane < 16) {
#pragma unroll
              for (int e = 0; e < 8; ++e) sacc[e] = (sacc[e] + kxp[e]) * ((float)(1 << att::KM_SHIFT) / 256.f);
              v2u o; o.x = pk_fp8x4(sacc[0], sacc[1], sacc[2], sacc[3]); o.y = pk_fp8x4(sacc[4], sacc[5], sacc[6], sacc[7]);
              *(v2u*)(KM + (size_t)blk * HD + c8) = o; } }
        {
            const int ch = VCU >> 1, hf = VCU & 1, R0 = ch * 128;
            LAS float* lng = (LAS float*)(lds + 81920); LAS float* lnb = lng + 512;
            lng[tid] = sgu_ln_g[hf * 512 + tid]; lnb[tid] = sgu_ln_b[hf * 512 + tid];
            v4u aa[4][8];
#pragma unroll
            for (int it4 = 0; it4 < 4; ++it4) { const v4u* vp = (const v4u*)(UV + (size_t)(R0 + wave * 16 + it4 * 4 + (lane >> 4)) * D + SGW) + (lane & 15);
#pragma unroll
                for (int q = 0; q < 8; ++q) aa[it4][q] = vp[16 * q]; }
#pragma unroll
            for (int it4 = 0; it4 < 4; ++it4) { const int j = wave * 16 + it4 * 4 + (lane >> 4);
                const v4u (&a)[8] = aa[it4];
                float s = 0.f;
#pragma unroll
                for (int q = 0; q < 8; ++q) s += ((bflo(a[q].x) + bfhi(a[q].x)) + (bflo(a[q].y) + bfhi(a[q].y))) + ((bflo(a[q].z) + bfhi(a[q].z)) + (bflo(a[q].w) + bfhi(a[q].w)));
#pragma unroll
                for (int o = 1; o < 16; o <<= 1) s += __shfl_xor(s, o);
                const float mean = s * (1.f / SGW); float qv = 0.f;
#pragma unroll
                for (int q = 0; q < 8; ++q) { float d;
                    d = bflo(a[q].x) - mean; qv += d * d; d = bfhi(a[q].x) - mean; qv += d * d; d = bflo(a[q].y) - mean; qv += d * d; d = bfhi(a[q].y) - mean; qv += d * d;
                    d = bflo(a[q].z) - mean; qv += d * d; d = bfhi(a[q].z) - mean; qv += d * d; d = bflo(a[q].w) - mean; qv += d * d; d = bfhi(a[q].w) - mean; qv += d * d; }
#pragma unroll
                for (int o = 1; o < 16; o <<= 1) qv += __shfl_xor(qv, o);
                if ((lane & 15) == 0) st[j] = (f32x2){mean, rsqrtf(qv * (1.f / SGW) + EPS)};
            }
            __syncthreads();
            for (int ps = 0; ps < 2; ++ps) {
                const int gp = hf * 2 + ps;
                { const int j = lane + 64 * (wave & 1), cb = 64 * (wave >> 1); const f32x2 ms = st[j];
                  v4u a[8];
#pragma unroll
                  for (int cq = 0; cq < 8; ++cq) a[cq] = *(const v4u*)(UV + (size_t)(R0 + j) * D + SGW + gp * 256 + cb + 8 * cq);
#pragma unroll
                  for (int cq = 0; cq < 8; ++cq) { const int c0 = cb + 8 * cq, chn = gp * 256 + c0;
                      const int cl_ = chn - hf * 512; const f32x4 g0 = *(const LAS f32x4*)(lng + cl_), g1 = *(const LAS f32x4*)(lng + cl_ + 4), b0 = *(const LAS f32x4*)(lnb + cl_), b1 = *(const LAS f32x4*)(lnb + cl_ + 4);
                      const float e[8] = {bflo(a[cq].x), bfhi(a[cq].x), bflo(a[cq].y), bfhi(a[cq].y), bflo(a[cq].z), bfhi(a[cq].z), bflo(a[cq].w), bfhi(a[cq].w)};
                      const float gg[8] = {g0[0], g0[1], g0[2], g0[3], g1[0], g1[1], g1[2], g1[3]}, bb[8] = {b0[0], b0[1], b0[2], b0[3], b1[0], b1[1], b1[2], b1[3]};
#pragma unroll
                      for (int i = 0; i < 8; ++i) vT[(c0 + i) * VP + j] = (bf16)f2bf((e[i] - ms.x) * ms.y * gg[i] + bb[i]); } }
                __syncthreads();
                { const int g = wave >> 2, ib = wave & 3, gg = gp * 2 + g, r32 = lane & 31, hi = lane >> 5; const int nks = 2 * (ib + 1);
                  const bf16* Wg = WSb + (size_t)gg * 16384 + (size_t)(ib * 32 + r32) * 128 + hi * 8;
                  f32x16 acc[4] = {};
                  const int tokr = R0 + ib * 32 + r32;
                  bf16x8 bwv[8]; v2u uu[4][4];
#pragma unroll
                  for (int ks = 0; ks < 8; ++ks) bwv[ks] = *(const bf16x8*)(Wg + (ks < nks ? ks : 0) * 16);
#pragma unroll
                  for (int db = 0; db < 4; ++db)
#pragma unroll
                      for (int q4 = 0; q4 < 4; ++q4) uu[db][q4] = *(const v2u*)(UV + (size_t)tokr * D + gg * 128 + db * 32 + 8 * q4 + 4 * hi);
                  __builtin_amdgcn_sched_barrier(0);
#pragma unroll
                  for (int ks = 0; ks < 8; ++ks) { if (ks >= nks) break;
                      const bf16x8 bw = bwv[ks];
#pragma unroll
                      for (int db = 0; db < 4; ++db) { const bf16x8 av = *(const LAS bf16x8*)(vT + (size_t)(g * 128 + db * 32 + r32) * VP + ks * 16 + hi * 8);
                          acc[db] = __builtin_amdgcn_mfma_f32_32x32x16_bf16(av, bw, acc[db], 0, 0, 0); }
                  }
                  const float bs = sgu_b_s[gg * 128 + ib * 32 + r32];
#pragma unroll
                  for (int db = 0; db < 4; ++db)
#pragma unroll
                      for (int q4 = 0; q4 < 4; ++q4) { const int d = db * 32 + 8 * q4 + 4 * hi;
                          const v2u u2 = uu[db][q4];
                          v2u w; w.x = cvt_pk_bf16(bflo(u2.x) * (acc[db][4 * q4 + 0] + bs), bfhi(u2.x) * (acc[db][4 * q4 + 1] + bs));
                          w.y = cvt_pk_bf16(bflo(u2.y) * (acc[db][4 * q4 + 2] + bs), bfhi(u2.y) * (acc[db][4 * q4 + 3] + bs));
                          *(v2u*)(SGUO + (size_t)tokr * SGW + gg * 128 + d) = w; } }
                __syncthreads();
            }
        }
    }
    GRID_BAR();
    }

    if ((BX & 1) == 0) { const int tid = ltid(wave0); conv_run(lds, tid, __builtin_amdgcn_readfirstlane(tid >> 6), tid & 63, NCONV_EARLY + VCU, NCONV); }
    {
        char* al = (char*)lds_raw;
        ArgsP A = kargs(); unsigned char* ws = A->ws; const int tid = ltid(wave0), lane = tid & 63, wave = __builtin_amdgcn_readfirstlane(tid >> 6); (void)lane; (void)wave;
        att::Seam S;
        att::moba_prime(att::make_ref(ws, VCU, 0), al, S, tid);
        constexpr int NBLK = 4 * ((((PROBE_DUP) >> 4) & 1) + 1);
        for (int k = 0; k < NBLK; ++k) att::moba_block(att::make_ref(ws, VCU, k & 3), att::make_ref(ws, VCU, (k + 1) & 3), al, S, tid);
    }
    if ((BX & 1) != 0) { asm volatile("s_waitcnt vmcnt(0)" ::: "memory"); __syncthreads(); const int tid = ltid(wave0); conv_run(lds, tid, __builtin_amdgcn_readfirstlane(tid >> 6), tid & 63, NCONV_EARLY + VCU, NCONV); }
    GRID_BAR();

    DUPLOOP(5) {
    {
        ArgsP A = kargs(); unsigned char* ws = A->ws; const int tid = ltid(wave0), lane = tid & 63, wave = __builtin_amdgcn_readfirstlane(tid >> 6); (void)lane; (void)wave;
        const bf16* SAg = WSP(bf16, WS_SA); const bf16* SBg = WSP(bf16, WS_SB); bf16* T1 = WSP(bf16, WS_Q); unsigned char* MERGED = ws + WS_MERGED;
        { pg8::StaticOrder S; S.init(T, D, SGW * 2, G, BX, ws + WS_WSO);
          pg8::EpiGateSeg E{SAg, SBg, T1, MERGED, 0};
          pg8::gemm_phase<false>(lds, (const char*)(ws + WS_SGUO), SGW * 2, S, E, tid); }
        { pg8::StaticOrder S; S.init(T, D, D, G, BX, ws + WS_WMO8);
          pg8::EpiGateSeg E{SAg, SBg, T1, MERGED, 1};
          pg8::gemm_phase<true>(lds, (const char*)(ws + WS_O8), D, S, E, tid, att::O8_SHIFT); }
    }
    GRID_BAR();
    }

    DUPLOOP(6) {
    {
        ArgsP A = kargs(); unsigned char* ws = A->ws; const int tid = ltid(wave0), lane = tid & 63, wave = __builtin_amdgcn_readfirstlane(tid >> 6); (void)lane; (void)wave;
        const float* ada = WSP(float, WS_ADA); bf16* DELTA = WSP(bf16, WS_DELTA);
        pg8::StaticOrder S; S.init(T, D, D, G, BX, ws + WS_WOUT);
        pg8::EpiDelta E{ada + 4096, DELTA};
        pg8::gemm_phase<true>(lds, (const char*)(ws + WS_MERGED), D, S, E, tid, pg8::M8_SHIFT);
    }
    GRID_BAR();
    }

    DUPLOOP(10) {
    {
        ArgsP A = kargs(); unsigned char* ws = A->ws; const int tid = ltid(wave0), lane = tid & 63, wave = __builtin_amdgcn_readfirstlane(tid >> 6); (void)lane; (void)wave; gu32* ctl = (gu32*)(ws + WS_CTL);
        const float* g_ffn = A->in[14]; const float* b_rg = A->in[16]; const float* b_re = A->in[18]; const float* __restrict__ x = A->in[0]; const bf16* __restrict__ DELTA = WSP(bf16, WS_DELTA);
        const float* ada = WSP(float, WS_ADA); const bf16* __restrict__ RT = WSP(bf16, WS_RT); unsigned char* __restrict__ N28 = ws + WS_N2F8;
        int* tok_e = WSP(int, WS_TOKE); int* tok_p = WSP(int, WS_TOKP); float* tok_w = WSP(float, WS_TOKW); int* elist = WSP(int, WS_LIST);
        if (rep_ == 1) { ctl += 32768; tok_e = WSP(int, WS_K); tok_p = tok_e + 2 * T; tok_w = (float*)(tok_p + 2 * T); elist = (int*)(ws + WS_K + 8 * MiB); }
        LAS unsigned char* At = lds;
        LAS float* lgx = (LAS float*)(lds + TAB_OFF);
        const int row0 = VCU * 64, b = row0 >> 12;
        LAS float* tgs = (LAS float*)(lds + TAB_OFF + 12288); LAS float* tsh = tgs + D;
        for (int i = tid; i < D; i += NWAVES * 64) { tgs[i] = g_ffn[i] * (ada[b * 12288 + 8192 + i] + 1.0f); tsh[i] = ada[b * 12288 + 6144 + i]; }
        __syncthreads();
        for (int ps = 0; ps < 2; ++ps) {
            { const LAS f32x4* gp = (const LAS f32x4*)tgs + lane; const LAS f32x4* shp = (const LAS f32x4*)tsh + lane;
#pragma unroll
              for (int rp = 0; rp < 2; ++rp) {
                  f32x4 v[2][8]; v2u dl[2][8];
#pragma unroll
                  for (int q = 0; q < 2; ++q) { const int row = row0 + ps * 32 + wave * 4 + rp * 2 + q;
#pragma unroll
                      for (int j = 0; j < 8; ++j) { v[q][j] = *((const f32x4*)(x + (size_t)row * D) + lane + 64 * j); dl[q][j] = *((const v2u*)(DELTA + (size_t)row * D) + lane + 64 * j); } }
#pragma unroll
                  for (int q = 0; q < 2; ++q) { const int rl = wave * 4 + rp * 2 + q, row = row0 + ps * 32 + rl; float ss = 0.f;
#pragma unroll
                      for (int j = 0; j < 8; ++j) { v[q][j] += (f32x4){bflo(dl[q][j].x), bfhi(dl[q][j].x), bflo(dl[q][j].y), bfhi(dl[q][j].y)};
                          ss += (v[q][j].x * v[q][j].x + v[q][j].y * v[q][j].y) + (v[q][j].z * v[q][j].z + v[q][j].w * v[q][j].w); }
                      const float rstd = rsqrtf(wave_sum(ss) * (1.f / D) + EPS);
#pragma unroll
                      for (int j = 0; j < 8; ++j) { const f32x4 y = v[q][j] * rstd * gp[64 * j] + shp[64 * j];
                          *((unsigned*)(N28 + (size_t)row * D) + lane + 64 * j) = pk_fp8x4(y.x, y.y, y.z, y.w);
                          v2u w; w.x = cvt_pk_bf16(y.x, y.y); w.y = cvt_pk_bf16(y.z, y.w);
                          *(LAS v2u*)(At + rl * 4096 + ((((lane >> 1) + 32 * j) ^ (rl & 15)) << 4) + ((lane & 1) << 3)) = w; } } } }
            __syncthreads();
            { const int i = lane & 15, kq = lane >> 4;
                f32x4 acc[2][3];
#pragma unroll
                for (int mt = 0; mt < 2; ++mt)
#pragma unroll
                    for (int nt = 0; nt < 3; ++nt) acc[mt][nt] = (f32x4){0.f, 0.f, 0.f, 0.f};
                unsigned voff = (unsigned)((wave * 8) * (2 * 48 * 32) + i * 32 + 8 * kq) * 2u;
#pragma unroll 1
                for (int ks = 0; ks < 8; ++ks, voff += 6144u) { const int kg = wave * 8 + ks;
                    bf16x8 wh[3], wl[3];
                    const char* ph = (const char*)RT + voff; const char* pl = ph + 3072;
#pragma unroll
                    for (int nt = 0; nt < 3; ++nt) { wh[nt] = *(const bf16x8*)(ph + nt * 1024); wl[nt] = *(const bf16x8*)(pl + nt * 1024); }
#pragma unroll
                    for (int mt = 0; mt < 2; ++mt) { const bf16x8 af = *(const LAS bf16x8*)(At + (16 * mt + i) * 4096 + (((4 * kg + kq) ^ i) << 4));
#pragma unroll
                        for (int nt = 0; nt < 3; ++nt) { acc[mt][nt] = __builtin_amdgcn_mfma_f32_16x16x32_bf16(af, wh[nt], acc[mt][nt], 0, 0, 0); acc[mt][nt] = __builtin_amdgcn_mfma_f32_16x16x32_bf16(af, wl[nt], acc[mt][nt], 0, 0, 0); } } }
                __syncthreads();
                LAS float* part = (LAS float*)At + wave * 1536;
#pragma unroll
                for (int mt = 0; mt < 2; ++mt)
#pragma unroll
                    for (int nt = 0; nt < 3; ++nt)
#pragma unroll
                        for (int e = 0; e < 4; ++e) part[(16 * mt + 4 * kq + e) * 48 + nt * 16 + i] = acc[mt][nt][e];
                __syncthreads();
#pragma unroll
                for (int q = 0; q < 3; ++q) { const int idx = tid + 512 * q; float sum = 0.f;
#pragma unroll
                    for (int w8 = 0; w8 < 8; ++w8) sum += ((const LAS float*)At)[w8 * 1536 + idx];
                    lgx[ps * 1536 + idx] = sum; }
                __syncthreads(); }
        }
        if (wave == 7) {
            const LAS float* l = lgx + lane * 48; const int tokn = row0 + lane;
            float gl[4]; int gs = 0; float gmax;
#pragma unroll
            for (int q = 0; q < 4; ++q) gl[q] = l[q] + b_rg[q];
            gmax = gl[0];
#pragma unroll
            for (int q = 1; q < 4; ++q) if (gl[q] > gmax) { gmax = gl[q]; gs = q; }
            float den = 0.f;
#pragma unroll
            for (int q = 0; q < 4; ++q) den += __expf(gl[q] - gmax);
            const float pg = 1.0f / den;
            float v0 = -3.0e38f, v1 = -3.0e38f; int i0 = 0, i1 = 0;
#pragma unroll
            for (int q = 0; q < 8; ++q) { const float ev = l[4 + gs * 8 + q] + b_re[gs * 8 + q];
                if (ev > v0) { v1 = v0; i1 = i0; v0 = ev; i0 = q; } else if (ev > v1) { v1 = ev; i1 = q; } }
            const float t = __expf(v1 - v0), w0 = pg / (1.0f + t), w1 = pg * t / (1.0f + t);
            const int e0 = gs * 8 + i0, e1 = gs * 8 + i1;
            const int p0 = (int)__hip_atomic_fetch_add(ctl + CW_CNT + 64 * e0, 1u, RLX_AGENT);
            const int p1 = (int)__hip_atomic_fetch_add(ctl + CW_CNT + 64 * e1, 1u, RLX_AGENT);
            elist[e0 * LCAP + p0] = tokn; elist[e1 * LCAP + p1] = tokn;
            tok_e[2 * tokn] = e0; tok_e[2 * tokn + 1] = e1; tok_p[2 * tokn] = p0; tok_p[2 * tokn + 1] = p1; tok_w[2 * tokn] = w0; tok_w[2 * tokn + 1] = w1;
        }
    }
    GRID_BAR();
    }

    LAS int* bstart = (LAS int*)(lds + TAB_OFF); LAS int* cntl = (LAS int*)(lds + TAB_OFF + 256);
    { const int t = ltid(wave0);
      if (t < 64) { gu32* ctl = (gu32*)(kargs()->ws + WS_CTL);
          const int c = (t < NEXP) ? (int)__hip_atomic_load(ctl + CW_CNT + 64 * (t & 31), RLX_AGENT) : 0, nb = (c + 255) >> 8;
          int incl = nb;
#pragma unroll
          for (int o = 1; o < 32; o <<= 1) { const int v = __shfl_up(incl, o); if (t >= o) incl += v; }
          if (t < NEXP) { cntl[t] = c; bstart[t] = incl - nb; if (t == NEXP - 1) bstart[NEXP] = incl; } } }
    __syncthreads();
    const int RB = bstart[NEXP];
    DUPLOOP(7) {
        ArgsP A = kargs(); unsigned char* ws = A->ws; const int tid = ltid(wave0), lane = tid & 63, wave = __builtin_amdgcn_readfirstlane(tid >> 6); (void)lane; (void)wave;
        const int* elist = WSP(int, WS_LIST);
        pg8::MoeSched S{bstart, cntl, elist, 4, RB * 4, G, VCU, D / 128, (const char*)(ws + WS_WGU8), (size_t)1024 * D, (size_t)256 * D, true};
        pg8::EpiSwiGLU E{ws + WS_HID8};
        pg8::gemm_phase<true>(lds, (const char*)(ws + WS_N2F8), D, S, E, tid);
        GRID_BAR();
    }
    DUPLOOP(8) {
        ArgsP A = kargs(); unsigned char* ws = A->ws; const int tid = ltid(wave0), lane = tid & 63, wave = __builtin_amdgcn_readfirstlane(tid >> 6); (void)lane; (void)wave;
        const int* elist = WSP(int, WS_LIST);
        pg8::MoeSched S{bstart, cntl, elist, 8, RB * 8, G, VCU, DFF / 128, (const char*)(ws + WS_WD8), (size_t)D * DFF, (size_t)256 * DFF, false};
        pg8::EpiStoreF8 E{ws + WS_YROW};
        pg8::gemm_phase<true>(lds, (const char*)(ws + WS_HID8), DFF, S, E, tid);
        GRID_BAR();
    }

    DUPLOOP(9)
    {
        ArgsP A = kargs(); unsigned char* ws = A->ws; const int tid = ltid(wave0), lane = tid & 63, wave = __builtin_amdgcn_readfirstlane(tid >> 6); (void)lane; (void)wave;
        float* out = A->out; const float* x = A->in[0]; const bf16* DELTA = WSP(bf16, WS_DELTA); const float* g_fin = A->in[22]; const float* ada = WSP(float, WS_ADA); const unsigned char* YROW = ws + WS_YROW;
        const int* tok_e = WSP(int, WS_TOKE); const int* tok_p = WSP(int, WS_TOKP); const float* tok_w = WSP(float, WS_TOKW);
        const bool poison = __hip_atomic_load((gu32*)(ws + WS_CTL) + CW_BAR + XB_TMO, RLX_AGENT) != 0u;
        LAS float* tgf = (LAS float*)lds; LAS float* tgn = tgf + D;
        { const int b0 = (VCU * NWAVES * 8) >> 12; for (int i = tid; i < D; i += NWAVES * 64) { tgf[i] = ada[(size_t)b0 * 12288 + 10240 + i]; tgn[i] = g_fin[i]; } }
        __syncthreads();
        for (int rr = 0; rr < 8; ++rr) {
            const int row = (VCU * NWAVES + wave) * 8 + rr;
            const int e0 = tok_e[2 * row], e1 = tok_e[2 * row + 1];
            const size_t s0 = (size_t)(bstart[e0] * 256 + tok_p[2 * row]), s1 = (size_t)(bstart[e1] * 256 + tok_p[2 * row + 1]);
            const float w0 = tok_w[2 * row] * (1.0f / (float)(1 << pg8::Y8_SHIFT)), w1 = tok_w[2 * row + 1] * (1.0f / (float)(1 << pg8::Y8_SHIFT));
            f32x4* hr = (f32x4*)(out + (size_t)row * D) + lane; const f32x4* xr = (const f32x4*)(x + (size_t)row * D) + lane; const v2u* dr = (const v2u*)(DELTA + (size_t)row * D) + lane;
            const unsigned* y0 = (const unsigned*)(YROW + s0 * D) + lane; const unsigned* y1 = (const unsigned*)(YROW + s1 * D) + lane;
            const LAS f32x4* gf = (const LAS f32x4*)tgf + lane;
            f32x4 v[8]; float ss = 0.f;
#pragma unroll
            for (int j = 0; j < 8; ++j) { const v2u dl = dr[64 * j]; const f32x4 hv = xr[64 * j] + (f32x4){bflo(dl.x), bfhi(dl.x), bflo(dl.y), bfhi(dl.y)}, gg = gf[64 * j]; const unsigned a = y0[64 * j], c = y1[64 * j];
                const f32x2 a0 = __builtin_amdgcn_cvt_pk_f32_fp8((int)a, false), a1 = __builtin_amdgcn_cvt_pk_f32_fp8((int)a, true), c0 = __builtin_amdgcn_cvt_pk_f32_fp8((int)c, false), c1 = __builtin_amdgcn_cvt_pk_f32_fp8((int)c, true);
                f32x4 y; y.x = w0 * a0.x + w1 * c0.x; y.y = w0 * a0.y + w1 * c0.y; y.z = w0 * a1.x + w1 * c1.x; y.w = w0 * a1.y + w1 * c1.y;
                v[j] = hv + gg * y; ss += (v[j].x * v[j].x + v[j].y * v[j].y) + (v[j].z * v[j].z + v[j].w * v[j].w); }
            const float rstd = rsqrtf(wave_sum(ss) * (1.f / D) + EPS);
#pragma unroll
            for (int j = 0; j < 8; ++j) { const f32x4 gg = *((const LAS f32x4*)tgn + lane + 64 * j); hr[64 * j] = poison ? (f32x4){__builtin_nanf(""), __builtin_nanf(""), __builtin_nanf(""), __builtin_nanf("")} : v[j] * rstd * gg; }
        }
    }
}

extern "C" void kernel_launch(void* const* d_in, const int* in_sizes, int n_in, void* d_out, int out_size, void* d_ws, size_t ws_size, hipStream_t stream) {
    static int grid = 0;
    if (grid == 0) {
        if (n_in != 23 || in_sizes[0] != T * D || out_size != T * D || ws_size < WS_END) { fprintf(stderr, "kernel_launch: unexpected shapes (n_in %d, out %d, ws %zu)\n", n_in, out_size, ws_size); grid = -1; return; }
        int dev = 0, cus = 0, per_cu = 0;
        if (hipGetDevice(&dev) != hipSuccess || hipDeviceGetAttribute(&cus, hipDeviceAttributeMultiprocessorCount, dev) != hipSuccess) { grid = -1; return; }
        if (hipFuncSetAttribute((const void*)fwd_kernel, hipFuncAttributeMaxDynamicSharedMemorySize, LDS_BYTES) != hipSuccess) { fprintf(stderr, "kernel_launch: hipFuncSetAttribute failed\n"); grid = -1; return; }
        if (hipOccupancyMaxActiveBlocksPerMultiprocessor(&per_cu, (const void*)fwd_kernel, NWAVES * 64, LDS_BYTES) != hipSuccess || per_cu < 1) fprintf(stderr, "kernel_launch: occupancy query reports %d\n", per_cu);
        (void)hipGetLastError();
        grid = cus;
        if (grid != 256) { fprintf(stderr, "kernel_launch: this kernel is built for 256 CUs, got %d\n", grid); grid = -1; return; }
    }
    if (grid < 0) return;
    (void)hipMemsetAsync((char*)d_ws + WS_CTL, 0, CTL_ZERO_BYTES, stream);
    Args a{};
    for (int i = 0; i < 23; ++i) a.in[i] = (const float*)d_in[i];
    a.out = (float*)d_out; a.ws = (unsigned char*)d_ws;
    hipLaunchKernelGGL(fwd_kernel, dim3(grid), dim3(NWAVES * 64), LDS_BYTES, stream, a);
}
```

```cpp
#include <hip/hip_runtime.h>
#include <cstdio>
#include <cstdint>

#define GAS __attribute__((address_space(1)))
#define LAS __attribute__((address_space(3)))
typedef unsigned short bf16;
typedef unsigned v4u __attribute__((ext_vector_type(4)));
typedef unsigned v2u __attribute__((ext_vector_type(2)));
typedef float f32x2 __attribute__((ext_vector_type(2)));
typedef float f32x4 __attribute__((ext_vector_type(4)));
typedef float f32x16 __attribute__((ext_vector_type(16)));
typedef short bf16x8 __attribute__((ext_vector_type(8)));
typedef short s16x4 __attribute__((ext_vector_type(4)));
typedef GAS unsigned gu32;
#define RLX_AGENT __ATOMIC_RELAXED, __HIP_MEMORY_SCOPE_AGENT
#define LDS_WAIT() asm volatile("s_waitcnt lgkmcnt(0)" ::: "memory")
#define VM_WAIT() asm volatile("s_waitcnt vmcnt(0)" ::: "memory")

constexpr int BATCH = 4, SEQ = 4096, T = BATCH * SEQ, D = 2048;
constexpr int SGW = 1024, NHEAD = 16, HD = 128, INC = 12288;
constexpr int NEXP = 32, DFF = 512, LCAP = 16384;
constexpr float EPS = 1e-6f;
constexpr int NWAVES = 8;
#ifndef PROBE_DUP
#define PROBE_DUP 0
#endif
#define DUPLOOP(k) for (int rep_ = 0; rep_ < (((PROBE_DUP) >> (k)) & 1) + 1; ++rep_)

constexpr size_t MiB = 1u << 20;
constexpr size_t WS_CTL = 0, CTL_ZERO_BYTES = 1 * MiB;
constexpr size_t WS_ADAP = 1 * MiB;
constexpr size_t WS_ADA = 1 * MiB + 786432;
constexpr size_t WS_COS = 2 * MiB, WS_SIN = 6 * MiB;
constexpr size_t WS_KM = 10 * MiB;
constexpr size_t WS_WS = 10 * MiB + 512 * 1024;
constexpr size_t WS_RT = 11 * MiB;
constexpr size_t WS_TOKE = 12 * MiB, WS_TOKP = WS_TOKE + 128 * 1024, WS_TOKW = WS_TOKP + 128 * 1024;
constexpr size_t WS_LIST = 13 * MiB;
constexpr size_t WS_WINZ = 16 * MiB;
constexpr size_t WS_WIN8 = 24 * MiB;
constexpr size_t WS_WSO = 48 * MiB;
constexpr size_t WS_WMO8 = 52 * MiB;
constexpr size_t WS_WOUT = 60 * MiB;
constexpr size_t WS_WGU8 = 68 * MiB;
constexpr size_t WS_WD8 = 132 * MiB;
constexpr size_t WS_N = 164 * MiB;
constexpr size_t WS_N1F8 = 228 * MiB;
constexpr size_t WS_UV = 260 * MiB;
constexpr size_t WS_Q = 324 * MiB, WS_K = 388 * MiB, WS_V = 452 * MiB;
constexpr size_t WS_SA = 516 * MiB, WS_SB = 580 * MiB;
constexpr size_t WS_END = 644 * MiB;
constexpr size_t WS_Q8 = WS_Q, WS_K8 = WS_K, WS_VT8 = WS_V;
constexpr size_t WS_SGUO = WS_N, WS_O8 = WS_N + 32 * MiB, WS_N2F8 = WS_UV, WS_MERGED = WS_UV, WS_HID8 = WS_N, WS_YROW = WS_Q, WS_DELTA = WS_SA;
constexpr int CW_BAR = 4096, CW_QUEUE = 8192, CW_CNT = 8192 + 64;
constexpr int CW_XLB = 14336;
constexpr int CW_P7A = 12288, CW_P7B = 12288 + 1024;

constexpr int RING_BYTES = 131072, LDSCTL_OFF = RING_BYTES, MISC_OFF = LDSCTL_OFF + 320, TAB_OFF = LDSCTL_OFF + 1024;
constexpr int LDS_BYTES = 163840;

__device__ __forceinline__ unsigned f2bf(float f) { unsigned u = __builtin_bit_cast(unsigned, f); return (u + 0x7fffu + ((u >> 16) & 1u)) >> 16; }
__device__ __forceinline__ unsigned pk2(float lo, float hi) { return f2bf(lo) | (f2bf(hi) << 16); }
typedef __bf16 bf16x2_t __attribute__((ext_vector_type(2)));
__device__ __forceinline__ unsigned cvt_pk_bf16(float lo, float hi) { f32x2 v = {lo, hi}; bf16x2_t b = __builtin_convertvector(v, bf16x2_t); return __builtin_bit_cast(unsigned, b); }
__device__ __forceinline__ unsigned pk_fp8x4(float a, float b, float c, float d) { unsigned w = 0u; w = __builtin_amdgcn_cvt_pk_fp8_f32(a, b, w, false); w = __builtin_amdgcn_cvt_pk_fp8_f32(c, d, w, true); return w; }
__device__ __forceinline__ float bflo(unsigned w) { return __builtin_bit_cast(float, w << 16); }
__device__ __forceinline__ float bfhi(unsigned w) { return __builtin_bit_cast(float, w & 0xffff0000u); }
__device__ __forceinline__ float wave_sum(float v) {
#pragma unroll
    for (int o = 1; o < 64; o <<= 1) v += __shfl_xor(v, o);
    return v;
}
__device__ __forceinline__ float fast_sigmoid(float x) { return __builtin_amdgcn_rcpf(1.0f + __builtin_amdgcn_exp2f(-1.4426950408889634f * x)); }
__device__ __forceinline__ float gelu_tanh(float x) { const float u = x * (1.0f + 0.044715f * x * x); return x * __builtin_amdgcn_rcpf(1.0f + __builtin_amdgcn_exp2f(-2.3022081985f * u)); }

#define XB_TMO      128
#define XB_XCNT(j)  (256  + 64 * (j))
#define XB_XSUB(j)  (1280 + 64 * (j))
#define XB_XGEN(j)  (2304 + 64 * (j))
#define XB_TOP      3328
#define XB_TOPGEN   3392
#define XCD_BAR_WORDS 3456
#define XB_SPIN_CAP (1u << 18)
__device__ __forceinline__ unsigned xb_ld(unsigned* p)              { return __hip_atomic_load(p, __ATOMIC_RELAXED, __HIP_MEMORY_SCOPE_AGENT); }
__device__ __forceinline__ unsigned xb_add(unsigned* p, unsigned v) { return __hip_atomic_fetch_add(p, v, __ATOMIC_RELAXED, __HIP_MEMORY_SCOPE_AGENT); }
__device__ __forceinline__ unsigned xb_xcc_id() { return (unsigned)__builtin_amdgcn_s_getreg((3 << 11) | 20) & 0xFu; }
#define XB_SPIN(cond, bar) do { unsigned _sp = 0; while (cond) { __builtin_amdgcn_s_sleep(1); \
    if ((++_sp & 255u) == 0u) { if (xb_ld(&(bar)[XB_TMO])) break; if (_sp > XB_SPIN_CAP) { atomicAdd(&(bar)[XB_TMO], 1u); break; } } } } while (0)
struct XcdBarrier { unsigned* bar; unsigned x; volatile LAS unsigned* st; };
__device__ __forceinline__ XcdBarrier xcd_barrier_post(unsigned* bar, volatile LAS unsigned* st, int tid) {
    XcdBarrier b; b.bar = bar; b.x = xb_xcc_id(); b.st = st;
    if (tid == 0) (void)xb_add(&bar[XB_XCNT(b.x)], 1u);
    return b;
}
__device__ __forceinline__ void xcd_barrier_complete(unsigned* bar, unsigned x, unsigned& nloc, unsigned& nx) {
    const unsigned G = gridDim.x * gridDim.y * gridDim.z;
    unsigned sum, cnt, mine, sp = 0u;
    for (;;) {
        sum = 0u; cnt = 0u; mine = 0u;
#pragma unroll
        for (unsigned j = 0; j < 16; ++j) { const unsigned c = xb_ld(&bar[XB_XCNT(j)]); sum += c; cnt += (c > 0u) ? 1u : 0u; mine = (j == x) ? c : mine; }
        if (sum == G) break;
        __builtin_amdgcn_s_sleep(1);
        if ((++sp & 255u) == 0u) { if (xb_ld(&bar[XB_TMO])) break; if (sp > XB_SPIN_CAP) { atomicAdd(&bar[XB_TMO], 1u); break; } }
    }
    nloc = mine > 0u ? mine : 1u; nx = cnt > 0u ? cnt : 1u;
}
__device__ __forceinline__ void xcd_barrier(const XcdBarrier& b, int tid) {
    asm volatile("s_waitcnt vmcnt(0)" ::: "memory");
    __syncthreads();
    if (tid == 0) {
        unsigned* bar = b.bar;
        __builtin_amdgcn_s_waitcnt(0);
        unsigned nloc = b.st[0], nx = b.st[1];
        if (nloc == 0u) { xcd_barrier_complete(bar, b.x, nloc, nx); b.st[0] = nloc; b.st[1] = nx; }
        const unsigned old = xb_add(&bar[XB_XSUB(b.x)], 1u);
        const unsigned gen = old / nloc;
        if (old + 1u == (gen + 1u) * nloc) {
            __builtin_amdgcn_fence(__ATOMIC_RELEASE, "agent");
            asm volatile("s_waitcnt vmcnt(0)" ::: "memory");
            const unsigned og = xb_add(&bar[XB_TOP], 1u);
            const unsigned tg = og / nx;
            __builtin_amdgcn_fence(__ATOMIC_ACQUIRE, "agent");
            if (og + 1u == (tg + 1u) * nx) xb_add(&bar[XB_TOPGEN], 1u);
            else XB_SPIN(xb_ld(&bar[XB_TOPGEN]) == tg, bar);
            xb_add(&bar[XB_XGEN(b.x)], 1u);
            asm volatile("s_waitcnt vmcnt(0)" ::: "memory");
        } else {
            __builtin_amdgcn_fence(__ATOMIC_ACQUIRE, "agent");
            XB_SPIN(xb_ld(&bar[XB_XGEN(b.x)]) == gen, bar);
            asm volatile("s_waitcnt vmcnt(0)" ::: "memory");
        }
    }
    __syncthreads();
}

namespace pg8 {
constexpr int BM = 256, BK = 64, HALF = 128, HTB = HALF * BK * 2, STAGE_BYTES = 8 * HTB, NXCD = 8, WGM = 4;
__device__ __forceinline__ int lds_byte(int r, int c) { const int st = (r >> 4) * 2 + (c >> 5), rr = r & 15, cc = c & 31, ob = rr * 64 + cc * 2; return st * 1024 + (ob ^ (((ob >> 9) & 1) << 5)); }
__device__ __forceinline__ void stage_rc(int b, int& R, int& C) { const int st = b / 1024, sb = b % 1024, swz = sb ^ (((sb >> 9) & 1) << 5); R = (st >> 1) * 16 + swz / 64; C = (st & 1) * 32 + (swz % 64) / 2; }
__device__ __forceinline__ int perm32(int rho) { const int n = rho >> 4, i = rho & 15; return 8 * (i >> 2) + 4 * n + (i & 3); }
typedef int v8i __attribute__((ext_vector_type(8)));
typedef int v4i __attribute__((ext_vector_type(4)));
constexpr int M8_SHIFT = 4;
constexpr int W8_SHIFT = 5;
__device__ __forceinline__ v8i cat8(bf16x8 lo, bf16x8 hi) { const v4i a = __builtin_bit_cast(v4i, lo), b = __builtin_bit_cast(v4i, hi); return __builtin_shufflevector(a, b, 0, 1, 2, 3, 4, 5, 6, 7); }
struct Unit { int pm, pn, ex, kt0, nkt; };

struct StaticOrder {
    int nM, nN, nwg, G, c, nkt; const char* Bt; size_t tstepB;
    __device__ __forceinline__ void init(int M, int N, int rowbytes, int G_, int c_, const void* Bt_) { nM = M / BM; nN = N / BM; nwg = nM * nN; G = G_; c = c_; Bt = (const char*)Bt_; tstepB = (size_t)BM * rowbytes; nkt = rowbytes / 128; }
    __device__ __forceinline__ bool next(int i, Unit& u) const {
        const long L = (long)i * G + c; if (L >= nwg) return false;
        int wgid = (int)L; { const int q = nwg / NXCD, r = nwg % NXCD, xcd = wgid % NXCD, off = wgid / NXCD; wgid = (xcd < r ? xcd * (q + 1) : r * (q + 1) + (xcd - r) * q) + off; }
        const int nig = WGM * nN, gid = wgid / nig, fm = gid * WGM, gsz = (nM - fm) < WGM ? (nM - fm) : WGM;
        u.pm = fm + ((wgid % nig) % gsz); u.pn = (wgid % nig) / gsz; u.ex = 0; u.kt0 = 0; u.nkt = nkt; return true;
    }
    __device__ __forceinline__ const char* b_ptr(const Unit& u) const { return Bt + (size_t)u.pn * tstepB; }
    __device__ __forceinline__ unsigned a_row(const Unit& u, int r) const { return (unsigned)(u.pm * BM + r); }
};

template <bool F8, class Epi, class Sched>
__device__ __forceinline__ void gemm_phase(LAS unsigned char* lds, const char* Ab, const int rowbytes, const Sched& S, const Epi& E, const int tid, const int a8shift = 0) {
    const int wid = __builtin_amdgcn_readfirstlane(tid >> 6), lane = tid & 63, wr = wid >> 2, wc = wid & 3, fr = lane & 15, fq = lane >> 4;
    int Rs[2]; unsigned Cs[2], voffB[2];
#pragma unroll
    for (int i = 0; i < 2; ++i) { int R, C; stage_rc(tid * 16 + i * 8192, R, C); const int Rb = Epi::ADJ ? ((R >> 5) * 64 + perm32(R & 31)) : Epi::PERM ? ((R & ~31) + perm32(R & 31)) : R;
        Rs[i] = R; Cs[i] = (unsigned)C * 2u; voffB[i] = (unsigned)(Rb * rowbytes + C * 2); }
    const size_t kstep = (size_t)(BK * 2);
    const size_t hstep = (size_t)(Epi::ADJ ? 32 : HALF) * rowbytes;
    const unsigned rowb = (unsigned)rowbytes;
    const unsigned ldsw = (unsigned)wid * 1024u;
    const int aoff = lds_byte(wr * 64 + fr, fq * 8), boff = lds_byte(wc * 32 + fr, fq * 8);
#define PG8_SA(b, h) (((b) * 2 + (h)) * HTB)
#define PG8_SB(b, h) ((4 + (b) * 2 + (h)) * HTB)
#define PG8_STAGE_B(bufoff, gbase) do { _Pragma("unroll") for (int _i = 0; _i < 2; ++_i) \
        __builtin_amdgcn_global_load_lds((const unsigned*)((const char*)(gbase) + voffB[_i]), (LAS unsigned*)(lds + (bufoff) + ldsw + _i * 8192), 16, 0, 0); } while (0)
#define PG8_STAGE_A(bufoff, kbyte, h) do { _Pragma("unroll") for (int _i = 0; _i < 2; ++_i) \
        __builtin_amdgcn_global_load_lds((const unsigned*)(Ab + (kbyte) + vC[h][_i]), (LAS unsigned*)(lds + (bufoff) + ldsw + _i * 8192), 16, 0, 0); } while (0)
#define PG8_LDA(dst, b, h) do { _Pragma("unroll") for (int m = 0; m < 4; ++m) _Pragma("unroll") for (int k = 0; k < 2; ++k) dst[m][k] = *(const LAS bf16x8*)(lds + PG8_SA(b, h) + aoff + m * 2048 + k * 1024); } while (0)
#define PG8_LDB(dst, b, h) do { _Pragma("unroll") for (int n = 0; n < 2; ++n) _Pragma("unroll") for (int k = 0; k < 2; ++k) dst[n][k] = *(const LAS bf16x8*)(lds + PG8_SB(b, h) + boff + n * 2048 + k * 1024); } while (0)
#define PG8_MMA(ai, bj, At, Bt) do { __builtin_amdgcn_s_setprio(1); _Pragma("unroll") for (int m = 0; m < 4; ++m) _Pragma("unroll") for (int n = 0; n < 2; ++n) { \
        if constexpr (F8) acc[ai][bj][m][n] = __builtin_amdgcn_mfma_scale_f32_16x16x128_f8f6f4(cat8(Bt[n][0], Bt[n][1]), cat8(At[m][0], At[m][1]), acc[ai][bj][m][n], 0, 0, 0, 127 - W8_SHIFT, 0, 127 - a8shift); \
        else { _Pragma("unroll") for (int k = 0; k < 2; ++k) acc[ai][bj][m][n] = __builtin_amdgcn_mfma_f32_16x16x32_bf16(Bt[n][k], At[m][k], acc[ai][bj][m][n], 0, 0, 0); } } __builtin_amdgcn_s_setprio(0); } while (0)
#define PG8_WAIT_V(n) asm volatile("s_waitcnt vmcnt(" #n ")" ::: "memory")
#define PG8_WAIT_L(n) asm volatile("s_waitcnt lgkmcnt(" #n ")" ::: "memory")
#define PG8_BAR __builtin_amdgcn_s_barrier()
#define PG8_SCHED __builtin_amdgcn_sched_barrier(0)
    Unit cur, nxt; int ui = 0;
    if (!S.next(0, cur)) return;
    f32x4 acc[2][2][4][2];
#pragma unroll
    for (int a = 0; a < 2; ++a)
#pragma unroll
        for (int b = 0; b < 2; ++b)
#pragma unroll
            for (int m = 0; m < 4; ++m)
#pragma unroll
                for (int n = 0; n < 2; ++n) acc[a][b][m][n] = (f32x4){0.f, 0.f, 0.f, 0.f};
    bf16x8 At[4][2], B0[2][2], B1[2][2];
    unsigned vC[2][2], vN[2][2];
#pragma unroll
    for (int h = 0; h < 2; ++h)
#pragma unroll
        for (int i = 0; i < 2; ++i) vC[h][i] = S.a_row(cur, h * HALF + Rs[i]) * rowb + Cs[i];
    const char* cB = S.b_ptr(cur) + (size_t)cur.kt0 * kstep; size_t kc = (size_t)cur.kt0 * kstep; int nt = cur.nkt;
    PG8_STAGE_B(PG8_SB(0, 0), cB); PG8_STAGE_B(PG8_SB(0, 1), cB + hstep); PG8_STAGE_A(PG8_SA(0, 0), kc, 0); PG8_STAGE_A(PG8_SA(0, 1), kc, 1);
    if (wr == 1) PG8_BAR;
    PG8_WAIT_V(2); PG8_BAR;
    PG8_STAGE_B(PG8_SB(1, 0), cB + kstep); PG8_STAGE_A(PG8_SA(1, 0), kc + kstep, 0); PG8_STAGE_B(PG8_SB(1, 1), cB + hstep + kstep);
    PG8_WAIT_V(6); PG8_BAR;
    for (;;) {
        const bool has_next = S.next(ui + 1, nxt);
        const char* nB = has_next ? S.b_ptr(nxt) + (size_t)nxt.kt0 * kstep : cB; const size_t kn = has_next ? (size_t)nxt.kt0 * kstep : kc;
#pragma unroll
        for (int h = 0; h < 2; ++h)
#pragma unroll
            for (int i = 0; i < 2; ++i) vN[h][i] = S.a_row(has_next ? nxt : cur, h * HALF + Rs[i]) * rowb + Cs[i];
        for (int t = 0; t < nt; t += 2) {
            const bool last = (t == nt - 2);
            const size_t ka1 = kc + (size_t)(t + 1) * kstep;
            const size_t ka2 = last ? kn : kc + (size_t)(t + 2) * kstep;
            const char* b2 = last ? nB : cB + (size_t)(t + 2) * kstep; const char* b3 = b2 + kstep;
            PG8_LDB(B0, 0, 0); PG8_LDB(B1, 0, 1); PG8_SCHED; PG8_LDA(At, 0, 0); PG8_STAGE_A(PG8_SA(1, 1), ka1, 1);
            if (last) {
#pragma unroll
                for (int h = 0; h < 2; ++h)
#pragma unroll
                    for (int i = 0; i < 2; ++i) vC[h][i] = vN[h][i];
            }
            PG8_WAIT_V(8); PG8_WAIT_L(0); PG8_BAR; PG8_MMA(0, 0, At, B0); PG8_MMA(0, 1, At, B1); PG8_BAR; PG8_SCHED;
            PG8_LDA(At, 0, 1); PG8_STAGE_B(PG8_SB(0, 0), b2); PG8_STAGE_B(PG8_SB(0, 1), b2 + hstep); PG8_STAGE_A(PG8_SA(0, 0), ka2, 0);
            PG8_WAIT_V(8); PG8_WAIT_L(0); PG8_BAR; PG8_MMA(1, 0, At, B0); PG8_MMA(1, 1, At, B1); PG8_BAR; PG8_SCHED;
            PG8_LDB(B0, 1, 0); PG8_LDB(B1, 1, 1); PG8_SCHED; PG8_LDA(At, 1, 0); PG8_STAGE_A(PG8_SA(0, 1), ka2, 1);
            PG8_WAIT_V(8); PG8_WAIT_L(0); PG8_BAR; PG8_MMA(0, 0, At, B0); PG8_MMA(0, 1, At, B1); PG8_BAR; PG8_SCHED;
            PG8_LDA(At, 1, 1); PG8_STAGE_B(PG8_SB(1, 0), b3); PG8_STAGE_B(PG8_SB(1, 1), b3 + hstep); PG8_STAGE_A(PG8_SA(1, 0), ka2 + kstep, 0);
            PG8_WAIT_V(8); PG8_WAIT_L(0); PG8_BAR; PG8_MMA(1, 0, At, B0); PG8_MMA(1, 1, At, B1); PG8_BAR; PG8_SCHED;
        }
        if (wr == 0) PG8_BAR;
        E(acc, cur, wr, wc, fr, fq);
        if (!has_next) break;
#pragma unroll
        for (int a = 0; a < 2; ++a)
#pragma unroll
            for (int b = 0; b < 2; ++b)
#pragma unroll
                for (int m = 0; m < 4; ++m)
#pragma unroll
                    for (int n = 0; n < 2; ++n) acc[a][b][m][n] = (f32x4){0.f, 0.f, 0.f, 0.f};
        cur = nxt; cB = nB; kc = kn; nt = cur.nkt; ++ui;
        if (wr == 1) PG8_BAR;
    }
    PG8_WAIT_V(0);
    PG8_BAR;
#undef PG8_SA
#undef PG8_SB
#undef PG8_STAGE_A
#undef PG8_STAGE_B
#undef PG8_LDA
#undef PG8_LDB
#undef PG8_MMA
#undef PG8_WAIT_V
#undef PG8_WAIT_L
#undef PG8_BAR
#undef PG8_SCHED
}

typedef const f32x4 (&AccRef)[2][2][4][2];
__device__ __forceinline__ v4u pair16(v2u w0, v2u w1) { auto rx = __builtin_amdgcn_permlane16_swap(w0.x, w1.x, false, false); auto ry = __builtin_amdgcn_permlane16_swap(w0.y, w1.y, false, false);
    v4u o; o.x = rx[0]; o.y = ry[0]; o.z = rx[1]; o.w = ry[1]; return o; }

struct EpiInProj {
    static constexpr bool PERM = true, ADJ = false;
    bf16* UV; unsigned char* Q8; unsigned char* K8; unsigned char* VT8; bf16* SA; bf16* SB; const float* cosT; const float* sinT; int pn_off;
    __device__ __forceinline__ void operator()(AccRef acc, const Unit& u, int wr, int wc, int fr, int fq) const {
        asm volatile("" : "+v"(fr), "+v"(fq));
        const int pn = u.pn + pn_off, rbase = u.pm * BM + wr * 64 + fr, cl = wc * 32 + 8 * fq;
        if (pn < 8) {
#pragma unroll
            for (int ai = 0; ai < 2; ++ai)
#pragma unroll
                for (int m = 0; m < 4; ++m) { bf16* rp = UV + (size_t)(rbase + ai * HALF + m * 16) * D + pn * BM + cl;
#pragma unroll
                    for (int bj = 0; bj < 2; ++bj) { const f32x4 a = acc[ai][bj][m][0], b = acc[ai][bj][m][1];
                        v4u w; w.x = cvt_pk_bf16(gelu_tanh(a[0]), gelu_tanh(a[1])); w.y = cvt_pk_bf16(gelu_tanh(a[2]), gelu_tanh(a[3]));
                        w.z = cvt_pk_bf16(gelu_tanh(b[0]), gelu_tanh(b[1])); w.w = cvt_pk_bf16(gelu_tanh(b[2]), gelu_tanh(b[3]));
                        *(v4u*)(rp + bj * HALF) = w; } }
        } else if (pn < 24) {
            unsigned char* dst = (pn < 16) ? Q8 : K8; const int hp = ((pn - 8) & 7) * 2, j0 = cl >> 1;
#pragma unroll
            for (int ai = 0; ai < 2; ++ai) {
                f32x4 cc[4], sn[4];
#pragma unroll
                for (int m = 0; m < 4; ++m) { const int row = rbase + ai * HALF + m * 16; cc[m] = *(const f32x4*)(cosT + (size_t)row * 64 + j0); sn[m] = *(const f32x4*)(sinT + (size_t)row * 64 + j0); }
#pragma unroll
                for (int m = 0; m < 4; ++m) { const int row = rbase + ai * HALF + m * 16, b = row >> 12, s = row & 4095;
                    const f32x4 c4 = cc[m], s4 = sn[m];
                    v2u w[2];
#pragma unroll
                    for (int bj = 0; bj < 2; ++bj) { const f32x4 x0 = acc[ai][bj][m][0], x1 = acc[ai][bj][m][1];
                        w[bj].x = pk_fp8x4(x0[0] * c4[0] - x0[1] * s4[0], x0[1] * c4[0] + x0[0] * s4[0], x0[2] * c4[1] - x0[3] * s4[1], x0[3] * c4[1] + x0[2] * s4[1]);
                        w[bj].y = pk_fp8x4(x1[0] * c4[2] - x1[1] * s4[2], x1[1] * c4[2] + x1[0] * s4[2], x1[2] * c4[3] - x1[3] * s4[3], x1[3] * c4[3] + x1[2] * s4[3]); }
                    *(v4u*)(dst + ((size_t)(b * NHEAD + hp + (fq & 1)) * SEQ + s) * HD + wc * 32 + 8 * (fq & ~1)) = pair16(w[0], w[1]); }
            }
        } else if (pn < 32) {
            const int hp = (pn - 24) * 2, lane = fr + 16 * fq, jq = lane & 3, qd = (lane >> 2) & 3; const bool qb1 = (qd & 2) != 0, qb0 = (qd & 1) != 0;
            const int tok0 = u.pm * BM + wr * 64 + 16 * qd, bb = tok0 >> 12;
#pragma unroll
            for (int ai = 0; ai < 2; ++ai)
#pragma unroll
                for (int bj = 0; bj < 2; ++bj) { unsigned d0[4], d1[4];
#pragma unroll
                    for (int m = 0; m < 4; ++m) { const f32x4 a = acc[ai][bj][m][0], c = acc[ai][bj][m][1];
                        const unsigned w0 = pk_fp8x4(a[0], a[1], a[2], a[3]), w1 = pk_fp8x4(c[0], c[1], c[2], c[3]);
                        unsigned o0 = 0u, o1 = 0u;
#define VQ(q) { const unsigned t0 = (unsigned)__builtin_amdgcn_mov_dpp((int)w0, (q) * 0x55, 0xf, 0xf, true), t1 = (unsigned)__builtin_amdgcn_mov_dpp((int)w1, (q) * 0x55, 0xf, 0xf, true); \
                            o0 |= ((t0 >> (8 * jq)) & 0xffu) << (8 * (q)); o1 |= ((t1 >> (8 * jq)) & 0xffu) << (8 * (q)); }
                        VQ(0) VQ(1) VQ(2) VQ(3)
#undef VQ
                        d0[m] = o0; d1[m] = o1; }
#define VX8(x, y) { const unsigned t_ = qb1 ? (x) : (y); const unsigned r_ = (unsigned)__builtin_amdgcn_mov_dpp((int)t_, 0x128, 0xf, 0xf, true); if (qb1) (x) = r_; else (y) = r_; }
#define VX4(x, y) { const unsigned t_ = qb0 ? (x) : (y); const unsigned r_ = (unsigned)__shfl_xor((int)t_, 4); if (qb0) (x) = r_; else (y) = r_; }
                    VX8(d0[0], d0[2]) VX8(d0[1], d0[3]) VX4(d0[0], d0[1]) VX4(d0[2], d0[3])
                    VX8(d1[0], d1[2]) VX8(d1[1], d1[3]) VX4(d1[0], d1[1]) VX4(d1[2], d1[3])
#undef VX8
#undef VX4
                    unsigned char* vp = VT8 + ((size_t)(bb * NHEAD + hp + bj) * HD + cl + jq) * SEQ + ((tok0 + ai * HALF) & 4095);
                    v4u oa; oa.x = d0[0]; oa.y = d0[1]; oa.z = d0[2]; oa.w = d0[3]; *(v4u*)vp = oa;
                    v4u ob; ob.x = d1[0]; ob.y = d1[1]; ob.z = d1[2]; ob.w = d1[3]; *(v4u*)(vp + 4 * SEQ) = ob; }
        } else {
            bf16* dst = (pn < 40) ? SA : SB; const int colt = ((pn - 32) & 7) * BM;
#pragma unroll
            for (int ai = 0; ai < 2; ++ai)
#pragma unroll
                for (int m = 0; m < 4; ++m) { bf16* rp = dst + (size_t)(rbase + ai * HALF + m * 16) * D + colt + cl;
#pragma unroll
                    for (int bj = 0; bj < 2; ++bj) { const f32x4 a = acc[ai][bj][m][0], b = acc[ai][bj][m][1];
                        v4u w; w.x = cvt_pk_bf16(fast_sigmoid(a[0]), fast_sigmoid(a[1])); w.y = cvt_pk_bf16(fast_sigmoid(a[2]), fast_sigmoid(a[3]));
                        w.z = cvt_pk_bf16(fast_sigmoid(b[0]), fast_sigmoid(b[1])); w.w = cvt_pk_bf16(fast_sigmoid(b[2]), fast_sigmoid(b[3]));
                        *(v4u*)(rp + bj * HALF) = w; } }
        }
    }
};
struct EpiGateSeg {
    static constexpr bool PERM = true, ADJ = true;
    const bf16* SAg; const bf16* SBg; bf16* T1; unsigned char* Mg; int seg;
    __device__ __forceinline__ void operator()(AccRef acc, const Unit& u, int wr, int wc, int fr, int fq) const {
        const int rbase = u.pm * BM + wr * 64 + fr, col0 = u.pn * BM + wc * 64 + 8 * fq;
        if (seg == 0) {
#pragma unroll
            for (int ai = 0; ai < 2; ++ai) {
                v4u g[4][2];
#pragma unroll
                for (int m = 0; m < 4; ++m)
#pragma unroll
                    for (int bj = 0; bj < 2; ++bj) g[m][bj] = *(const v4u*)(SAg + (size_t)(rbase + ai * HALF + m * 16) * D + col0 + bj * 32);
#pragma unroll
                for (int m = 0; m < 4; ++m) { const size_t off = (size_t)(rbase + ai * HALF + m * 16) * D + col0;
#pragma unroll
                    for (int bj = 0; bj < 2; ++bj) { const v4u gg = g[m][bj]; const f32x4 a = acc[ai][bj][m][0], b = acc[ai][bj][m][1];
                        v4u w; w.x = cvt_pk_bf16(bflo(gg.x) * a[0], bfhi(gg.x) * a[1]); w.y = cvt_pk_bf16(bflo(gg.y) * a[2], bfhi(gg.y) * a[3]);
                        w.z = cvt_pk_bf16(bflo(gg.z) * b[0], bfhi(gg.z) * b[1]); w.w = cvt_pk_bf16(bflo(gg.w) * b[2], bfhi(gg.w) * b[3]);
                        *(v4u*)(T1 + off + bj * 32) = w; } }
            }
        } else {
#pragma unroll
            for (int ai = 0; ai < 2; ++ai)
#pragma unroll
                for (int mp = 0; mp < 2; ++mp) {
                    v4u tt[2][2], g[2][2];
#pragma unroll
                    for (int mm = 0; mm < 2; ++mm)
#pragma unroll
                        for (int bj = 0; bj < 2; ++bj) { const size_t off = (size_t)(rbase + ai * HALF + (2 * mp + mm) * 16) * D + col0 + bj * 32; tt[mm][bj] = *(const v4u*)(T1 + off); g[mm][bj] = *(const v4u*)(SBg + off); }
#pragma unroll
                    for (int mm = 0; mm < 2; ++mm) { const int m = 2 * mp + mm; const size_t off = (size_t)(rbase + ai * HALF + m * 16) * D + u.pn * BM + wc * 64 + 8 * (fq & ~1) + (fq & 1) * 32;
                        v2u w[2];
#pragma unroll
                        for (int bj = 0; bj < 2; ++bj) { const v4u t = tt[mm][bj], gg = g[mm][bj]; const f32x4 a = acc[ai][bj][m][0], b = acc[ai][bj][m][1];
                            constexpr float MS = (float)(1 << M8_SHIFT);
                            w[bj].x = pk_fp8x4((bflo(t.x) + bflo(gg.x) * a[0]) * MS, (bfhi(t.x) + bfhi(gg.x) * a[1]) * MS, (bflo(t.y) + bflo(gg.y) * a[2]) * MS, (bfhi(t.y) + bfhi(gg.y) * a[3]) * MS);
                            w[bj].y = pk_fp8x4((bflo(t.z) + bflo(gg.z) * b[0]) * MS, (bfhi(t.z) + bfhi(gg.z) * b[1]) * MS, (bflo(t.w) + bflo(gg.w) * b[2]) * MS, (bfhi(t.w) + bfhi(gg.w) * b[3]) * MS); }
                        *(v4u*)(Mg + off) = pair16(w[0], w[1]); }
                }
        }
    }
};
struct EpiDelta {
    static constexpr bool PERM = true, ADJ = true;
    const float* gm; bf16* Dl;
    __device__ __forceinline__ void operator()(AccRef acc, const Unit& u, int wr, int wc, int fr, int fq) const {
        const int rbase = u.pm * BM + wr * 64 + fr, col0 = u.pn * BM + wc * 64 + 8 * fq, b = (u.pm * BM) >> 12;
        f32x4 gv[2][2];
#pragma unroll
        for (int bj = 0; bj < 2; ++bj)
#pragma unroll
            for (int n = 0; n < 2; ++n) gv[bj][n] = *(const f32x4*)(gm + (size_t)b * 12288 + col0 + bj * 32 + 4 * n);
#pragma unroll
        for (int ai = 0; ai < 2; ++ai)
#pragma unroll
            for (int m = 0; m < 4; ++m) { bf16* rp = Dl + (size_t)(rbase + ai * HALF + m * 16) * D + col0;
#pragma unroll
                for (int bj = 0; bj < 2; ++bj) { const f32x4 a = acc[ai][bj][m][0] * gv[bj][0], c = acc[ai][bj][m][1] * gv[bj][1];
                    v4u w; w.x = cvt_pk_bf16(a[0], a[1]); w.y = cvt_pk_bf16(a[2], a[3]); w.z = cvt_pk_bf16(c[0], c[1]); w.w = cvt_pk_bf16(c[2], c[3]);
                    *(v4u*)(rp + bj * 32) = w; } }
    }
};
struct MoeSched {
    const LAS int* bstart; const LAS int* cntl; const int* list; int npn, total, G, c, nkt; const char* Bt; size_t estride, tstepB; bool gather; int rb0;
    __device__ __forceinline__ bool next(int i, Unit& u) const {
        const int L = i * G + c; if (L >= total) return false;
        const int rb = rb0 + L / npn; int e = 0;
        for (int j = 1; j < NEXP; ++j) e += (bstart[j] <= rb) ? 1 : 0;
        u.pm = rb; u.pn = L - (L / npn) * npn; u.ex = e; u.kt0 = 0; u.nkt = nkt; return true;
    }
    __device__ __forceinline__ const char* b_ptr(const Unit& u) const { return Bt + (size_t)u.ex * estride + (size_t)u.pn * tstepB; }
    __device__ __forceinline__ unsigned a_row(const Unit& u, int r) const {
        if (!gather) return (unsigned)(u.pm * BM + r);
        const int pos = (u.pm - bstart[u.ex]) * BM + r, cnt = cntl[u.ex], idx = pos < cnt ? pos : cnt - 1;
        const unsigned v = (unsigned)list[u.ex * LCAP + idx];
        return (pos < cnt) ? v : 0u;
    }
};
struct EpiSwiGLU {
    static constexpr bool PERM = true, ADJ = true;
    unsigned char* HID;
    unsigned* done_a; unsigned* done_b; int rb_late;
    __device__ __forceinline__ void operator()(AccRef acc, const Unit& u, int wr, int wc, int fr, int fq) const {
        const int rbase = u.pm * BM + wr * 64 + fr + 16 * fq, hc0 = u.pn * 128 + wc * 32;
#pragma unroll
        for (int ai = 0; ai < 2; ++ai)
#pragma unroll
            for (int bj = 0; bj < 2; ++bj) { unsigned d[4];
#pragma unroll
                for (int m = 0; m < 4; ++m) { const f32x4 g = acc[ai][bj][m][0], up = acc[ai][bj][m][1];
                    d[m] = pk_fp8x4(g[0] * fast_sigmoid(g[0]) * up[0], g[1] * fast_sigmoid(g[1]) * up[1], g[2] * fast_sigmoid(g[2]) * up[2], g[3] * fast_sigmoid(g[3]) * up[3]); }
                auto p = __builtin_amdgcn_permlane16_swap(d[0], d[1], false, false); auto q = __builtin_amdgcn_permlane16_swap(d[2], d[3], false, false);
                auto s0 = __builtin_amdgcn_permlane32_swap(p[0], q[0], false, false); auto s1 = __builtin_amdgcn_permlane32_swap(p[1], q[1], false, false);
                v4u o; o.x = s0[0]; o.y = s1[0]; o.z = s0[1]; o.w = s1[1];
                *(v4u*)(HID + (size_t)(rbase + ai * HALF) * DFF + hc0 + bj * 16) = o; }
        if (done_a != nullptr) { asm volatile("s_waitcnt vmcnt(0)" ::: "memory");
            if ((fr | fq) == 0) __hip_atomic_fetch_add(u.pm >= rb_late ? done_b : done_a, 1u, __ATOMIC_RELAXED, __HIP_MEMORY_SCOPE_AGENT); }
    }
};
constexpr int Y8_SHIFT = 4;
struct EpiStoreF8 {
    static constexpr bool PERM = true, ADJ = true;
    unsigned char* Y;
    __device__ __forceinline__ void operator()(AccRef acc, const Unit& u, int wr, int wc, int fr, int fq) const {
        const int rbase = u.pm * BM + wr * 64 + fr, col0 = u.pn * BM + wc * 32 + 8 * fq;
        constexpr float YS = (float)(1 << Y8_SHIFT);
#pragma unroll
        for (int ai = 0; ai < 2; ++ai)
#pragma unroll
            for (int m = 0; m < 4; ++m) { unsigned char* rp = Y + (size_t)(rbase + ai * HALF + m * 16) * D + u.pn * BM + wc * 64 + 8 * (fq & ~1) + (fq & 1) * 32;
                v2u w[2];
#pragma unroll
                for (int bj = 0; bj < 2; ++bj) { const f32x4 a = acc[ai][bj][m][0], b = acc[ai][bj][m][1];
                    w[bj].x = pk_fp8x4(a[0] * YS, a[1] * YS, a[2] * YS, a[3] * YS); w[bj].y = pk_fp8x4(b[0] * YS, b[1] * YS, b[2] * YS, b[3] * YS); }
                *(v4u*)rp = pair16(w[0], w[1]); }
    }
};
}

namespace att {
constexpr int NW = 8, QBLK = 32, KVBLK = 64, QB = 256, OP = 2048;
constexpr int KPITCH = 144, VPITCH = 144;
constexpr int SHM_K = 2 * KVBLK * KPITCH, SHM_V = HD * VPITCH;
constexpr int LDS_BYTES = 2 * SHM_V + 2 * SHM_K + NW * 64 * 4;
constexpr float SCALE = 0.08838834764831845f, THR = 4.f;
constexpr int O8_SHIFT = 4;
constexpr int KM_SHIFT = 4;
#define SBAR() __builtin_amdgcn_sched_barrier(0)
typedef pg8::v8i v8i; typedef pg8::v4i v4i;
__device__ __forceinline__ v8i cat32(v4i a, v4i b) { return __builtin_shufflevector(a, b, 0, 1, 2, 3, 4, 5, 6, 7); }
__device__ __forceinline__ v4i ld16(const unsigned char* p) { return *reinterpret_cast<const v4i*>(p); }
__device__ __forceinline__ f32x16 mma8(v8i a, v8i b, f32x16 c) { return __builtin_amdgcn_mfma_scale_f32_32x32x64_f8f6f4(a, b, c, 0, 0, 0, 127, 0, 127); }
__device__ __forceinline__ int crow(int r, int hi) { return (r & 3) + 8 * (r >> 2) + 4 * hi; }
__device__ __forceinline__ void mask_tile(f32x16& p0, f32x16& p1, int dq) {
    const float NEG = -__builtin_inff();
#pragma unroll
    for (int r = 0; r < 16; ++r) {
        const int c = (r & 3) + 8 * (r >> 2);
        if (dq - c < 0) p0[r] = NEG;
        if (dq - c - 32 < 0) p1[r] = NEG;
    }
}
__device__ __forceinline__ void partialSM(f32x16& p0, f32x16& p1, float& m_reg, float& mn, float& alpha, bool keep) {
    float pmax = p0[0];
#pragma unroll
    for (int r = 1; r < 16; ++r) pmax = fmaxf(pmax, p0[r]);
#pragma unroll
    for (int r = 0; r < 16; ++r) pmax = fmaxf(pmax, p1[r]);
    { auto rr = __builtin_amdgcn_permlane32_swap(__float_as_uint(pmax), __float_as_uint(pmax), false, false);
      pmax = fmaxf(__uint_as_float(rr[0]), __uint_as_float(rr[1])); }
    const float NEG = -__builtin_inff();
    pmax = keep ? pmax : NEG;
    constexpr float C2 = 1.4426950408889634f * SCALE;
    if (__builtin_expect(__all((pmax - m_reg) * SCALE <= THR), 1)) { mn = m_reg; alpha = 1.f; }
    else { mn = fmaxf(m_reg, pmax); alpha = __builtin_amdgcn_exp2f((m_reg - mn) * C2); m_reg = mn; }
    const float c2l = keep ? C2 : 0.f;
    const float mnL = keep ? -mn * C2 : NEG;
#pragma unroll
    for (int r = 0; r < 16; ++r) p0[r] = fmaf(p0[r], c2l, mnL);
#pragma unroll
    for (int r = 0; r < 16; ++r) p1[r] = fmaf(p1[r], c2l, mnL);
#pragma unroll
    for (int r = 0; r < 16; ++r) p0[r] = __builtin_amdgcn_exp2f(p0[r]);
}
__device__ __forceinline__ void finishSM(f32x16& p0, f32x16& p1, float alpha, float& l_reg, v8i& pf) {
#pragma unroll
    for (int r = 0; r < 16; ++r) p1[r] = __builtin_amdgcn_exp2f(p1[r]);
    float ps = 0;
#pragma unroll
    for (int r = 0; r < 16; ++r) ps += p0[r];
#pragma unroll
    for (int r = 0; r < 16; ++r) ps += p1[r];
    { auto rr = __builtin_amdgcn_permlane32_swap(__float_as_uint(ps), __float_as_uint(ps), false, false);
      ps = __uint_as_float(rr[0]) + __uint_as_float(rr[1]); }
    l_reg = l_reg * alpha + ps;
#pragma unroll
    for (int q = 0; q < 4; ++q) { pf[q] = (int)pk_fp8x4(p0[4 * q], p0[4 * q + 1], p0[4 * q + 2], p0[4 * q + 3]); pf[4 + q] = (int)pk_fp8x4(p1[4 * q], p1[4 * q + 1], p1[4 * q + 2], p1[4 * q + 3]); }
}
template <int SUB>
__device__ __forceinline__ void qkt(int KB, f32x16& p0, f32x16& p1, const unsigned char* K_lds, int r32, int hi, const v8i* qf) {
    p0 = f32x16{}; p1 = f32x16{};
    const unsigned char* kb = K_lds + KB * SHM_K + (SUB * KVBLK + r32) * KPITCH + hi * 32;
#pragma unroll
    for (int ks = 0; ks < 2; ++ks) {
        const v8i a0 = cat32(ld16(kb + ks * 64), ld16(kb + ks * 64 + 16)), a1 = cat32(ld16(kb + 32 * KPITCH + ks * 64), ld16(kb + 32 * KPITCH + ks * 64 + 16));
        p0 = mma8(a0, qf[ks], p0); p1 = mma8(a1, qf[ks], p1); }
}
template <int SUB>
__device__ __forceinline__ void pv_tile(int VB, f32x16* o, const unsigned char* V_lds, int r32, int hi, v8i pf) {
    const unsigned char* vb = V_lds + VB * SHM_V + r32 * VPITCH + SUB * KVBLK + hi * 32;
#pragma unroll
    for (int d0 = 0; d0 < 4; ++d0) { const v8i a = cat32(ld16(vb + d0 * 32 * VPITCH), ld16(vb + d0 * 32 * VPITCH + 16)); o[d0] = mma8(a, pf, o[d0]); }
}
__device__ __forceinline__ unsigned moba_sel(const v8i* qf, const unsigned char* KM, int qb, int r32, int hi) {
    f32x16 g = f32x16{}; const unsigned char* kp = KM + (r32 & 15) * HD + hi * 32;
#pragma unroll
    for (int ks = 0; ks < 2; ++ks) g = mma8(cat32(ld16(kp + ks * 64), ld16(kp + ks * 64 + 16)), qf[ks], g);
    float v[16];
#pragma unroll
    for (int r = 0; r < 8; ++r) { const float mine = g[r], oth = __shfl_xor(mine, 32); const int base = (r & 3) + 8 * (r >> 2);
        v[base] = hi ? oth : mine; v[base + 4] = hi ? mine : oth; }
#pragma unroll
    for (int n = 0; n < 16; ++n) v[n] = (n < qb) ? v[n] : -1e30f;
    unsigned sel = 0u;
#pragma unroll
    for (int pass = 0; pass < 3; ++pass) {
        float best = v[0]; int bi = 0;
#pragma unroll
        for (int n = 1; n < 16; ++n) { const bool gt = v[n] > best; best = gt ? v[n] : best; bi = gt ? n : bi; }
        if (best > -1e29f) sel |= 1u << bi;
#pragma unroll
        for (int n = 0; n < 16; ++n) v[n] = (n == bi) ? -__builtin_inff() : v[n];
    }
    return sel;
}
struct BlockRef { const unsigned char* Q; const unsigned char* K; const unsigned char* V; unsigned char* O; const unsigned char* KM; int qb; };
struct Seam { v8i qf[2]; v4i st_k[2], st_v[2]; };
__device__ __forceinline__ BlockRef make_ref(unsigned char* ws, int vcu, int k) {
    const int x8 = vcu & 7, bh = (k < 2) ? (vcu >> 3) : 32 + (vcu >> 3), qb = (k & 1) ? 15 - x8 : x8, b = bh >> 4, h = bh & 15;
    BlockRef r; r.Q = ws + WS_Q8 + ((size_t)bh * SEQ + (size_t)qb * 256) * HD; r.K = ws + WS_K8 + (size_t)bh * SEQ * HD; r.V = ws + WS_VT8 + (size_t)bh * HD * SEQ;
    r.O = ws + WS_O8 + ((size_t)(b * SEQ + qb * 256)) * OP + h * HD; r.KM = ws + WS_KM + (size_t)bh * 16 * HD; r.qb = qb; return r;
}
#define VMW() asm volatile("s_waitcnt vmcnt(0)" ::: "memory")
#define VMWN(n) asm volatile("s_waitcnt vmcnt(%0)" :: "i"(n) : "memory")
#define SLOAD_H(Kp, Vp, k0) do { const unsigned char* kp_ = (Kp) + (size_t)(k0) * HD + klo; const unsigned char* vp_ = (Vp) + (size_t)(k0) + vlo; \
        S.st_k[0] = ld16(kp_); S.st_k[1] = ld16(kp_ + KVBLK * HD); S.st_v[0] = ld16(vp_); S.st_v[1] = ld16(vp_ + KVBLK); } while (0)
#define SWRITE_HK(bf) do { *(v4i*)(K_lds + (bf) * SHM_K + kws) = S.st_k[0]; *(v4i*)(K_lds + (bf) * SHM_K + kws + KVBLK * KPITCH) = S.st_k[1]; } while (0)
#define SWRITE_HV(bf) do { _Pragma("unroll") for (int i_ = 0; i_ < 2; ++i_) { unsigned char* vd_ = V_lds + (bf) * SHM_V + vws + i_ * KVBLK; \
        *(int*)(vd_) = S.st_v[i_][0]; *(int*)(vd_ + 32) = S.st_v[i_][1]; *(int*)(vd_ + 4) = S.st_v[i_][2]; *(int*)(vd_ + 36) = S.st_v[i_][3]; } } while (0)
#define SWRITE_H(bf) do { SWRITE_HV(bf); SWRITE_HK(bf); } while (0)
#define QLOAD(Qp) do { const unsigned char* qp_ = (Qp) + qoff; S.qf[0] = cat32(ld16(qp_), ld16(qp_ + 16)); S.qf[1] = cat32(ld16(qp_ + 64), ld16(qp_ + 80)); } while (0)
#define ATT_GEOM() const int wid = __builtin_amdgcn_readfirstlane(tid >> 6), lane = tid & 63, r32 = lane & 31, hi = lane >> 5; \
    const unsigned klo = (unsigned)((tid >> 3) * HD + (tid & 7) * 16), kws = (unsigned)((tid >> 3) * KPITCH + (tid & 7) * 16); \
    const unsigned vlo = (unsigned)((tid >> 2) * SEQ + (tid & 3) * 16), vws = (unsigned)((tid >> 2) * VPITCH + (tid & 3) * 8); \
    const unsigned qoff = (unsigned)((wid * QBLK + r32) * HD + hi * 32); \
    unsigned char* V_lds = (unsigned char*)lds; unsigned char* K_lds = (unsigned char*)lds + 2 * SHM_V
__device__ __forceinline__ void moba_prime(const BlockRef& cur, char* lds, Seam& S, const int tid) {
    ATT_GEOM(); (void)V_lds; (void)vws;
    QLOAD(cur.Q);
    SLOAD_H(cur.K, cur.V, 0); VMW(); SWRITE_HK(0);
    __syncthreads();
}
__device__ __forceinline__ void moba_block(const BlockRef& cur, const BlockRef& nxt, char* lds, Seam& S, const int tid) {
    ATT_GEOM();
    const int qb = cur.qb, NS = 2 * (qb + 1);
    const int qlo = qb * QB + wid * QBLK;
    unsigned* sel_l = (unsigned*)(lds + 2 * SHM_V + 2 * SHM_K) + wid * 64;
    { const unsigned sel0 = (qb > 0) ? moba_sel(S.qf, cur.KM, qb, r32, hi) : 0u; if (hi == 0) sel_l[r32] = sel0; }
    float m_reg = -1e30f, l_reg = 0; f32x16 o[4] = {};
    const unsigned char* Kh = cur.K; const unsigned char* Vh = cur.V;
#define RESC(a) do { if (__any((a) < 1.f)) { for (int d_ = 0; d_ < 4; ++d_) for (int r = 0; r < 16; ++r) o[d_][r] *= (a); } } while (0)
#define KBASE(t) ((t) * KVBLK)
#define KEEP(t) ((((t) >> 2) >= qb) || (((sel_l[r32] >> ((t) >> 2)) & 1u) != 0u))
#define MASKT(P0_, P1_, t) do { const int kb_ = KBASE(t); if (kb_ + KVBLK - 1 > qlo) mask_tile(P0_, P1_, qlo - kb_ + r32 - 4 * hi); } while (0)
    f32x16 pA0, pA1, pB0, pB1; float mnA, mnB, alA, alB; v8i pf;
#define STEP_A(T_, B_, LOADNEXT) do { SBAR(); qkt<0>(B_, pA0, pA1, K_lds, r32, hi, S.qf); finishSM(pB0, pB1, alB, l_reg, pf); SBAR(); \
        if (LOADNEXT) { SLOAD_H(Kh, Vh, KBASE(2 * (T_) + 2)); SBAR(); } \
        pv_tile<1>(1 - (B_), o, V_lds, r32, hi, pf); MASKT(pA0, pA1, 2 * (T_)); partialSM(pA0, pA1, m_reg, mnA, alA, KEEP(2 * (T_))); RESC(alA); } while (0)
#define STEP_B(T_, B_, WRITENEXT) do { SBAR(); qkt<1>(B_, pB0, pB1, K_lds, r32, hi, S.qf); finishSM(pA0, pA1, alA, l_reg, pf); SBAR(); \
        pv_tile<0>(B_, o, V_lds, r32, hi, pf); MASKT(pB0, pB1, 2 * (T_) + 1); partialSM(pB0, pB1, m_reg, mnB, alB, KEEP(2 * (T_) + 1)); \
        if (WRITENEXT) { __syncthreads(); VMW(); SWRITE_H(1 - (B_)); RESC(alB); __syncthreads(); } else { RESC(alB); } } while (0)
    SWRITE_HV(0); SBAR();
    SLOAD_H(Kh, Vh, KBASE(2));
    SBAR(); qkt<0>(0, pA0, pA1, K_lds, r32, hi, S.qf);
    MASKT(pA0, pA1, 0); partialSM(pA0, pA1, m_reg, mnA, alA, KEEP(0));
    __syncthreads();
    STEP_B(0, 0, true);
    for (int T_ = 1; T_ + 1 < NS; ++T_) { const int bsel = T_ & 1; STEP_A(T_, bsel, true); STEP_B(T_, bsel, true); }
    STEP_A(NS - 1, 1, false);
    SBAR(); qkt<1>(1, pB0, pB1, K_lds, r32, hi, S.qf); SBAR();
    SLOAD_H(nxt.K, nxt.V, 0); SBAR();
    QLOAD(nxt.Q);
    SBAR();
    finishSM(pA0, pA1, alA, l_reg, pf); SBAR();
    pv_tile<0>(1, o, V_lds, r32, hi, pf);
    MASKT(pB0, pB1, 2 * NS - 1); partialSM(pB0, pB1, m_reg, mnB, alB, true); RESC(alB);
    finishSM(pB0, pB1, alB, l_reg, pf); SBAR(); pv_tile<1>(1, o, V_lds, r32, hi, pf);
    SBAR(); VMWN(4); SWRITE_HK(0); SBAR();
    { const float rl = __builtin_amdgcn_rcpf(l_reg) * (float)(1 << O8_SHIFT);
      int r32e = r32, hie = hi; asm volatile("" : "+v"(r32e), "+v"(hie));
      unsigned char* Ow = cur.O + (size_t)(wid * QBLK + r32e) * OP + 64 * hie;
      unsigned wa[8], wb[8];
#pragma unroll
      for (int d0 = 0; d0 < 2; ++d0)
#pragma unroll
          for (int g4 = 0; g4 < 4; ++g4) {
              const unsigned lo = pk_fp8x4(o[d0][4 * g4] * rl, o[d0][4 * g4 + 1] * rl, o[d0][4 * g4 + 2] * rl, o[d0][4 * g4 + 3] * rl);
              const unsigned up = pk_fp8x4(o[d0 + 2][4 * g4] * rl, o[d0 + 2][4 * g4 + 1] * rl, o[d0 + 2][4 * g4 + 2] * rl, o[d0 + 2][4 * g4 + 3] * rl);
              auto rr = __builtin_amdgcn_permlane32_swap(lo, up, false, false); wa[4 * d0 + g4] = rr[0]; wb[4 * d0 + g4] = rr[1]; }
#pragma unroll
      for (int j = 0; j < 4; ++j) { pg8::v4i v; v[0] = (int)wa[2 * j]; v[1] = (int)wb[2 * j]; v[2] = (int)wa[2 * j + 1]; v[3] = (int)wb[2 * j + 1]; *(pg8::v4i*)(Ow + 16 * j) = v; } }
    __syncthreads();
#undef RESC
#undef KBASE
#undef KEEP
#undef MASKT
#undef STEP_A
#undef STEP_B
}
#undef VMW
#undef VMWN
#undef SLOAD_H
#undef SWRITE_HK
#undef SWRITE_HV
#undef SWRITE_H
#undef QLOAD
#undef ATT_GEOM
}

struct Args { const float* in[23]; float* out; unsigned char* ws; };
typedef const __attribute__((address_space(4))) Args* ArgsP;
__device__ __forceinline__ int ltid(int wave0) { int l; asm volatile("v_mbcnt_lo_u32_b32 %0, -1, 0\n\tv_mbcnt_hi_u32_b32 %0, -1, %0" : "=v"(l)); return (wave0 << 6) | l; }
__device__ __forceinline__ ArgsP kargs() { ArgsP p = (ArgsP)__builtin_amdgcn_kernarg_segment_ptr(); asm volatile("" : "+s"(p)); return p; }
#define WSP(T_, off) ((T_*)(ws + (off)))

struct ConvUnit { const float* W; void* WT; int ldw, ldt, k0, n0, kind, add; };
__device__ __forceinline__ int conv_row(const ConvUnit& c, int n) {
    if (c.kind == 2) { if (n >= 6144) return n - 2048; const int p = n & 127; return (n & ~127) + 2 * (p & 63) + (p >> 6) - 2048; }
    if (c.kind == 3) return (n >> 2) * 8 + (n & 3) + c.add;
    return n;
}
constexpr int CBUF = 65536, OP8 = 144, OP16 = 272;
__device__ __forceinline__ void conv_dma(const ConvUnit& c, int wave, int lane, LAS unsigned char* buf) {
    const float* Wl = c.W + (size_t)(c.k0 + 16 * wave + (lane >> 5)) * c.ldw + c.n0 + 4 * (lane & 31);
#pragma unroll
    for (int i = 0; i < 8; ++i) __builtin_amdgcn_global_load_lds((const unsigned*)(Wl + (size_t)(2 * i) * c.ldw), (LAS unsigned*)(buf + (16 * wave + 2 * i) * 512), 16, 0, 0);
}
__device__ __forceinline__ void conv_read(int wave, int lane, const LAS unsigned char* buf, float (&f)[32]) {
    const LAS float* p = (const LAS float*)(buf + (16 * wave) * 512 + 4 * lane);
#pragma unroll
    for (int i = 0; i < 16; ++i) { f[i] = p[i * 128]; f[16 + i] = p[i * 128 + 64]; }
}
__device__ __forceinline__ void conv_park8(int wave, int lane, LAS unsigned char* img, const float (&f)[32]) {
    constexpr float SC = (float)(1 << pg8::W8_SHIFT);
#pragma unroll
    for (int h = 0; h < 2; ++h) { v4u o; o.x = pk_fp8x4(f[16 * h] * SC, f[16 * h + 1] * SC, f[16 * h + 2] * SC, f[16 * h + 3] * SC); o.y = pk_fp8x4(f[16 * h + 4] * SC, f[16 * h + 5] * SC, f[16 * h + 6] * SC, f[16 * h + 7] * SC);
        o.z = pk_fp8x4(f[16 * h + 8] * SC, f[16 * h + 9] * SC, f[16 * h + 10] * SC, f[16 * h + 11] * SC); o.w = pk_fp8x4(f[16 * h + 12] * SC, f[16 * h + 13] * SC, f[16 * h + 14] * SC, f[16 * h + 15] * SC);
        *(LAS v4u*)(img + (lane + 64 * h) * OP8 + 16 * wave) = o; }
}
__device__ __forceinline__ void conv_out8(const ConvUnit& c, int tid, const LAS unsigned char* img) {
#pragma unroll
    for (int j = 0; j < 2; ++j) { const int row = (tid >> 3) + 64 * j, ch = tid & 7; const v4u v = *(const LAS v4u*)(img + row * OP8 + 16 * ch);
        *(v4u*)((unsigned char*)c.WT + (size_t)conv_row(c, c.n0 + row) * c.ldt + c.k0 + 16 * ch) = v; }
}
__device__ __forceinline__ void conv_park16(int wave, int lane, LAS unsigned char* img, const float (&f)[32], const int h) {
    v4u o0, o1; o0.x = pk2(f[16 * h], f[16 * h + 1]); o0.y = pk2(f[16 * h + 2], f[16 * h + 3]); o0.z = pk2(f[16 * h + 4], f[16 * h + 5]); o0.w = pk2(f[16 * h + 6], f[16 * h + 7]);
    o1.x = pk2(f[16 * h + 8], f[16 * h + 9]); o1.y = pk2(f[16 * h + 10], f[16 * h + 11]); o1.z = pk2(f[16 * h + 12], f[16 * h + 13]); o1.w = pk2(f[16 * h + 14], f[16 * h + 15]);
    LAS unsigned char* q = img + lane * OP16 + 32 * wave; *(LAS v4u*)q = o0; *(LAS v4u*)(q + 16) = o1;
}
__device__ __forceinline__ void conv_out16(const ConvUnit& c, int tid, const LAS unsigned char* img, const int h) {
#pragma unroll
    for (int j = 0; j < 2; ++j) { const int row = (tid >> 4) + 32 * j, ch = tid & 15; const v4u v = *(const LAS v4u*)(img + row * OP16 + 16 * ch);
        *(v4u*)((bf16*)c.WT + (size_t)conv_row(c, c.n0 + 64 * h + row) * c.ldt + c.k0 + 8 * ch) = v; }
}
constexpr int NCONV = 8320;
__device__ __forceinline__ ConvUnit conv_decode(int u, ArgsP A, unsigned char* ws) {
    ConvUnit c; c.add = 0;
    if (u < 1536) { const int kp = u / 96, g = u - kp * 96; c.W = A->in[6]; c.ldw = INC; c.k0 = kp * 128; c.n0 = g * 128; c.ldt = D;
        if (g < 16) { c.WT = ws + WS_WINZ; c.kind = 1; } else { c.WT = ws + WS_WIN8; c.kind = 2; } return c; }
    u -= 1536;
    if (u < 128) { c.W = A->in[11]; c.ldw = D; c.k0 = (u >> 4) * 128; c.n0 = (u & 15) * 128; c.WT = ws + WS_WSO; c.ldt = SGW; c.kind = 0; return c; }
    u -= 128;
    if (u < 256) { c.W = A->in[12]; c.ldw = D; c.k0 = (u >> 4) * 128; c.n0 = (u & 15) * 128; c.WT = ws + WS_WMO8; c.ldt = D; c.kind = 1; return c; }
    u -= 256;
    if (u < 256) { c.W = A->in[13]; c.ldw = D; c.k0 = (u >> 4) * 128; c.n0 = (u & 15) * 128; c.WT = ws + WS_WOUT; c.ldt = D; c.kind = 1; return c; }
    u -= 256;
    const int m = u >> 11, r = u & 2047, e = r >> 6, q = r & 63;
    if (m < 2) { c.W = A->in[19 + m] + (size_t)e * D * DFF; c.ldw = DFF; c.k0 = (q >> 2) * 128; c.n0 = (q & 3) * 128; c.WT = ws + WS_WGU8 + (size_t)e * 1024 * D; c.ldt = D; c.kind = 3; c.add = 4 * m; return c; }
    c.W = A->in[21] + (size_t)e * DFF * D; c.ldw = D; c.k0 = (q >> 4) * 128; c.n0 = (q & 15) * 128; c.WT = ws + WS_WD8 + (size_t)e * D * DFF; c.ldt = DFF; c.kind = 1; return c;
}
constexpr int NCONV_EARLY = 1536;
__device__ __forceinline__ void conv_run(LAS unsigned char* lds, const int tid, const int wave, const int lane, int u, const int uend) {
    float f[32];
    LAS unsigned char* b0 = lds; LAS unsigned char* b1 = lds + CBUF; LAS unsigned char* img = lds + TAB_OFF;
#define CONV_CLAMP(x) ((x) < uend ? (x) : uend - 1)
#define CONV_BAR() do { asm volatile("s_waitcnt lgkmcnt(0)" ::: "memory"); __builtin_amdgcn_s_barrier(); asm volatile("" ::: "memory"); } while (0)
#define CONV_STEP(N, buf) do { \
        asm volatile("s_waitcnt vmcnt(" #N ")" ::: "memory"); __builtin_amdgcn_s_barrier(); asm volatile("" ::: "memory"); \
        conv_read(wave, lane, buf, f); CONV_BAR(); \
        { ArgsP Ai = kargs(); const ConvUnit cn = conv_decode(CONV_CLAMP(u + 512), Ai, Ai->ws); conv_dma(cn, wave, lane, buf); } \
        { ArgsP Ai = kargs(); const ConvUnit c = conv_decode(u, Ai, Ai->ws); \
          if (c.kind != 0) { conv_park8(wave, lane, img, f); CONV_BAR(); conv_out8(c, tid, img); } \
          else { conv_park16(wave, lane, img, f, 0); CONV_BAR(); conv_out16(c, tid, img, 0); CONV_BAR(); conv_park16(wave, lane, img, f, 1); CONV_BAR(); conv_out16(c, tid, img, 1); } } \
        u += 256; } while (0)
    { ArgsP Ai = kargs(); const ConvUnit c = conv_decode(u, Ai, Ai->ws); conv_dma(c, wave, lane, b0); }
    { ArgsP Ai = kargs(); const ConvUnit c = conv_decode(CONV_CLAMP(u + 256), Ai, Ai->ws); conv_dma(c, wave, lane, b1); }
    CONV_STEP(8, b0);
    if (u < uend) { CONV_STEP(10, b1);
        for (;;) {
            if (u >= uend) break; CONV_STEP(12, b0);
            if (u >= uend) break; CONV_STEP(12, b1);
        } }
    asm volatile("s_waitcnt vmcnt(0)" ::: "memory");
    __builtin_amdgcn_s_barrier();
#undef CONV_STEP
#undef CONV_BAR
#undef CONV_CLAMP
}

__global__ void __launch_bounds__(NWAVES * 64, 2) fwd_kernel(Args args) {
    extern __shared__ __attribute__((aligned(16))) unsigned char lds_raw[];
    LAS unsigned char* lds = (LAS unsigned char*)lds_raw;
    const int wave0 = __builtin_amdgcn_readfirstlane((int)threadIdx.x >> 6);
    constexpr int G = 256;
#define BX ((int)__builtin_amdgcn_readfirstlane((int)MISC[19]))
#define VCU ((int)__builtin_amdgcn_readfirstlane((int)MISC[18]))
    volatile LAS unsigned* MISC = (volatile LAS unsigned*)(lds + MISC_OFF);
    for (int u = ltid(wave0); u < (LDS_BYTES - LDSCTL_OFF) / 4; u += NWAVES * 64) ((LAS unsigned*)(lds + LDSCTL_OFF))[u] = 0u;
    __syncthreads();
    if (ltid(wave0) == 0) { unsigned* bar = (unsigned*)(args.ws + WS_CTL) + CW_BAR; const unsigned x = xb_xcc_id(); MISC[16] = x; MISC[17] = xb_add(&bar[XB_XCNT(x)], 1u);
        MISC[18] = ((unsigned)blockIdx.x & 7u) * 32u + ((unsigned)blockIdx.x >> 3); MISC[19] = (unsigned)blockIdx.x; MISC[20] = 0u; }
    __syncthreads();
#define GRID_BAR() do { XcdBarrier b_; b_.bar = (unsigned*)(kargs()->ws + WS_CTL) + CW_BAR; b_.x = xb_xcc_id(); b_.st = (volatile LAS unsigned*)(lds + MISC_OFF) + 8; xcd_barrier(b_, ltid(wave0)); } while (0)
#define LOCAL_BAR(k) do { if (MISC[20] != 0u) { asm volatile("s_waitcnt vmcnt(0)" ::: "memory"); __syncthreads(); \
        if (ltid(wave0) == 0) { unsigned* ctlw_ = (unsigned*)(kargs()->ws + WS_CTL); unsigned* xw_ = ctlw_ + CW_XLB + 64 * MISC[16]; (void)xb_add(xw_, 1u); __builtin_amdgcn_fence(__ATOMIC_ACQUIRE, "agent"); \
            XB_SPIN(xb_ld(xw_) < 32u * ((k) + 1u), ctlw_ + CW_BAR); asm volatile("s_waitcnt vmcnt(0)" ::: "memory"); } \
        __syncthreads(); } else GRID_BAR(); } while (0)

    DUPLOOP(0) {
    {
        ArgsP A = kargs(); unsigned char* ws = A->ws; const int tid = ltid(wave0), lane = tid & 63, wave = __builtin_amdgcn_readfirstlane(tid >> 6); (void)lane; (void)wave; gu32* ctl = (gu32*)(ws + WS_CTL);
        const float* cin = A->in[1];
        LAS float* cact = (LAS float*)(lds + 98304);
        { float cv[16];
#pragma unroll
          for (int q = 0; q < 16; ++q) cv[q] = cin[tid + q * NWAVES * 64];
#pragma unroll
          for (int q = 0; q < 16; ++q) cact[tid + q * NWAVES * 64] = cv[q] / (1.0f + __expf(-cv[q])); }
        __syncthreads();
        { const int it = (wave < 6) ? VCU * 6 + wave : 1536 + VCU * 2 + (wave - 6); ArgsP Ai = kargs(); unsigned char* wsi = Ai->ws;
            if (it < 1536) {
                const int qd = it / 384, col = (it - qd * 384) * 32 + 4 * (lane & 7), rq = lane >> 3;
                f32x4 a0 = {0.f, 0.f, 0.f, 0.f}, a1 = a0, a2 = a0, a3 = a0;
                for (int k0 = qd * 512; k0 < qd * 512 + 512; k0 += 256) {
                    f32x4 w[32];
#pragma unroll
                    for (int i = 0; i < 32; ++i) w[i] = *(const f32x4*)(Ai->in[3] + (size_t)(k0 + rq + 8 * i) * 12288 + col);
#pragma unroll
                    for (int i = 0; i < 32; ++i) { const int k = k0 + rq + 8 * i;
                        a0 += cact[k] * w[i]; a1 += cact[D + k] * w[i]; a2 += cact[2 * D + k] * w[i]; a3 += cact[3 * D + k] * w[i]; }
                }
#pragma unroll
                for (int e = 0; e < 4; ++e)
#pragma unroll
                    for (int o = 8; o < 64; o <<= 1) { a0[e] += __shfl_xor(a0[e], o); a1[e] += __shfl_xor(a1[e], o); a2[e] += __shfl_xor(a2[e], o); a3[e] += __shfl_xor(a3[e], o); }
                if (rq == 0) { const f32x4 bb = (qd == 0) ? *(const f32x4*)(Ai->in[4] + col) : (f32x4){0.f, 0.f, 0.f, 0.f}; float* ap = ((float*)(wsi + WS_ADAP)) + (size_t)qd * 49152 + col;
                    *(f32x4*)(ap) = a0 + bb; *(f32x4*)(ap + 12288) = a1 + bb; *(f32x4*)(ap + 2 * 12288) = a2 + bb; *(f32x4*)(ap + 3 * 12288) = a3 + bb; }
            } else if (it < 1792) {
                const int tok = (it - 1536) * 64 + lane; const double pos = (double)((const int*)Ai->in[2])[tok];
                float* cosT = (float*)(wsi + WS_COS); float* sinT = (float*)(wsi + WS_SIN);
                double inv = 1.0;
                for (int j = 0; j < 64; ++j) {
                    const double rev = pos * inv * 0.15915494309189535;
                    const float fr = (float)(rev - __builtin_floor(rev));
                    cosT[(size_t)tok * 64 + j] = __builtin_amdgcn_cosf(fr); sinT[(size_t)tok * 64 + j] = __builtin_amdgcn_sinf(fr);
                    inv *= 0.8659643233600653;
                }
            } else if (it < 1824) {
                const int g = (it - 1792) >> 2, part = (it - 1792) & 3; bf16* WSb = (bf16*)(wsi + WS_WS);
                for (int i = part * 4096 + lane; i < part * 4096 + 4096; i += 64) { const int r = i >> 7, c = i & 127; WSb[g * 16384 + i] = (c <= r) ? (bf16)f2bf(Ai->in[9][g * 16384 + i]) : (bf16)0; }
            } else if (it < 2016) {
                const int q = it - 1824, u = q & 7, n0 = (q >> 3) * 2; bf16* RT = (bf16*)(wsi + WS_RT);
#pragma unroll
                for (int nn = 0; nn < 2; ++nn) { const int n = n0 + nn;
#pragma unroll
                    for (int i = 0; i < 4; ++i) { const int k = u * 256 + lane + 64 * i; const float w = (n < 4) ? Ai->in[15][k * 4 + n] : (n < 36) ? Ai->in[17][k * 32 + (n - 4)] : 0.f;
                        const unsigned hi = f2bf(w); const int ks = k >> 5, kk = k & 31; RT[((ks * 2) * 48 + n) * 32 + kk] = (bf16)hi; RT[((ks * 2 + 1) * 48 + n) * 32 + kk] = (bf16)f2bf(w - __builtin_bit_cast(float, hi << 16)); } }
            }
        }
        __syncthreads();
        conv_run(lds, tid, wave, lane, VCU, NCONV_EARLY);
    }
    GRID_BAR();
    }
    { const int t = ltid(wave0);
      if (t < 64) { const unsigned c = (t < 16) ? xb_ld((unsigned*)(kargs()->ws + WS_CTL) + CW_BAR + XB_XCNT(t)) : 0u;
          const bool uni = __ballot((t >= 16) || (c == ((t < 8) ? 32u : 0u))) == ~0ull;
          if (t == 0 && uni) { const unsigned x = MISC[16], r = MISC[17]; MISC[18] = x * 32u + r; MISC[19] = r * 8u + x; MISC[20] = 1u; } } }
    __syncthreads();

    DUPLOOP(1) {
    {
        ArgsP A = kargs(); unsigned char* ws = A->ws; const int tid = ltid(wave0), lane = tid & 63, wave = __builtin_amdgcn_readfirstlane(tid >> 6); (void)lane; (void)wave;
        const float* x = A->in[0]; const float* g_mix = A->in[5]; const float* adap = WSP(float, WS_ADAP); float* adaf = WSP(float, WS_ADA); bf16* Nb = WSP(bf16, WS_N); unsigned char* N8 = ws + WS_N1F8;
        LAS float* tg = (LAS float*)(lds); LAS float* tb = (LAS float*)(lds + 8192);
        const int row0 = VCU * 64, b = row0 >> 12;
        for (int i = tid; i < D; i += NWAVES * 64) { const float* ap = adap + b * 12288 + i;
            tg[i] = g_mix[i] * (1.0f + ((ap[2048] + ap[49152 + 2048]) + (ap[2 * 49152 + 2048] + ap[3 * 49152 + 2048]))); tb[i] = (ap[0] + ap[49152]) + (ap[2 * 49152] + ap[3 * 49152]); }
        if (tid < 192) { const int i = VCU * 192 + tid; adaf[i] = (adap[i] + adap[49152 + i]) + (adap[2 * 49152 + i] + adap[3 * 49152 + i]); }
        __syncthreads();
        for (int rq = 0; rq < 2; ++rq) {
            f32x4 v[4][8];
#pragma unroll
            for (int q = 0; q < 4; ++q) { const f32x4* xr = (const f32x4*)(x + (size_t)(row0 + wave * 8 + rq * 4 + q) * D) + lane;
#pragma unroll
                for (int j = 0; j < 8; ++j) v[q][j] = xr[64 * j]; }
#pragma unroll
            for (int q = 0; q < 4; ++q) { const int row = row0 + wave * 8 + rq * 4 + q; float ss = 0.f;
#pragma unroll
                for (int j = 0; j < 8; ++j) ss += (v[q][j].x * v[q][j].x + v[q][j].y * v[q][j].y) + (v[q][j].z * v[q][j].z + v[q][j].w * v[q][j].w);
                const float rstd = rsqrtf(wave_sum(ss) * (1.f / D) + EPS);
                v2u* o8 = (v2u*)(Nb + (size_t)row * D) + lane;
#pragma unroll
                for (int j = 0; j < 8; ++j) { const f32x4 gg = *(const LAS f32x4*)(tg + 4 * lane + 256 * j), bb = *(const LAS f32x4*)(tb + 4 * lane + 256 * j);
                    const f32x4 y = v[q][j] * rstd * gg + bb; v2u w; w.x = cvt_pk_bf16(y.x, y.y); w.y = cvt_pk_bf16(y.z, y.w); o8[64 * j] = w;
                    *((unsigned*)(N8 + (size_t)row * D) + lane + 64 * j) = pk_fp8x4(y.x, y.y, y.z, y.w); } }
        }
    }
    LOCAL_BAR(0);
    }

    DUPLOOP(2) {
    {
        ArgsP A = kargs(); unsigned char* ws = A->ws; const int tid = ltid(wave0), lane = tid & 63, wave = __builtin_amdgcn_readfirstlane(tid >> 6); (void)lane; (void)wave;
        bf16* Nb = WSP(bf16, WS_N); bf16* UV = WSP(bf16, WS_UV); unsigned char* Qh = ws + WS_Q8; unsigned char* Kh = ws + WS_K8; unsigned char* Vh = ws + WS_VT8;
        bf16* SAg = WSP(bf16, WS_SA); bf16* SBg = WSP(bf16, WS_SB); const float* cosT = WSP(float, WS_COS); const float* sinT = WSP(float, WS_SIN);
        { pg8::StaticOrder S; S.init(T, 2048, D, G, BX, ws + WS_WINZ);
          pg8::EpiInProj E{UV, Qh, Kh, Vh, SAg, SBg, cosT, sinT, 0};
          pg8::gemm_phase<true>(lds, (const char*)(ws + WS_N1F8), D, S, E, tid); }
        { pg8::StaticOrder S; S.init(T, 10240, D, G, BX, ws + WS_WIN8);
          pg8::EpiInProj E{UV, Qh, Kh, Vh, SAg, SBg, cosT, sinT, 8};
          pg8::gemm_phase<true>(lds, (const char*)(ws + WS_N1F8), D, S, E, tid); }
    }
    GRID_BAR();
    }

    DUPLOOP(3) {
    {
        ArgsP A = kargs(); unsigned char* ws = A->ws; const int tid = ltid(wave0), lane = tid & 63, wave = __builtin_amdgcn_readfirstlane(tid >> 6); (void)lane; (void)wave;
        const float* sgu_ln_g = A->in[7]; const float* sgu_ln_b = A->in[8]; const float* sgu_b_s = A->in[10];
        const bf16* UV = WSP(bf16, WS_UV); const bf16* WSb = WSP(bf16, WS_WS); bf16* SGUO = WSP(bf16, WS_SGUO); const unsigned char* K8 = ws + WS_K8; unsigned char* KM = ws + WS_KM;
        constexpr int VP = 136;
        LAS bf16* vT = (LAS bf16*)lds; LAS f32x2* st = (LAS f32x2*)(lds + 2 * 128 * VP * 2); LAS float* kx = (LAS float*)(lds + 73728);
        { const int item = VCU * NWAVES + wave, blk = item >> 1, half = item & 1, c8 = (lane & 15) * 8, r0 = lane >> 4;
          const unsigned char* kp = K8 + ((size_t)blk * 256 + half * 128 + r0) * HD + c8;
          float sacc[8] = {0.f, 0.f, 0.f, 0.f, 0.f, 0.f, 0.f, 0.f};
          { v2u w[32];
#pragma unroll
              for (int u = 0; u < 32; ++u) w[u] = *(const v2u*)(kp + (size_t)(4 * u) * HD);
#pragma unroll
              for (int u = 0; u < 32; ++u) { const f32x2 a0 = __builtin_amdgcn_cvt_pk_f32_fp8((int)w[u].x, false), a1 = __builtin_amdgcn_cvt_pk_f32_fp8((int)w[u].x, true), a2 = __builtin_amdgcn_cvt_pk_f32_fp8((int)w[u].y, false), a3 = __builtin_amdgcn_cvt_pk_f32_fp8((int)w[u].y, true);
                  sacc[0] += a0.x; sacc[1] += a0.y; sacc[2] += a1.x; sacc[3] += a1.y; sacc[4] += a2.x; sacc[5] += a2.y; sacc[6] += a3.x; sacc[7] += a3.y; } }
#pragma unroll
          for (int e = 0; e < 8; ++e) { sacc[e] += __shfl_xor(sacc[e], 16); sacc[e] += __shfl_xor(sacc[e], 32); }
          LAS float* kxp = kx + (wave >> 1) * 128 + c8;
          if (half == 1 && lane < 16) {
#pragma unroll
              for (int e = 0; e < 8; ++e) kxp[e] = sacc[e]; }
          __syncthreads();
          if (half == 0 && lane < 16) {
#pragma unroll
              for (int e = 0; e < 8; ++e) sacc[e] = (sacc[e] + kxp[e]) * ((float)(1 << att::KM_SHIFT) / 256.f);
              v2u o; o.x = pk_fp8x4(sacc[0], sacc[1], sacc[2], sacc[3]); o.y = pk_fp8x4(sacc[4], sacc[5], sacc[6], sacc[7]);
              *(v2u*)(KM + (size_t)blk * HD + c8) = o; } }
        {
            const int ch = VCU >> 1, hf = VCU & 1, R0 = ch * 128;
            LAS float* lng = (LAS float*)(lds + 81920); LAS float* lnb = lng + 512;
            lng[tid] = sgu_ln_g[hf * 512 + tid]; lnb[tid] = sgu_ln_b[hf * 512 + tid];
            v4u aa[4][8];
#pragma unroll
            for (int it4 = 0; it4 < 4; ++it4) { const v4u* vp = (const v4u*)(UV + (size_t)(R0 + wave * 16 + it4 * 4 + (lane >> 4)) * D + SGW) + (lane & 15);
#pragma unroll
                for (int q = 0; q < 8; ++q) aa[it4][q] = vp[16 * q]; }
#pragma unroll
            for (int it4 = 0; it4 < 4; ++it4) { const int j = wave * 16 + it4 * 4 + (lane >> 4);
                const v4u (&a)[8] = aa[it4];
                float s = 0.f;
#pragma unroll
                for (int q = 0; q < 8; ++q) s += ((bflo(a[q].x) + bfhi(a[q].x)) + (bflo(a[q].y) + bfhi(a[q].y))) + ((bflo(a[q].z) + bfhi(a[q].z)) + (bflo(a[q].w) + bfhi(a[q].w)));
#pragma unroll
                for (int o = 1; o < 16; o <<= 1) s += __shfl_xor(s, o);
                const float mean = s * (1.f / SGW); float qv = 0.f;
#pragma unroll
                for (int q = 0; q < 8; ++q) { float d;
                    d = bflo(a[q].x) - mean; qv += d * d; d = bfhi(a[q].x) - mean; qv += d * d; d = bflo(a[q].y) - mean; qv += d * d; d = bfhi(a[q].y) - mean; qv += d * d;
                    d = bflo(a[q].z) - mean; qv += d * d; d = bfhi(a[q].z) - mean; qv += d * d; d = bflo(a[q].w) - mean; qv += d * d; d = bfhi(a[q].w) - mean; qv += d * d; }
#pragma unroll
                for (int o = 1; o < 16; o <<= 1) qv += __shfl_xor(qv, o);
                if ((lane & 15) == 0) st[j] = (f32x2){mean, rsqrtf(qv * (1.f / SGW) + EPS)};
            }
            __syncthreads();
            for (int ps = 0; ps < 2; ++ps) {
                const int gp = hf * 2 + ps;
                { const int j = lane + 64 * (wave & 1), cb = 64 * (wave >> 1); const f32x2 ms = st[j];
                  v4u a[8];
#pragma unroll
                  for (int cq = 0; cq < 8; ++cq) a[cq] = *(const v4u*)(UV + (size_t)(R0 + j) * D + SGW + gp * 256 + cb + 8 * cq);
#pragma unroll
                  for (int cq = 0; cq < 8; ++cq) { const int c0 = cb + 8 * cq, chn = gp * 256 + c0;
                      const int cl_ = chn - hf * 512; const f32x4 g0 = *(const LAS f32x4*)(lng + cl_), g1 = *(const LAS f32x4*)(lng + cl_ + 4), b0 = *(const LAS f32x4*)(lnb + cl_), b1 = *(const LAS f32x4*)(lnb + cl_ + 4);
                      const float e[8] = {bflo(a[cq].x), bfhi(a[cq].x), bflo(a[cq].y), bfhi(a[cq].y), bflo(a[cq].z), bfhi(a[cq].z), bflo(a[cq].w), bfhi(a[cq].w)};
                      const float gg[8] = {g0[0], g0[1], g0[2], g0[3], g1[0], g1[1], g1[2], g1[3]}, bb[8] = {b0[0], b0[1], b0[2], b0[3], b1[0], b1[1], b1[2], b1[3]};
#pragma unroll
                      for (int i = 0; i < 8; ++i) vT[(c0 + i) * VP + j] = (bf16)f2bf((e[i] - ms.x) * ms.y * gg[i] + bb[i]); } }
                __syncthreads();
                { const int g = wave >> 2, ib = wave & 3, gg = gp * 2 + g, r32 = lane & 31, hi = lane >> 5; const int nks = 2 * (ib + 1);
                  const bf16* Wg = WSb + (size_t)gg * 16384 + (size_t)(ib * 32 + r32) * 128 + hi * 8;
                  f32x16 acc[4] = {};
                  const int tokr = R0 + ib * 32 + r32;
                  bf16x8 bwv[8]; v2u uu[4][4];
#pragma unroll
                  for (int ks = 0; ks < 8; ++ks) bwv[ks] = *(const bf16x8*)(Wg + (ks < nks ? ks : 0) * 16);
#pragma unroll
                  for (int db = 0; db < 4; ++db)
#pragma unroll
                      for (int q4 = 0; q4 < 4; ++q4) uu[db][q4] = *(const v2u*)(UV + (size_t)tokr * D + gg * 128 + db * 32 + 8 * q4 + 4 * hi);
                  __builtin_amdgcn_sched_barrier(0);
#pragma unroll
                  for (int ks = 0; ks < 8; ++ks) { if (ks >= nks) break;
                      const bf16x8 bw = bwv[ks];
#pragma unroll
                      for (int db = 0; db < 4; ++db) { const bf16x8 av = *(const LAS bf16x8*)(vT + (size_t)(g * 128 + db * 32 + r32) * VP + ks * 16 + hi * 8);
                          acc[db] = __builtin_amdgcn_mfma_f32_32x32x16_bf16(av, bw, acc[db], 0, 0, 0); }
                  }
                  const float bs = sgu_b_s[gg * 128 + ib * 32 + r32];
#pragma unroll
                  for (int db = 0; db < 4; ++db)
#pragma unroll
                      for (int qp = 0; qp < 2; ++qp) { v2u w[2];
#pragma unroll
                          for (int e = 0; e < 2; ++e) { const int q4 = 2 * qp + e; const v2u u2 = uu[db][q4];
                              w[e].x = cvt_pk_bf16(bflo(u2.x) * (acc[db][4 * q4 + 0] + bs), bfhi(u2.x) * (acc[db][4 * q4 + 1] + bs));
                              w[e].y = cvt_pk_bf16(bflo(u2.y) * (acc[db][4 * q4 + 2] + bs), bfhi(u2.y) * (acc[db][4 * q4 + 3] + bs)); }
                          auto rx = __builtin_amdgcn_permlane32_swap(w[0].x, w[1].x, false, false); auto ry = __builtin_amdgcn_permlane32_swap(w[0].y, w[1].y, false, false);
                          v4u o; o.x = rx[0]; o.y = ry[0]; o.z = rx[1]; o.w = ry[1];
                          *(v4u*)(SGUO + (size_t)tokr * SGW + gg * 128 + db * 32 + 16 * qp + 8 * hi) = o; } }
                __syncthreads();
            }
        }
    }
    GRID_BAR();
    }

    if ((BX & 1) == 0) { const int tid = ltid(wave0); conv_run(lds, tid, __builtin_amdgcn_readfirstlane(tid >> 6), tid & 63, NCONV_EARLY + VCU, NCONV); }
    {
        char* al = (char*)lds_raw;
        ArgsP A = kargs(); unsigned char* ws = A->ws; const int tid = ltid(wave0), lane = tid & 63, wave = __builtin_amdgcn_readfirstlane(tid >> 6); (void)lane; (void)wave;
        att::Seam S;
        att::moba_prime(att::make_ref(ws, VCU, 0), al, S, tid);
        constexpr int NBLK = 4 * ((((PROBE_DUP) >> 4) & 1) + 1);
        for (int k = 0; k < NBLK; ++k) att::moba_block(att::make_ref(ws, VCU, k & 3), att::make_ref(ws, VCU, (k + 1) & 3), al, S, tid);
    }
    if ((BX & 1) != 0) { asm volatile("s_waitcnt vmcnt(0)" ::: "memory"); __syncthreads(); const int tid = ltid(wave0); conv_run(lds, tid, __builtin_amdgcn_readfirstlane(tid >> 6), tid & 63, NCONV_EARLY + VCU, NCONV); }
    GRID_BAR();

    DUPLOOP(5) {
    {
        ArgsP A = kargs(); unsigned char* ws = A->ws; const int tid = ltid(wave0), lane = tid & 63, wave = __builtin_amdgcn_readfirstlane(tid >> 6); (void)lane; (void)wave;
        const bf16* SAg = WSP(bf16, WS_SA); const bf16* SBg = WSP(bf16, WS_SB); bf16* T1 = WSP(bf16, WS_Q); unsigned char* MERGED = ws + WS_MERGED;
        { pg8::StaticOrder S; S.init(T, D, SGW * 2, G, BX, ws + WS_WSO);
          pg8::EpiGateSeg E{SAg, SBg, T1, MERGED, 0};
          pg8::gemm_phase<false>(lds, (const char*)(ws + WS_SGUO), SGW * 2, S, E, tid); }
        { pg8::StaticOrder S; S.init(T, D, D, G, BX, ws + WS_WMO8);
          pg8::EpiGateSeg E{SAg, SBg, T1, MERGED, 1};
          pg8::gemm_phase<true>(lds, (const char*)(ws + WS_O8), D, S, E, tid, att::O8_SHIFT); }
    }
    LOCAL_BAR(1);
    }

    DUPLOOP(6) {
    {
        ArgsP A = kargs(); unsigned char* ws = A->ws; const int tid = ltid(wave0), lane = tid & 63, wave = __builtin_amdgcn_readfirstlane(tid >> 6); (void)lane; (void)wave;
        const float* ada = WSP(float, WS_ADA); bf16* DELTA = WSP(bf16, WS_DELTA);
        pg8::StaticOrder S; S.init(T, D, D, G, BX, ws + WS_WOUT);
        pg8::EpiDelta E{ada + 4096, DELTA};
        pg8::gemm_phase<true>(lds, (const char*)(ws + WS_MERGED), D, S, E, tid, pg8::M8_SHIFT);
    }
    LOCAL_BAR(2);
    }

    DUPLOOP(10) {
    {
        ArgsP A = kargs(); unsigned char* ws = A->ws; const int tid = ltid(wave0), lane = tid & 63, wave = __builtin_amdgcn_readfirstlane(tid >> 6); (void)lane; (void)wave; gu32* ctl = (gu32*)(ws + WS_CTL);
        const float* g_ffn = A->in[14]; const float* b_rg = A->in[16]; const float* b_re = A->in[18]; const float* __restrict__ x = A->in[0]; const bf16* __restrict__ DELTA = WSP(bf16, WS_DELTA);
        const float* ada = WSP(float, WS_ADA); const bf16* __restrict__ RT = WSP(bf16, WS_RT); unsigned char* __restrict__ N28 = ws + WS_N2F8;
        int* tok_e = WSP(int, WS_TOKE); int* tok_p = WSP(int, WS_TOKP); float* tok_w = WSP(float, WS_TOKW); int* elist = WSP(int, WS_LIST);
        if (rep_ == 1) { ctl += 32768; tok_e = WSP(int, WS_K); tok_p = tok_e + 2 * T; tok_w = (float*)(tok_p + 2 * T); elist = (int*)(ws + WS_K + 8 * MiB); }
        LAS unsigned char* At = lds;
        LAS float* lgx = (LAS float*)(lds + TAB_OFF);
        const int row0 = VCU * 64, b = row0 >> 12;
        LAS float* rbias = (LAS float*)(lds + TAB_OFF + 12288 + 16384);
        if (tid < 4) rbias[tid] = b_rg[tid]; else if (tid < 36) rbias[tid] = b_re[tid - 4];
        LAS float* tgs = (LAS float*)(lds + TAB_OFF + 12288); LAS float* tsh = tgs + D;
        for (int i = tid; i < D; i += NWAVES * 64) { tgs[i] = g_ffn[i] * (ada[b * 12288 + 8192 + i] + 1.0f); tsh[i] = ada[b * 12288 + 6144 + i]; }
        __syncthreads();
        for (int ps = 0; ps < 2; ++ps) {
            { const LAS f32x4* gp = (const LAS f32x4*)tgs + lane; const LAS f32x4* shp = (const LAS f32x4*)tsh + lane;
#pragma unroll
              for (int rp = 0; rp < 2; ++rp) {
                  f32x4 v[2][8]; v2u dl[2][8];
#pragma unroll
                  for (int q = 0; q < 2; ++q) { const int row = row0 + ps * 32 + wave * 4 + rp * 2 + q;
#pragma unroll
                      for (int j = 0; j < 8; ++j) { v[q][j] = *((const f32x4*)(x + (size_t)row * D) + lane + 64 * j); dl[q][j] = *((const v2u*)(DELTA + (size_t)row * D) + lane + 64 * j); } }
#pragma unroll
                  for (int q = 0; q < 2; ++q) { const int rl = wave * 4 + rp * 2 + q, row = row0 + ps * 32 + rl; float ss = 0.f;
#pragma unroll
                      for (int j = 0; j < 8; ++j) { v[q][j] += (f32x4){bflo(dl[q][j].x), bfhi(dl[q][j].x), bflo(dl[q][j].y), bfhi(dl[q][j].y)};
                          ss += (v[q][j].x * v[q][j].x + v[q][j].y * v[q][j].y) + (v[q][j].z * v[q][j].z + v[q][j].w * v[q][j].w); }
                      const float rstd = rsqrtf(wave_sum(ss) * (1.f / D) + EPS);
#pragma unroll
                      for (int j = 0; j < 8; ++j) { const f32x4 y = v[q][j] * rstd * gp[64 * j] + shp[64 * j];
                          *((unsigned*)(N28 + (size_t)row * D) + lane + 64 * j) = pk_fp8x4(y.x, y.y, y.z, y.w);
                          v2u w; w.x = cvt_pk_bf16(y.x, y.y); w.y = cvt_pk_bf16(y.z, y.w);
                          *(LAS v2u*)(At + rl * 4096 + ((((lane >> 1) + 32 * j) ^ (rl & 15)) << 4) + ((lane & 1) << 3)) = w; } } } }
            __syncthreads();
            { const int i = lane & 15, kq = lane >> 4;
                f32x4 acc[2][3];
#pragma unroll
                for (int mt = 0; mt < 2; ++mt)
#pragma unroll
                    for (int nt = 0; nt < 3; ++nt) acc[mt][nt] = (f32x4){0.f, 0.f, 0.f, 0.f};
                const unsigned voff = (unsigned)(i * 32 + 8 * kq) * 2u;
                const char* rtw = (const char*)RT + (size_t)(wave * 8) * 6144;
#pragma unroll 1
                for (int kh = 0; kh < 2; ++kh, rtw += 4 * 6144) {
                    bf16x8 wh[4][3], wl[4][3];
#pragma unroll
                    for (int k4 = 0; k4 < 4; ++k4) { const char* ph = rtw + k4 * 6144; const char* pl = ph + 3072;
#pragma unroll
                        for (int nt = 0; nt < 3; ++nt) { wh[k4][nt] = *(const bf16x8*)(ph + voff + nt * 1024); wl[k4][nt] = *(const bf16x8*)(pl + voff + nt * 1024); } }
#pragma unroll
                    for (int k4 = 0; k4 < 4; ++k4) { const int kg = wave * 8 + kh * 4 + k4;
#pragma unroll
                        for (int mt = 0; mt < 2; ++mt) { const bf16x8 af = *(const LAS bf16x8*)(At + (16 * mt + i) * 4096 + (((4 * kg + kq) ^ i) << 4));
#pragma unroll
                            for (int nt = 0; nt < 3; ++nt) { acc[mt][nt] = __builtin_amdgcn_mfma_f32_16x16x32_bf16(af, wh[k4][nt], acc[mt][nt], 0, 0, 0); acc[mt][nt] = __builtin_amdgcn_mfma_f32_16x16x32_bf16(af, wl[k4][nt], acc[mt][nt], 0, 0, 0); } } } }
                __syncthreads();
                LAS float* part = (LAS float*)At + wave * 1536;
#pragma unroll
                for (int mt = 0; mt < 2; ++mt)
#pragma unroll
                    for (int nt = 0; nt < 3; ++nt)
#pragma unroll
                        for (int e = 0; e < 4; ++e) part[(16 * mt + 4 * kq + e) * 48 + nt * 16 + i] = acc[mt][nt][e];
                __syncthreads();
#pragma unroll
                for (int q = 0; q < 3; ++q) { const int idx = tid + 512 * q; float sum = 0.f;
#pragma unroll
                    for (int w8 = 0; w8 < 8; ++w8) sum += ((const LAS float*)At)[w8 * 1536 + idx];
                    lgx[ps * 1536 + idx] = sum; }
                __syncthreads(); }
        }
        if (wave == 7) {
            const LAS float* l = lgx + lane * 48; const int tokn = row0 + lane;
            float gl[4]; int gs = 0; float gmax;
#pragma unroll
            for (int q = 0; q < 4; ++q) gl[q] = l[q] + rbias[q];
            gmax = gl[0];
#pragma unroll
            for (int q = 1; q < 4; ++q) if (gl[q] > gmax) { gmax = gl[q]; gs = q; }
            float den = 0.f;
#pragma unroll
            for (int q = 0; q < 4; ++q) den += __expf(gl[q] - gmax);
            const float pg = 1.0f / den;
            float v0 = -3.0e38f, v1 = -3.0e38f; int i0 = 0, i1 = 0;
#pragma unroll
            for (int q = 0; q < 8; ++q) { const float ev = l[4 + gs * 8 + q] + rbias[4 + gs * 8 + q];
                if (ev > v0) { v1 = v0; i1 = i0; v0 = ev; i0 = q; } else if (ev > v1) { v1 = ev; i1 = q; } }
            const float t = __expf(v1 - v0), w0 = pg / (1.0f + t), w1 = pg * t / (1.0f + t);
            const int e0 = gs * 8 + i0, e1 = gs * 8 + i1;
            const int p0 = (int)__hip_atomic_fetch_add(ctl + CW_CNT + 64 * e0, 1u, RLX_AGENT);
            const int p1 = (int)__hip_atomic_fetch_add(ctl + CW_CNT + 64 * e1, 1u, RLX_AGENT);
            elist[e0 * LCAP + p0] = tokn; elist[e1 * LCAP + p1] = tokn;
            tok_e[2 * tokn] = e0; tok_e[2 * tokn + 1] = e1; tok_p[2 * tokn] = p0; tok_p[2 * tokn + 1] = p1; tok_w[2 * tokn] = w0; tok_w[2 * tokn + 1] = w1;
        }
    }
    GRID_BAR();
    }

    LAS int* bstart = (LAS int*)(lds + TAB_OFF); LAS int* cntl = (LAS int*)(lds + TAB_OFF + 256); LAS int* p7f = (LAS int*)(lds + TAB_OFF + 512);
    { const int t = ltid(wave0);
      if (t < 64) { gu32* ctl = (gu32*)(kargs()->ws + WS_CTL);
          const int c = (t < NEXP) ? (int)__hip_atomic_load(ctl + CW_CNT + 64 * (t & 31), RLX_AGENT) : (t < 48) ? (int)__hip_atomic_load(ctl + CW_BAR + XB_XCNT(t - 32), RLX_AGENT) : 0, nb = (c + 255) >> 8;
          const bool okx = (t < 32) || (t >= 48) || (c == ((t < 40) ? 32 : 0));
          const bool uniform = __ballot(okx) == ~0ull;
          int incl = (t < NEXP) ? nb : 0;
#pragma unroll
          for (int o = 1; o < 32; o <<= 1) { const int v = __shfl_up(incl, o); if (t >= o) incl += v; }
          if (t < NEXP) { cntl[t] = c; bstart[t] = incl - nb; if (t == NEXP - 1) bstart[NEXP] = incl; }
          if (t == 0) p7f[0] = uniform ? 1 : 0; } }
    __syncthreads();
    const int RB = bstart[NEXP];
    const bool xloc = p7f[0] != 0;
    int a_c = VCU, a_G = G, a_tot = RB * 4, b_c = VCU, b_G = G, b_tot = RB * 8, rb0 = 0, rb_late = 0, t1 = 0, t2 = 0; bool late = false; unsigned xme = 0;
    if (xloc) { xme = MISC[16]; const int r = (int)MISC[17]; rb0 = (RB * (int)xme) >> 3; const int nx = ((RB * ((int)xme + 1)) >> 3) - rb0, U = 4 * nx, full = U >> 5, rem = U & 31, E = 32 - rem, Q = 8 * nx;
        int Ql = 0;
        if (rem != 0) { const int covered = 64 * full < Q ? 64 * full : Q, Qlmin = Q - covered; int tq = (rem * (10 * Q - 24 * E)) / 320; tq = tq < 0 ? 0 : tq; Ql = ((tq + 4) >> 3) << 3; Ql = Ql < Qlmin ? Qlmin : Ql; Ql = Ql > Q ? Q : Ql; }
        const int Qe = Q - Ql; late = r < rem;
        a_c = r; a_G = 32; a_tot = U; rb_late = rb0 + 8 * full; t1 = 256 * full; t2 = 8 * rem;
        if (late) { b_c = Qe + r; b_G = rem; b_tot = Q; } else { b_c = r - rem; b_G = E; b_tot = Qe; } }
    {
        ArgsP A = kargs(); unsigned char* ws = A->ws; const int tid = ltid(wave0), lane = tid & 63, wave = __builtin_amdgcn_readfirstlane(tid >> 6); (void)lane; (void)wave;
        const int* elist = WSP(int, WS_LIST); unsigned* ctlw = (unsigned*)(ws + WS_CTL);
        pg8::MoeSched S{bstart, cntl, elist, 4, a_tot, a_G, a_c, D / 128, (const char*)(ws + WS_WGU8), (size_t)1024 * D, (size_t)256 * D, true, rb0};
        pg8::EpiSwiGLU E{ws + WS_HID8, xloc ? ctlw + CW_P7A + 64 * xme : nullptr, ctlw + CW_P7B + 64 * xme, rb_late};
        pg8::gemm_phase<true>(lds, (const char*)(ws + WS_N2F8), D, S, E, tid);
    }
    if (xloc) {
        if (ltid(wave0) == 0) { unsigned* ctlw = (unsigned*)(kargs()->ws + WS_CTL); unsigned* bar = ctlw + CW_BAR;
            __builtin_amdgcn_fence(__ATOMIC_ACQUIRE, "agent");
            XB_SPIN(xb_ld(ctlw + CW_P7A + 64 * xme) < (unsigned)t1, bar);
            if (late) XB_SPIN(xb_ld(ctlw + CW_P7B + 64 * xme) < (unsigned)t2, bar);
            asm volatile("s_waitcnt vmcnt(0)" ::: "memory"); }
        __syncthreads();
    } else GRID_BAR();
    {
        ArgsP A = kargs(); unsigned char* ws = A->ws; const int tid = ltid(wave0), lane = tid & 63, wave = __builtin_amdgcn_readfirstlane(tid >> 6); (void)lane; (void)wave;
        const int* elist = WSP(int, WS_LIST);
        pg8::MoeSched S{bstart, cntl, elist, 8, b_tot, b_G, b_c, DFF / 128, (const char*)(ws + WS_WD8), (size_t)D * DFF, (size_t)256 * DFF, false, rb0};
        pg8::EpiStoreF8 E{ws + WS_YROW};
        pg8::gemm_phase<true>(lds, (const char*)(ws + WS_HID8), DFF, S, E, tid);
        GRID_BAR();
    }

    DUPLOOP(9)
    {
        ArgsP A = kargs(); unsigned char* ws = A->ws; const int tid = ltid(wave0), lane = tid & 63, wave = __builtin_amdgcn_readfirstlane(tid >> 6); (void)lane; (void)wave;
        float* out = A->out; const float* x = A->in[0]; const bf16* DELTA = WSP(bf16, WS_DELTA); const float* g_fin = A->in[22]; const float* ada = WSP(float, WS_ADA); const unsigned char* YROW = ws + WS_YROW;
        const int* tok_e = WSP(int, WS_TOKE); const int* tok_p = WSP(int, WS_TOKP); const float* tok_w = WSP(float, WS_TOKW);
        const bool poison = __hip_atomic_load((gu32*)(ws + WS_CTL) + CW_BAR + XB_TMO, RLX_AGENT) != 0u;
        LAS float* tgf = (LAS float*)lds; LAS float* tgn = tgf + D;
        { const int b0 = (VCU * NWAVES * 8) >> 12; for (int i = tid; i < D; i += NWAVES * 64) { tgf[i] = ada[(size_t)b0 * 12288 + 10240 + i]; tgn[i] = g_fin[i]; } }
        __syncthreads();
        for (int rr = 0; rr < 8; ++rr) {
            const int row = (VCU * NWAVES + wave) * 8 + rr;
            const int e0 = tok_e[2 * row], e1 = tok_e[2 * row + 1];
            const size_t s0 = (size_t)(bstart[e0] * 256 + tok_p[2 * row]), s1 = (size_t)(bstart[e1] * 256 + tok_p[2 * row + 1]);
            const float w0 = tok_w[2 * row] * (1.0f / (float)(1 << pg8::Y8_SHIFT)), w1 = tok_w[2 * row + 1] * (1.0f / (float)(1 << pg8::Y8_SHIFT));
            f32x4* hr = (f32x4*)(out + (size_t)row * D) + lane; const f32x4* xr = (const f32x4*)(x + (size_t)row * D) + lane; const v2u* dr = (const v2u*)(DELTA + (size_t)row * D) + lane;
            const unsigned* y0 = (const unsigned*)(YROW + s0 * D) + lane; const unsigned* y1 = (const unsigned*)(YROW + s1 * D) + lane;
            const LAS f32x4* gf = (const LAS f32x4*)tgf + lane;
            f32x4 v[8]; float ss = 0.f;
#pragma unroll
            for (int j = 0; j < 8; ++j) { const v2u dl = dr[64 * j]; const f32x4 hv = xr[64 * j] + (f32x4){bflo(dl.x), bfhi(dl.x), bflo(dl.y), bfhi(dl.y)}, gg = gf[64 * j]; const unsigned a = y0[64 * j], c = y1[64 * j];
                const f32x2 a0 = __builtin_amdgcn_cvt_pk_f32_fp8((int)a, false), a1 = __builtin_amdgcn_cvt_pk_f32_fp8((int)a, true), c0 = __builtin_amdgcn_cvt_pk_f32_fp8((int)c, false), c1 = __builtin_amdgcn_cvt_pk_f32_fp8((int)c, true);
                f32x4 y; y.x = w0 * a0.x + w1 * c0.x; y.y = w0 * a0.y + w1 * c0.y; y.z = w0 * a1.x + w1 * c1.x; y.w = w0 * a1.y + w1 * c1.y;
                v[j] = hv + gg * y; ss += (v[j].x * v[j].x + v[j].y * v[j].y) + (v[j].z * v[j].z + v[j].w * v[j].w); }
            const float rstd = rsqrtf(wave_sum(ss) * (1.f / D) + EPS);
#pragma unroll
            for (int j = 0; j < 8; ++j) { const f32x4 gg = *((const LAS f32x4*)tgn + lane + 64 * j); hr[64 * j] = poison ? (f32x4){__builtin_nanf(""), __builtin_nanf(""), __builtin_nanf(""), __builtin_nanf("")} : v[j] * rstd * gg; }
        }
    }
}

extern "C" void kernel_launch(void* const* d_in, const int* in_sizes, int n_in, void* d_out, int out_size, void* d_ws, size_t ws_size, hipStream_t stream) {
    static int grid = 0;
    if (grid == 0) {
        if (n_in != 23 || in_sizes[0] != T * D || out_size != T * D || ws_size < WS_END) { fprintf(stderr, "kernel_launch: unexpected shapes (n_in %d, out %d, ws %zu)\n", n_in, out_size, ws_size); grid = -1; return; }
        int dev = 0, cus = 0, per_cu = 0;
        if (hipGetDevice(&dev) != hipSuccess || hipDeviceGetAttribute(&cus, hipDeviceAttributeMultiprocessorCount, dev) != hipSuccess) { grid = -1; return; }
        if (hipFuncSetAttribute((const void*)fwd_kernel, hipFuncAttributeMaxDynamicSharedMemorySize, LDS_BYTES) != hipSuccess) { fprintf(stderr, "kernel_launch: hipFuncSetAttribute failed\n"); grid = -1; return; }
        if (hipOccupancyMaxActiveBlocksPerMultiprocessor(&per_cu, (const void*)fwd_kernel, NWAVES * 64, LDS_BYTES) != hipSuccess || per_cu < 1) fprintf(stderr, "kernel_launch: occupancy query reports %d\n", per_cu);
        (void)hipGetLastError();
        grid = cus;
        if (grid != 256) { fprintf(stderr, "kernel_launch: this kernel is built for 256 CUs, got %d\n", grid); grid = -1; return; }
    }
    if (grid < 0) return;
    (void)hipMemsetAsync((char*)d_ws + WS_CTL, 0, CTL_ZERO_BYTES, stream);
    Args a{};
    for (int i = 0; i < 23; ++i) a.in[i] = (const float*)d_in[i];
    a.out = (float*)d_out; a.ws = (unsigned char*)d_ws;
    hipLaunchKernelGGL(fwd_kernel, dim3(grid), dim3(NWAVES * 64), LDS_BYTES, stream, a);
}
```
